# Optimizing an MI355X kernel written in HIP

```python
import jax
import jax.numpy as jnp
from jax import lax
import numpy as np

D_MODEL = 1024
BATCH = 4
SEQ = 8192
DEPTH = 4

CTX_LEN = 256
GRID_W = 64
D_MIX = D_MODEL
CONV_CH = D_MIX // 2
RET_HEADS = 4
RET_DK = (D_MIX - CONV_CH) // RET_HEADS
RET_DV = RET_DK
RET_W = RET_HEADS * RET_DV
N_PROJ = 3 * CONV_CH + 4 * RET_W
CHUNK = 128
ROPE_BASE = 10000.0
PEER_HEADS = 8
N_KEYS = 128
N_EXPERTS = N_KEYS * N_KEYS
PEER_TOPK = 16
PEER_DK = 256
PEER_HALF = PEER_DK // 2
PEER_BLOCK = 128
ALPHA = float((2 * DEPTH) ** 0.25)
BETA = float((8 * DEPTH) ** -0.25)
LN_EPS = 1e-5
GN_EPS = 1e-5

kernel_name = 'hybrid_conv_retention_peer_dit'


def _layer_norm(x, g, b):
    xf = x.astype(jnp.float32)
    mu = jnp.mean(xf, -1, keepdims=True)
    var = jnp.mean(jnp.square(xf - mu), -1, keepdims=True)
    return ((xf - mu) * lax.rsqrt(var + LN_EPS)).astype(x.dtype) * g + b


def _modulate(x, shift, scale):
    return x * (1 + scale) + shift


def _conv3_grid(z, w):
    b, length, ch = z.shape
    rows = length // GRID_W
    zp = jnp.pad(z.reshape(b, rows, GRID_W, ch), ((0, 0), (0, 0), (1, 1), (0, 0)))
    y = zp[:, :, :-2] * w[:, 0] + zp[:, :, 1:-1] * w[:, 1] + zp[:, :, 2:] * w[:, 2]
    return y.reshape(b, length, ch)


def _conv3_seq(z, w):
    zp = jnp.pad(z, ((0, 0), (1, 1), (0, 0)))
    return zp[:, :-2] * w[:, 0] + zp[:, 1:-1] * w[:, 1] + zp[:, 2:] * w[:, 2]


def _rope_2d(t):
    length = t.shape[1]
    pos = jnp.arange(length)
    nf = RET_DK // 4
    inv = ROPE_BASE ** (-jnp.arange(nf, dtype=jnp.float32) / nf)

    def rot(u, p):
        ang = p.astype(jnp.float32)[:, None] * inv[None, :]
        cos = jnp.cos(ang)[None, :, None, :].astype(u.dtype)
        sin = jnp.sin(ang)[None, :, None, :].astype(u.dtype)
        u1, u2 = u[..., :nf], u[..., nf:]
        return jnp.concatenate([u1 * cos - u2 * sin, u1 * sin + u2 * cos], -1)

    half = RET_DK // 2
    return jnp.concatenate([rot(t[..., :half], pos // GRID_W), rot(t[..., half:], pos % GRID_W)], -1)


def _heads(t):
    return t.reshape(t.shape[:-1] + (RET_HEADS, RET_DK))


def _bhld(t):
    return jnp.transpose(t, (0, 2, 1, 3)).astype(jnp.float32)


def _log_gammas(offset):
    h = jnp.arange(RET_HEADS, dtype=jnp.float32)
    return jnp.log1p(-jnp.exp2(-(5.0 + offset + h)))


def _final_state(k, v, lg):
    length = k.shape[2]
    w = jnp.exp((length - 1 - jnp.arange(length, dtype=jnp.float32))[None, :] * lg[:, None])
    return jnp.einsum('bhld,bhle->bhde', k * w[None, :, :, None], v)


def _chunk_retention(q, k, v, lg, state0, inclusive):
    b, h, length, dk = q.shape
    dv = v.shape[-1]
    n = length // CHUNK
    qc = q.reshape(b, h, n, CHUNK, dk)
    kc = k.reshape(b, h, n, CHUNK, dk)
    vc = v.reshape(b, h, n, CHUNK, dv)
    pos = jnp.arange(CHUNK, dtype=jnp.float32)
    diff = pos[:, None] - pos[None, :]
    mask = diff >= 0 if inclusive else diff > 0
    dmat = jnp.where(mask[None], jnp.exp(jnp.where(mask, diff, 0.0)[None] * lg[:, None, None]), 0.0)
    scores = jnp.einsum('bhncd,bhnsd->bhncs', qc, kc) * dmat[None, :, None]
    o_intra = jnp.einsum('bhncs,bhnse->bhnce', scores, vc)
    k_w = kc * jnp.exp((CHUNK - 1 - pos)[None, :] * lg[:, None])[None, :, None, :, None]
    upd = jnp.einsum('bhnsd,bhnse->bhnde', k_w, vc)
    chunk_decay = jnp.exp(CHUNK * lg)[None, :, None, None]

    def step(s, u):
        return chunk_decay * s + u, s

    _, s_prev = lax.scan(step, state0, jnp.moveaxis(upd, 2, 0))
    s_prev = jnp.moveaxis(s_prev, 0, 2)
    q_w = qc * jnp.exp((pos + 1)[None, :] * lg[:, None])[None, :, None, :, None]
    o_cross = jnp.einsum('bhncd,bhnde->bhnce', q_w, s_prev)
    return (o_intra + o_cross).reshape(b, h, length, dv)


def _retention_bidir(q, k, v, s_f, s_b):
    o_f = _chunk_retention(q, k, v, _log_gammas(0.0), s_f, True)
    o_b = jnp.flip(_chunk_retention(jnp.flip(q, 2), jnp.flip(k, 2), jnp.flip(v, 2),
                                    _log_gammas(0.5), s_b, False), 2)
    return o_f + o_b


def _retention_out(o, g):
    mu = jnp.mean(o, -1, keepdims=True)
    var = jnp.mean(jnp.square(o - mu), -1, keepdims=True)
    on = (o - mu) * lax.rsqrt(var + GN_EPS)
    b, h, length, dv = o.shape
    on = jnp.transpose(on, (0, 2, 1, 3)).reshape(b, length, h * dv).astype(g.dtype)
    return jax.nn.silu(g) * on


def _token_mixer(h_lat, h_ctx, w_in, conv_w, w_out, with_ctx_out):
    scale_k = RET_DK ** -0.5
    bg, cg, hx, q, k, v, g = jnp.split(h_lat @ w_in, 7, axis=-1)
    conv_lat = bg * _conv3_grid(cg * hx, conv_w)
    q_l = _bhld(_rope_2d(_heads(q)))
    k_l = _bhld(_rope_2d(_heads(k))) * scale_k
    v_l = _bhld(_heads(v))
    k0 = 3 * CONV_CH + RET_W
    if with_ctx_out:
        bgc, cgc, hxc, qc, kc, vc, gc = jnp.split(h_ctx @ w_in, 7, axis=-1)
    else:
        kc, vc = jnp.split(h_ctx @ w_in[:, k0:k0 + 2 * RET_W], 2, axis=-1)
    k_c = _bhld(_heads(kc)) * scale_k
    v_c = _bhld(_heads(vc))
    s_f = _final_state(k_c, v_c, _log_gammas(0.0))
    s_b = _final_state(jnp.flip(k_c, 2), jnp.flip(v_c, 2), _log_gammas(0.5))
    ret_lat = _retention_out(_retention_bidir(q_l, k_l, v_l, s_f, s_b), g)
    y_lat = jnp.concatenate([conv_lat, ret_lat], -1) @ w_out
    if not with_ctx_out:
        return y_lat, None
    conv_ctx = bgc * _conv3_seq(cgc * hxc, conv_w)
    zero = jnp.zeros_like(s_f)
    ret_ctx = _retention_out(_retention_bidir(_bhld(_heads(qc)), k_c, v_c, zero, zero), gc)
    y_ctx = jnp.concatenate([conv_ctx, ret_ctx], -1) @ w_out
    return y_lat, y_ctx


def _peer_ffn(h, wq, keys, u, v):
    b, length, d = h.shape
    blocks = h.reshape(-1, PEER_BLOCK, d)

    def one(hb):
        q = (hb @ wq).reshape(PEER_BLOCK, PEER_HEADS, 2, PEER_HALF)
        s = jnp.einsum('thpd,pnd->thpn', q, keys).astype(jnp.float32)
        sv, si = lax.top_k(s, PEER_TOPK)
        cand = sv[:, :, 0, :, None] + sv[:, :, 1, None, :]
        cv, ci = lax.top_k(cand.reshape(PEER_BLOCK, PEER_HEADS, PEER_TOPK * PEER_TOPK), PEER_TOPK)
        i1 = jnp.take_along_axis(si[:, :, 0], ci // PEER_TOPK, axis=-1)
        i2 = jnp.take_along_axis(si[:, :, 1], ci % PEER_TOPK, axis=-1)
        e = i1 * N_KEYS + i2
        gate = jax.nn.softmax(cv, axis=-1)
        act = jax.nn.gelu(jnp.einsum('thkd,td->thk', jnp.take(u, e, axis=0), hb), approximate=False)
        return jnp.einsum('thk,thkd->td', (gate * act).astype(hb.dtype), jnp.take(v, e, axis=0))

    return lax.map(one, blocks).reshape(b, length, d)


def setup_inputs(seed: int = 0) -> dict:
    key = jax.random.key(seed)
    ks = jax.random.split(key, 17)
    n = jax.random.normal
    f32 = jnp.float32
    col_scale = jnp.concatenate([
        jnp.ones((2 * CONV_CH,), f32), jnp.full((CONV_CH,), BETA, f32),
        jnp.ones((2 * RET_W,), f32), jnp.full((RET_W,), BETA, f32),
        jnp.ones((RET_W,), f32)])
    return {
        'x': n(ks[0], (BATCH, SEQ, D_MODEL), f32),
        'c': n(ks[1], (BATCH, D_MODEL), f32),
        'ctx': n(ks[2], (BATCH, CTX_LEN, D_MODEL), f32),
        'c_ctx': n(ks[3], (D_MODEL,), f32),
        'w_mod': n(ks[4], (DEPTH, D_MODEL, 6 * D_MODEL), f32) * D_MODEL ** -0.5,
        'b_mod': 0.02 * n(ks[5], (DEPTH, 6 * D_MODEL), f32),
        'w_in': n(ks[6], (DEPTH, D_MODEL, N_PROJ), f32) * (D_MODEL ** -0.5) * col_scale,
        'conv_w': n(ks[7], (DEPTH, CONV_CH, 3), f32) * 3 ** -0.5,
        'w_out': n(ks[8], (DEPTH, D_MIX, D_MODEL), f32) * (D_MIX ** -0.5) * BETA,
        'ln1_g': 1.0 + 0.02 * n(ks[9], (DEPTH, D_MODEL), f32),
        'ln1_b': 0.02 * n(ks[10], (DEPTH, D_MODEL), f32),
        'peer_wq': n(ks[11], (DEPTH, D_MODEL, PEER_HEADS * PEER_DK), f32) * D_MODEL ** -0.5,
        'peer_keys': n(ks[12], (DEPTH, 2, N_KEYS, PEER_HALF), f32) * PEER_HALF ** -0.5,
        'peer_u': n(ks[13], (DEPTH, N_EXPERTS, D_MODEL), f32) * D_MODEL ** -0.5,
        'peer_v': n(ks[14], (DEPTH, N_EXPERTS, D_MODEL), f32) * BETA,
        'ln2_g': 1.0 + 0.02 * n(ks[15], (DEPTH, D_MODEL), f32),
        'ln2_b': 0.02 * n(ks[16], (DEPTH, D_MODEL), f32),
    }


def reference(x, c, ctx, c_ctx, w_mod, b_mod, w_in, conv_w, w_out, ln1_g, ln1_b,
              peer_wq, peer_keys, peer_u, peer_v, ln2_g, ln2_b):
    sc = jax.nn.silu(c)
    scc = jax.nn.silu(c_ctx)
    x_lat, x_ctx = x, ctx
    for l in range(DEPTH):
        last = l == DEPTH - 1
        m_lat = [m[:, None, :] for m in jnp.split(sc @ w_mod[l] + b_mod[l], 6, axis=-1)]
        m_ctx = jnp.split(scc @ w_mod[l] + b_mod[l], 6, axis=-1)
        h_lat = _modulate(x_lat, m_lat[0], m_lat[1])
        h_ctx = _modulate(x_ctx, m_ctx[0], m_ctx[1])
        y_lat, y_ctx = _token_mixer(h_lat, h_ctx, w_in[l], conv_w[l], w_out[l], not last)
        x_lat = _layer_norm(ALPHA * x_lat + m_lat[2] * y_lat, ln1_g[l], ln1_b[l])
        h2 = _modulate(x_lat, m_lat[3], m_lat[4])
        f_lat = _peer_ffn(h2, peer_wq[l], peer_keys[l], peer_u[l], peer_v[l])
        x_lat = _layer_norm(ALPHA * x_lat + m_lat[5] * f_lat, ln2_g[l], ln2_b[l])
        if not last:
            x_ctx = _layer_norm(ALPHA * x_ctx + m_ctx[2] * y_ctx, ln1_g[l], ln1_b[l])
            h2c = _modulate(x_ctx, m_ctx[3], m_ctx[4])
            f_ctx = _peer_ffn(h2c, peer_wq[l], peer_keys[l], peer_u[l], peer_v[l])
            x_ctx = _layer_norm(ALPHA * x_ctx + m_ctx[5] * f_ctx, ln2_g[l], ln2_b[l])
    return x_lat
```

```cpp
#include <hip/hip_runtime.h>
#include <hip/hip_cooperative_groups.h>
#include <stdint.h>
#include <math.h>
#include <stdio.h>
#include <utility>
#include <type_traits>

namespace cg = cooperative_groups;

typedef unsigned short bf16_t;
using bf16x8 = __attribute__((ext_vector_type(8))) short;
using s16x4 = __attribute__((ext_vector_type(4))) short;
using f32x4 = __attribute__((ext_vector_type(4))) float;

#define DM 1024
#define NB 4
#define SEQ 8192
#define TL 32768
#define TC 1024
#define TT 33792
#define NCHUNK 264
#define NPROJ 3584
#define NLAYER 4
#define NEXP 16384
#define ALPHA_F 1.681792830507429f
#define SMEM_BYTES 53248
#ifndef DBG_HMASK
#define DBG_HMASK 0x40
#endif
#ifndef DBG_RO
#define DBG_RO 0
#endif
#ifndef DBG_STOP
#define DBG_STOP 0
#endif

struct Params {
  const float *x, *c, *ctx, *c_ctx, *w_mod, *b_mod, *w_in, *conv_w, *w_out, *ln1_g, *ln1_b;
  const float *peer_wq, *peer_keys, *peer_u, *peer_v, *ln2_g, *ln2_b;
  float* out;
  float* xres; bf16_t* hA; char* big; bf16_t* cat; float* st; float* ybuf;
  bf16_t *w_inT, *w_outT, *wkT, *ubf, *vbf;
  float* sv; unsigned char* si; int* pe; float* pg;
  float *mod, *modp, *ropec, *ropes;
  unsigned* bar; unsigned* pad0;
  float lg2[2][4];
};

__device__ __forceinline__ bf16_t f2bf(float f) {
  uint32_t u = __float_as_uint(f);
  u += 0x7fffu + ((u >> 16) & 1u);
  return (bf16_t)(u >> 16);
}
__device__ __forceinline__ float bf2f(bf16_t b) { return __uint_as_float(((uint32_t)b) << 16); }
__device__ __forceinline__ uint32_t pack2(float a, float b) { return (uint32_t)f2bf(a) | ((uint32_t)f2bf(b) << 16); }
__device__ __forceinline__ float bflo(uint32_t w) { return __uint_as_float(w << 16); }
__device__ __forceinline__ float bfhi(uint32_t w) { return __uint_as_float(w & 0xffff0000u); }
__device__ __forceinline__ float wave_sum(float v) {
#pragma unroll
  for (int o = 32; o > 0; o >>= 1) v += __shfl_xor(v, o);
  return v;
}
__device__ __forceinline__ float row16_sum(float v) {
  v += __builtin_bit_cast(float, __builtin_amdgcn_update_dpp(0, __builtin_bit_cast(int, v), 0xB1, 0xF, 0xF, true));
  v += __builtin_bit_cast(float, __builtin_amdgcn_update_dpp(0, __builtin_bit_cast(int, v), 0x4E, 0xF, 0xF, true));
  v += __builtin_bit_cast(float, __builtin_amdgcn_update_dpp(0, __builtin_bit_cast(int, v), 0x141, 0xF, 0xF, true));
  v += __builtin_bit_cast(float, __builtin_amdgcn_update_dpp(0, __builtin_bit_cast(int, v), 0x140, 0xF, 0xF, true));
  return v;
}
__device__ __forceinline__ float silu_f(float v) { return v * __builtin_amdgcn_rcpf(1.f + __expf(-v)); }
__device__ __forceinline__ int mod_row(int t) { return t < TL ? (t >> 13) : 4; }

__device__ __forceinline__ f32x4 zero4() { f32x4 a = {0.f, 0.f, 0.f, 0.f}; asm volatile("" : "+v"(a)); return a; }

template <class F, int... I>
__device__ __forceinline__ void static_for_impl(F&& f, std::integer_sequence<int, I...>) { (f(std::integral_constant<int, I>{}), ...); }
template <int N, class F>
__device__ __forceinline__ void static_for(F&& f) { static_for_impl(f, std::make_integer_sequence<int, N>{}); }

__device__ __forceinline__ unsigned tr_lane_base(unsigned base, unsigned ld) {
  const unsigned lane = threadIdx.x & 63u;
  const unsigned g = lane >> 4, q = (lane & 15u) >> 2, p = lane & 3u;
  return base + (8u * g + q) * ld + 8u * p;
}
template <int O0, int O1, int O2, int O3, int D>
__device__ __forceinline__ void tr_frag4(unsigned a, bf16x8& f0, bf16x8& f1, bf16x8& f2, bf16x8& f3) {
  s16x4 r0, r1, r2, r3, r4, r5, r6, r7;
  asm volatile(
      "ds_read_b64_tr_b16 %0, %8 offset:%9\n\t"
      "ds_read_b64_tr_b16 %1, %8 offset:%10\n\t"
      "ds_read_b64_tr_b16 %2, %8 offset:%11\n\t"
      "ds_read_b64_tr_b16 %3, %8 offset:%12\n\t"
      "ds_read_b64_tr_b16 %4, %8 offset:%13\n\t"
      "ds_read_b64_tr_b16 %5, %8 offset:%14\n\t"
      "ds_read_b64_tr_b16 %6, %8 offset:%15\n\t"
      "ds_read_b64_tr_b16 %7, %8 offset:%16\n\t"
      "s_waitcnt lgkmcnt(0)"
      : "=&v"(r0), "=&v"(r1), "=&v"(r2), "=&v"(r3), "=&v"(r4), "=&v"(r5), "=&v"(r6), "=&v"(r7)
      : "v"(a), "n"(O0), "n"(O0 + D), "n"(O1), "n"(O1 + D), "n"(O2), "n"(O2 + D), "n"(O3), "n"(O3 + D)
      : "memory");
  f0 = __builtin_shufflevector(r0, r1, 0, 1, 2, 3, 4, 5, 6, 7);
  f1 = __builtin_shufflevector(r2, r3, 0, 1, 2, 3, 4, 5, 6, 7);
  f2 = __builtin_shufflevector(r4, r5, 0, 1, 2, 3, 4, 5, 6, 7);
  f3 = __builtin_shufflevector(r6, r7, 0, 1, 2, 3, 4, 5, 6, 7);
}

__device__ void ph_mod_partial(const Params& p, int bid, int nb, char* smem) {
  float* sm = (float*)smem;
  const int tid = threadIdx.x;
  for (int item = bid; item < 4 * 24 * 8; item += nb) {
    const int ks = item & 7, cb = (item >> 3) % 24, l = item / 192;
    __syncthreads();
    for (int idx = tid; idx < 640; idx += 256) {
      const int r = idx >> 7, k = ks * 128 + (idx & 127);
      const float v = (r < 4) ? p.c[r * DM + k] : p.c_ctx[k];
      sm[idx] = silu_f(v);
    }
    __syncthreads();
    const int col = cb * 256 + tid;
    float acc[5] = {0.f, 0.f, 0.f, 0.f, 0.f};
    const float* w = p.w_mod + ((size_t)l * DM + ks * 128) * 6144 + col;
#pragma unroll 4
    for (int k = 0; k < 128; ++k) {
      const float wv = w[(size_t)k * 6144];
#pragma unroll
      for (int r = 0; r < 5; ++r) acc[r] += sm[r * 128 + k] * wv;
    }
#pragma unroll
    for (int r = 0; r < 5; ++r) p.modp[((size_t)(ks * 4 + l) * 5 + r) * 6144 + col] = acc[r];
  }
}

__device__ void ph_mod_reduce(const Params& p, int bid, int nb) {
  const int gtid = bid * 256 + threadIdx.x, gn = nb * 256;
  for (int idx = gtid; idx < 4 * 5 * 6144; idx += gn) {
    const int l = idx / (5 * 6144), col = idx % 6144;
    float s = p.b_mod[l * 6144 + col];
#pragma unroll
    for (int ks = 0; ks < 8; ++ks) s += p.modp[(size_t)ks * (4 * 5 * 6144) + idx];
    p.mod[idx] = s;
  }
  for (int idx = gtid; idx < 128 * 32; idx += gn) {
    const int pos = idx >> 5, d = idx & 31;
    const float inv = exp2f(-(float)d * (13.287712379549449f / 32.f));
    const float angf = (float)pos * inv;
    const double a = (double)angf;
    const double kk = rint(a * 0.15915494309189535);
    const double r = a - kk * 6.283185307179586;
    const double r2 = r * r;
    double sn = 1.0, cs = 1.0;
    for (int n = 13; n >= 1; --n) {
      sn = 1.0 - sn * r2 / (double)((2 * n) * (2 * n + 1));
      cs = 1.0 - cs * r2 / (double)((2 * n - 1) * (2 * n));
    }
    p.ropec[idx] = (float)cs;
    p.ropes[idx] = (float)(r * sn);
  }
}

__device__ void ph_transpose_cvt(const float* src, bf16_t* dst, int K, int N, int bid, int nb, char* smem) {
  float* tile = (float*)smem;
  const int tid = threadIdx.x;
  const int ntn = N >> 6, ntk = K >> 6;
  for (int item = bid; item < ntn * ntk; item += nb) {
    const int kt = item / ntn, nt = item % ntn;
    __syncthreads();
#pragma unroll
    for (int i = 0; i < 4; ++i) {
      const int r = (tid >> 4) + 16 * i, c4 = (tid & 15) * 4;
      const float4 v = *(const float4*)(src + (size_t)(kt * 64 + r) * N + nt * 64 + c4);
      tile[r * 65 + c4 + 0] = v.x; tile[r * 65 + c4 + 1] = v.y; tile[r * 65 + c4 + 2] = v.z; tile[r * 65 + c4 + 3] = v.w;
    }
    __syncthreads();
    const int n = tid >> 2, kseg = (tid & 3) * 16;
    uint32_t w[8];
#pragma unroll
    for (int e = 0; e < 8; ++e) w[e] = pack2(tile[(kseg + 2 * e) * 65 + n], tile[(kseg + 2 * e + 1) * 65 + n]);
    uint4* d = (uint4*)(dst + (size_t)(nt * 64 + n) * K + kt * 64 + kseg);
    d[0] = make_uint4(w[0], w[1], w[2], w[3]);
    d[1] = make_uint4(w[4], w[5], w[6], w[7]);
  }
}

__device__ void ph_wk_fold(const Params& p, int bid, int nb, char* smem) {
  float* wq_s = (float*)smem;
  float* key_s = wq_s + 64 * 65;
  const int tid = threadIdx.x;
  const int tc = tid >> 4, tn = tid & 15;
  for (int item = bid; item < 4 * 16 * 16; item += nb) {
    const int ct = item & 15, hp = (item >> 4) & 15, l = item >> 8;
    float acc[4][8];
#pragma unroll
    for (int a = 0; a < 4; ++a)
#pragma unroll
      for (int b = 0; b < 8; ++b) acc[a][b] = 0.f;
    for (int dh = 0; dh < 2; ++dh) {
      __syncthreads();
#pragma unroll
      for (int i = 0; i < 4; ++i) {
        const int r = (tid >> 4) + 16 * i, c4 = (tid & 15) * 4;
        const float4 v = *(const float4*)(p.peer_wq + ((size_t)l * DM + ct * 64 + r) * 2048 + hp * 128 + dh * 64 + c4);
        wq_s[r * 65 + c4 + 0] = v.x; wq_s[r * 65 + c4 + 1] = v.y; wq_s[r * 65 + c4 + 2] = v.z; wq_s[r * 65 + c4 + 3] = v.w;
      }
#pragma unroll
      for (int i = 0; i < 8; ++i) {
        const int r = (tid >> 4) + 16 * i, c4 = (tid & 15) * 4;
        const float4 v = *(const float4*)(p.peer_keys + (((size_t)l * 2 + (hp & 1)) * 128 + r) * 128 + dh * 64 + c4);
        key_s[r * 65 + c4 + 0] = v.x; key_s[r * 65 + c4 + 1] = v.y; key_s[r * 65 + c4 + 2] = v.z; key_s[r * 65 + c4 + 3] = v.w;
      }
      __syncthreads();
#pragma unroll 4
      for (int d = 0; d < 64; ++d) {
        float av[4], bv[8];
#pragma unroll
        for (int a = 0; a < 4; ++a) av[a] = wq_s[(tc * 4 + a) * 65 + d];
#pragma unroll
        for (int b = 0; b < 8; ++b) bv[b] = key_s[(tn + 16 * b) * 65 + d];
#pragma unroll
        for (int a = 0; a < 4; ++a)
#pragma unroll
          for (int b = 0; b < 8; ++b) acc[a][b] += av[a] * bv[b];
      }
    }
#pragma unroll
    for (int b = 0; b < 8; ++b) {
      const int row = hp * 128 + tn + 16 * b;
      uint2 o;
      o.x = pack2(acc[0][b], acc[1][b]);
      o.y = pack2(acc[2][b], acc[3][b]);
      *(uint2*)(p.wkT + ((size_t)l * 2048 + row) * DM + ct * 64 + tc * 4) = o;
    }
  }
}

__device__ void ph_cvt_uv(const Params& p, int l, int bid, int nb) {
  const size_t n8 = (size_t)NEXP * DM / 8;
  const float* su = p.peer_u + (size_t)l * NEXP * DM;
  const float* sv = p.peer_v + (size_t)l * NEXP * DM;
  for (size_t i = (size_t)bid * 256 + threadIdx.x; i < 2 * n8; i += (size_t)nb * 256) {
    const bool isv = i >= n8;
    const size_t j = isv ? i - n8 : i;
    const float4* s = (const float4*)((isv ? sv : su) + j * 8);
    const float4 a = s[0], b = s[1];
    uint4 o = make_uint4(pack2(a.x, a.y), pack2(a.z, a.w), pack2(b.x, b.y), pack2(b.z, b.w));
    *(uint4*)((isv ? p.vbf : p.ubf) + j * 8) = o;
  }
}

__device__ void ph_init_h(const Params& p, int bid, int nb) {
  const int lane = threadIdx.x & 63;
  const int gw = bid * 4 + (threadIdx.x >> 6), nw = nb * 4;
  for (int t = gw; t < TT; t += nw) {
    const float* xr = t < TL ? p.x + (size_t)t * DM : p.ctx + (size_t)(t - TL) * DM;
    const float* m = p.mod + (size_t)(0 * 5 + mod_row(t)) * 6144;
#pragma unroll
    for (int i = 0; i < 4; ++i) {
      const int col = lane * 4 + 256 * i;
      const float4 v = *(const float4*)(xr + col);
      const float4 sh = *(const float4*)(m + col);
      const float4 sc = *(const float4*)(m + 1024 + col);
      uint2 o;
      o.x = pack2(v.x * (1.f + sc.x) + sh.x, v.y * (1.f + sc.y) + sh.y);
      o.y = pack2(v.z * (1.f + sc.z) + sh.z, v.w * (1.f + sc.w) + sh.w);
      *(uint2*)(p.hA + (size_t)t * DM + col) = o;
    }
  }
}

template <bool OUT_BF16>
__device__ void ph_gemm(const bf16_t* __restrict__ A, const bf16_t* __restrict__ Bt, void* Cout, int M, int N, int K,
                        int bid, int nb, char* smem) {
  bf16_t* As = (bf16_t*)smem;
  bf16_t* Bs = As + 2 * 128 * 40;
  const int tid = threadIdx.x, lane = tid & 63, wave = tid >> 6;
  const int wm = wave >> 1, wn = wave & 1;
  const int ntn = N >> 7, ntm = M >> 7;
  const int nk = K >> 5;
  for (int tile = bid; tile < ntn * ntm; tile += nb) {
    const int m0 = (tile / ntn) << 7, n0 = (tile % ntn) << 7;
    f32x4 acc[4][4];
#pragma unroll
    for (int i = 0; i < 4; ++i)
#pragma unroll
      for (int j = 0; j < 4; ++j) acc[i][j] = zero4();
    uint4 ra[2], rb[2];
    const int lrow0 = tid >> 2, lkc = (tid & 3) * 8;
    const bf16_t* ga = A + (size_t)(m0 + lrow0) * K + lkc;
    const bf16_t* gb = Bt + (size_t)(n0 + lrow0) * K + lkc;
    __syncthreads();
    ra[0] = *(const uint4*)(ga); ra[1] = *(const uint4*)(ga + (size_t)64 * K);
    rb[0] = *(const uint4*)(gb); rb[1] = *(const uint4*)(gb + (size_t)64 * K);
    *(uint4*)(As + lrow0 * 40 + lkc) = ra[0]; *(uint4*)(As + (lrow0 + 64) * 40 + lkc) = ra[1];
    *(uint4*)(Bs + lrow0 * 40 + lkc) = rb[0]; *(uint4*)(Bs + (lrow0 + 64) * 40 + lkc) = rb[1];
    __syncthreads();
    for (int kt = 0; kt < nk; ++kt) {
      const int cur = kt & 1;
      if (kt + 1 < nk) {
        ra[0] = *(const uint4*)(ga + (kt + 1) * 32); ra[1] = *(const uint4*)(ga + (size_t)64 * K + (kt + 1) * 32);
        rb[0] = *(const uint4*)(gb + (kt + 1) * 32); rb[1] = *(const uint4*)(gb + (size_t)64 * K + (kt + 1) * 32);
      }
      const bf16_t* as = As + cur * 128 * 40 + (wm * 64 + (lane & 15)) * 40 + (lane >> 4) * 8;
      const bf16_t* bs = Bs + cur * 128 * 40 + (wn * 64 + (lane & 15)) * 40 + (lane >> 4) * 8;
      bf16x8 af[4], bfr[4];
#pragma unroll
      for (int i = 0; i < 4; ++i) af[i] = *(const bf16x8*)(as + i * 16 * 40);
#pragma unroll
      for (int j = 0; j < 4; ++j) bfr[j] = *(const bf16x8*)(bs + j * 16 * 40);
#pragma unroll
      for (int i = 0; i < 4; ++i)
#pragma unroll
        for (int j = 0; j < 4; ++j) acc[i][j] = __builtin_amdgcn_mfma_f32_16x16x32_bf16(af[i], bfr[j], acc[i][j], 0, 0, 0);
      if (kt + 1 < nk) {
        const int nx = cur ^ 1;
        *(uint4*)(As + nx * 128 * 40 + lrow0 * 40 + lkc) = ra[0]; *(uint4*)(As + nx * 128 * 40 + (lrow0 + 64) * 40 + lkc) = ra[1];
        *(uint4*)(Bs + nx * 128 * 40 + lrow0 * 40 + lkc) = rb[0]; *(uint4*)(Bs + nx * 128 * 40 + (lrow0 + 64) * 40 + lkc) = rb[1];
      }
      __syncthreads();
    }
#pragma unroll
    for (int i = 0; i < 4; ++i)
#pragma unroll
      for (int j = 0; j < 4; ++j)
#pragma unroll
        for (int r = 0; r < 4; ++r) {
          const int row = m0 + wm * 64 + i * 16 + (lane >> 4) * 4 + r;
          const int col = n0 + wn * 64 + j * 16 + (lane & 15);
          if (OUT_BF16) ((bf16_t*)Cout)[(size_t)row * N + col] = f2bf(acc[i][j][r]);
          else ((float*)Cout)[(size_t)row * N + col] = acc[i][j][r];
        }
  }
}

__device__ void ph_elem(const Params& p, int l, int bid, int nb) {
  bf16_t* proj = (bf16_t*)p.big;
  const int tid = threadIdx.x;
  const int sub = tid & 127;
  for (int tp = bid; tp < TT / 2; tp += nb) {
    const int t = tp * 2 + (tid >> 7);
    bf16_t* row = proj + (size_t)t * NPROJ;
    if (sub < 64) {
      const int ch = sub * 8;
      bool hasl, hasr;
      if (t < TL) { const int i = t & 63; hasl = i != 0; hasr = i != 63; }
      else { const int i = (t - TL) & 255; hasl = i != 0; hasr = i != 255; }
      const uint4 bg = *(const uint4*)(row + ch);
      const uint4 c1 = *(const uint4*)(row + 512 + ch), h1 = *(const uint4*)(row + 1024 + ch);
      uint4 c0 = make_uint4(0, 0, 0, 0), h0 = c0, c2 = c0, h2 = c0;
      if (hasl) { c0 = *(const uint4*)(row - NPROJ + 512 + ch); h0 = *(const uint4*)(row - NPROJ + 1024 + ch); }
      if (hasr) { c2 = *(const uint4*)(row + NPROJ + 512 + ch); h2 = *(const uint4*)(row + NPROJ + 1024 + ch); }
      const uint32_t bgw[4] = {bg.x, bg.y, bg.z, bg.w};
      const uint32_t c0w[4] = {c0.x, c0.y, c0.z, c0.w}, c1w[4] = {c1.x, c1.y, c1.z, c1.w}, c2w[4] = {c2.x, c2.y, c2.z, c2.w};
      const uint32_t h0w[4] = {h0.x, h0.y, h0.z, h0.w}, h1w[4] = {h1.x, h1.y, h1.z, h1.w}, h2w[4] = {h2.x, h2.y, h2.z, h2.w};
      const float* cw = p.conv_w + ((size_t)l * 512 + ch) * 3;
      uint32_t ow[4];
#pragma unroll
      for (int e = 0; e < 4; ++e) {
        const float z0a = bflo(c0w[e]) * bflo(h0w[e]), z1a = bflo(c1w[e]) * bflo(h1w[e]), z2a = bflo(c2w[e]) * bflo(h2w[e]);
        const float z0b = bfhi(c0w[e]) * bfhi(h0w[e]), z1b = bfhi(c1w[e]) * bfhi(h1w[e]), z2b = bfhi(c2w[e]) * bfhi(h2w[e]);
        const float* wa = cw + (2 * e) * 3;
        const float ya = z0a * wa[0] + z1a * wa[1] + z2a * wa[2];
        const float yb = z0b * wa[3] + z1b * wa[4] + z2b * wa[5];
        ow[e] = pack2(bflo(bgw[e]) * ya, bfhi(bgw[e]) * yb);
      }
      *(uint4*)(p.cat + (size_t)t * DM + ch) = make_uint4(ow[0], ow[1], ow[2], ow[3]);
    } else {
      const int it = sub - 64;
      const int hd = it >> 4, isk = (it >> 3) & 1, half = (it >> 2) & 1, dg = it & 3;
      bf16_t* b1 = row + 1536 + isk * 512 + hd * 128 + half * 64 + dg * 8;
      const uint4 u1 = *(const uint4*)b1, u2 = *(const uint4*)(b1 + 32);
      const uint32_t u1w[4] = {u1.x, u1.y, u1.z, u1.w}, u2w[4] = {u2.x, u2.y, u2.z, u2.w};
      const float scl = isk ? 0.08838834764831845f : 1.f;
      float cs[8], sn[8];
      if (t < TL) {
        const int i = t & 8191;
        const int pos = half ? (i & 63) : (i >> 6);
#pragma unroll
        for (int e = 0; e < 8; ++e) { cs[e] = p.ropec[pos * 32 + dg * 8 + e]; sn[e] = p.ropes[pos * 32 + dg * 8 + e]; }
      } else {
#pragma unroll
        for (int e = 0; e < 8; ++e) { cs[e] = 1.f; sn[e] = 0.f; }
      }
      uint32_t o1[4], o2[4];
#pragma unroll
      for (int e = 0; e < 4; ++e) {
        const float a0 = bflo(u1w[e]), a1 = bfhi(u1w[e]), b0 = bflo(u2w[e]), b1v = bfhi(u2w[e]);
        o1[e] = pack2((a0 * cs[2 * e] - b0 * sn[2 * e]) * scl, (a1 * cs[2 * e + 1] - b1v * sn[2 * e + 1]) * scl);
        o2[e] = pack2((a0 * sn[2 * e] + b0 * cs[2 * e]) * scl, (a1 * sn[2 * e + 1] + b1v * cs[2 * e + 1]) * scl);
      }
      *(uint4*)b1 = make_uint4(o1[0], o1[1], o1[2], o1[3]);
      *(uint4*)(b1 + 32) = make_uint4(o2[0], o2[1], o2[2], o2[3]);
    }
  }
}

__device__ void ph_ret_upd(const Params& p, int bid, int nb, char* smem) {
  const bf16_t* proj = (const bf16_t*)p.big;
  bf16_t* Vs = (bf16_t*)smem;
  bf16_t* Ks = Vs + 64 * 136;
  const int tid = threadIdx.x, lane = tid & 63, wave = tid >> 6;
  const int wm = wave >> 1, wn = wave & 1;
  const unsigned va = tr_lane_base((unsigned)(size_t)Vs, 272u) + wm * 128;
  const unsigned ka = tr_lane_base((unsigned)(size_t)Ks, 272u) + wn * 128;
  for (int item = bid; item < NCHUNK * 4; item += nb) {
    const int c = item >> 2, hd = item & 3;
    const int t0 = c * 128;
    for (int dir = 0; dir < 2; ++dir) {
      const float lg = p.lg2[dir][hd];
      f32x4 acc[4][4];
#pragma unroll
      for (int i = 0; i < 4; ++i)
#pragma unroll
        for (int j = 0; j < 4; ++j) acc[i][j] = zero4();
      for (int half = 0; half < 2; ++half) {
        __syncthreads();
#pragma unroll
        for (int i = 0; i < 4; ++i) {
          const int idx = tid + 256 * i;
          const int r = idx >> 4, ck = (idx & 15) * 8;
          const int s = half * 64 + r;
          const bf16_t* src = proj + (size_t)(t0 + s) * NPROJ + hd * 128 + ck;
          const uint4 vv = *(const uint4*)(src + 2560);
          const uint4 kv = *(const uint4*)(src + 2048);
          const float w = exp2f((dir == 0 ? (float)(127 - s) : (float)s) * lg);
          uint4 ko;
          ko.x = pack2(bflo(kv.x) * w, bfhi(kv.x) * w); ko.y = pack2(bflo(kv.y) * w, bfhi(kv.y) * w);
          ko.z = pack2(bflo(kv.z) * w, bfhi(kv.z) * w); ko.w = pack2(bflo(kv.w) * w, bfhi(kv.w) * w);
          *(uint4*)(Vs + r * 136 + ck) = vv;
          *(uint4*)(Ks + r * 136 + ck) = ko;
        }
        __syncthreads();
        static_for<2>([&](auto KS) {
          constexpr int ks = decltype(KS)::value;
          bf16x8 af[4], bfr[4];
          tr_frag4<ks * 32 * 272 + 0, ks * 32 * 272 + 32, ks * 32 * 272 + 64, ks * 32 * 272 + 96, 4 * 272>(va, af[0], af[1], af[2], af[3]);
          tr_frag4<ks * 32 * 272 + 0, ks * 32 * 272 + 32, ks * 32 * 272 + 64, ks * 32 * 272 + 96, 4 * 272>(ka, bfr[0], bfr[1], bfr[2], bfr[3]);
#pragma unroll
          for (int i = 0; i < 4; ++i)
#pragma unroll
            for (int j = 0; j < 4; ++j) acc[i][j] = __builtin_amdgcn_mfma_f32_16x16x32_bf16(af[i], bfr[j], acc[i][j], 0, 0, 0);
        });
      }
      float* dst = p.st + ((size_t)(dir * NCHUNK + c) * 4 + hd) * 16384;
#pragma unroll
      for (int i = 0; i < 4; ++i)
#pragma unroll
        for (int j = 0; j < 4; ++j)
#pragma unroll
          for (int r = 0; r < 4; ++r) {
            const int row = wm * 64 + i * 16 + (lane >> 4) * 4 + r;
            const int col = wn * 64 + j * 16 + (lane & 15);
            dst[row * 128 + col] = acc[i][j][r];
          }
    }
  }
}

__device__ void ph_ret_scan(const Params& p, int bid, int nb) {
  const int gtid = bid * 256 + threadIdx.x, gn = nb * 256;
  for (int idx = gtid; idx < 2 * 4 * 4 * 16384; idx += gn) {
    const int e = idx & 16383, hd = (idx >> 14) & 3, b = (idx >> 16) & 3, dir = idx >> 18;
    const float dc = exp2f(128.f * p.lg2[dir][hd]);
    const size_t boff = (size_t)dir * NCHUNK * 4 * 16384 + (size_t)hd * 16384 + e;
    const float* src = p.st + boff;
    float* dst = p.ybuf + boff;
    float carry = 0.f;
    if (dir == 0) {
      for (int n = 0; n < 2; ++n) {
        const size_t o = (size_t)(256 + b * 2 + n) * 4 * 16384;
        const float u = src[o]; dst[o] = carry; carry = carry * dc + u;
      }
      for (int n = 0; n < 64; ++n) {
        const size_t o = (size_t)(b * 64 + n) * 4 * 16384;
        const float u = src[o]; dst[o] = carry; carry = carry * dc + u;
      }
    } else {
      for (int n = 1; n >= 0; --n) {
        const size_t o = (size_t)(256 + b * 2 + n) * 4 * 16384;
        const float u = src[o]; dst[o] = carry; carry = carry * dc + u;
      }
      for (int n = 63; n >= 0; --n) {
        const size_t o = (size_t)(b * 64 + n) * 4 * 16384;
        const float u = src[o]; dst[o] = carry; carry = carry * dc + u;
      }
    }
  }
}

__device__ void ph_ret_out(const Params& p, int bid, int nb, char* smem) {
  const bf16_t* proj = (const bf16_t*)p.big;
  bf16_t* buf = (bf16_t*)smem;
  bf16_t* Pb = buf + 128 * 136;
  const unsigned ba = tr_lane_base((unsigned)(size_t)buf, 272u);
  const int tid = threadIdx.x, lane = tid & 63, wave = tid >> 6;
  const int g = lane >> 4, l15 = lane & 15;
  bf16_t* Pw = Pb + wave * 16 * 136;
  for (int item = bid; item < NCHUNK * 8; item += nb) {
    const int c = item >> 3, hd = (item >> 1) & 3, rh = item & 1;
    const int t0 = c * 128;
    const int rw = rh * 64 + wave * 16;
    const float lgf = p.lg2[0][hd], lgb = p.lg2[1][hd];
    bf16x8 qf[4];
#pragma unroll
    for (int ks = 0; ks < 4; ++ks)
      qf[ks] = *(const bf16x8*)(proj + (size_t)(t0 + rw + l15) * NPROJ + 1536 + hd * 128 + ks * 32 + g * 8);
    f32x4 acc[8];
    if (!(DBG_RO & 4)) {
    __syncthreads();
#pragma unroll
    for (int i = 0; i < 8; ++i) {
      const int idx = tid + 256 * i; const int r = idx >> 4, ck = (idx & 15) * 8;
      *(uint4*)(buf + r * 136 + ck) = *(const uint4*)(proj + (size_t)(t0 + r) * NPROJ + 2048 + hd * 128 + ck);
    }
    __syncthreads();
#pragma unroll
    for (int nt = 0; nt < 8; ++nt) acc[nt] = zero4();
#pragma unroll
    for (int ks = 0; ks < 4; ++ks) {
#pragma unroll
      for (int nt = 0; nt < 8; ++nt) {
        const bf16x8 bfr = *(const bf16x8*)(buf + (nt * 16 + l15) * 136 + ks * 32 + g * 8);
        acc[nt] = __builtin_amdgcn_mfma_f32_16x16x32_bf16(qf[ks], bfr, acc[nt], 0, 0, 0);
      }
    }
#pragma unroll
    for (int nt = 0; nt < 8; ++nt)
#pragma unroll
      for (int r = 0; r < 4; ++r) {
        const int tl = g * 4 + r;
        const int t = rw + tl, s = nt * 16 + l15;
        const float d = (s <= t) ? exp2f((float)(t - s) * lgf) : exp2f((float)(s - t) * lgb);
        Pw[tl * 136 + s] = f2bf(acc[nt][r] * d);
      }
    __syncthreads();
#pragma unroll
    for (int i = 0; i < 8; ++i) {
      const int idx = tid + 256 * i; const int r = idx >> 4, ck = (idx & 15) * 8;
      *(uint4*)(buf + r * 136 + ck) = *(const uint4*)(proj + (size_t)(t0 + r) * NPROJ + 2560 + hd * 128 + ck);
    }
    __syncthreads();
    }
    f32x4 o[8];
#pragma unroll
    for (int nt = 0; nt < 8; ++nt) o[nt] = zero4();
    if (!(DBG_RO & 1)) static_for<4>([&](auto KS) {
      constexpr int ks = decltype(KS)::value;
      const bf16x8 pf = *(const bf16x8*)(Pw + l15 * 136 + ks * 32 + g * 8);
      static_for<2>([&](auto NH) {
        constexpr int nh = decltype(NH)::value;
        bf16x8 bfr[4];
        tr_frag4<ks * 32 * 272 + nh * 128 + 0, ks * 32 * 272 + nh * 128 + 32, ks * 32 * 272 + nh * 128 + 64, ks * 32 * 272 + nh * 128 + 96, 4 * 272>(
            ba, bfr[0], bfr[1], bfr[2], bfr[3]);
#pragma unroll
        for (int j = 0; j < 4; ++j) o[nh * 4 + j] = __builtin_amdgcn_mfma_f32_16x16x32_bf16(pf, bfr[j], o[nh * 4 + j], 0, 0, 0);
      });
    });
    if (!(DBG_RO & 2)) for (int dir = 0; dir < 2; ++dir) {
      __syncthreads();
      const float* ssrc = p.ybuf + ((size_t)(dir * NCHUNK + c) * 4 + hd) * 16384;
#pragma unroll
      for (int i = 0; i < 16; ++i) {
        const int idx = tid + 256 * i; const int r = idx >> 5, c4 = (idx & 31) * 4;
        const float4 v = *(const float4*)(ssrc + r * 128 + c4);
        uint2 w; w.x = pack2(v.x, v.y); w.y = pack2(v.z, v.w);
        *(uint2*)(buf + r * 136 + c4) = w;
      }
      __syncthreads();
      float fr[4];
#pragma unroll
      for (int r = 0; r < 4; ++r) {
        const int t = rw + g * 4 + r;
        fr[r] = (dir == 0) ? exp2f((float)(t + 1) * lgf) : exp2f((float)(128 - t) * lgb);
      }
#pragma unroll
      for (int nt = 0; nt < 8; ++nt) acc[nt] = zero4();
      __builtin_amdgcn_sched_barrier(0);
#pragma unroll
      for (int ks = 0; ks < 4; ++ks) {
#pragma unroll
        for (int nt = 0; nt < 8; ++nt) {
          const bf16x8 bfr = *(const bf16x8*)(buf + (nt * 16 + l15) * 136 + ks * 32 + g * 8);
          acc[nt] = __builtin_amdgcn_mfma_f32_16x16x32_bf16(qf[ks], bfr, acc[nt], 0, 0, 0);
        }
      }
      __builtin_amdgcn_sched_barrier(0);
      asm volatile("s_nop 15\n\ts_nop 15\n\ts_nop 15\n\ts_nop 15" ::: "memory");
      __builtin_amdgcn_sched_barrier(0);
#pragma unroll
      for (int r = 0; r < 4; ++r) {
#pragma unroll
        for (int nt = 0; nt < 8; ++nt) o[nt][r] += fr[r] * acc[nt][r];
      }
    }
#pragma unroll
    for (int r = 0; r < 4; ++r) {
      const int t = t0 + rw + g * 4 + r;
#pragma unroll
      for (int nt = 0; nt < 8; ++nt) p.cat[(size_t)t * DM + 512 + hd * 128 + nt * 16 + l15] = f2bf(o[nt][r]);
    }
  }
}

__device__ void ph_gnorm(const Params& p, int bid, int nb) {
  const bf16_t* proj = (const bf16_t*)p.big;
  const int lane = threadIdx.x & 63;
  const int gw = bid * 4 + (threadIdx.x >> 6), nw = nb * 4;
  for (int t = gw; t < TT; t += nw) {
    bf16_t* op = p.cat + (size_t)t * DM + 512 + lane * 8;
    const uint4 ov = *(const uint4*)op;
    const uint4 gv = *(const uint4*)(proj + (size_t)t * NPROJ + 3072 + lane * 8);
    float o[8], gg[8];
    o[0] = bflo(ov.x); o[1] = bfhi(ov.x); o[2] = bflo(ov.y); o[3] = bfhi(ov.y);
    o[4] = bflo(ov.z); o[5] = bfhi(ov.z); o[6] = bflo(ov.w); o[7] = bfhi(ov.w);
    gg[0] = bflo(gv.x); gg[1] = bfhi(gv.x); gg[2] = bflo(gv.y); gg[3] = bfhi(gv.y);
    gg[4] = bflo(gv.z); gg[5] = bfhi(gv.z); gg[6] = bflo(gv.w); gg[7] = bfhi(gv.w);
    float s1 = 0.f;
#pragma unroll
    for (int i = 0; i < 8; ++i) s1 += o[i];
    s1 = row16_sum(s1);
    const float mu = s1 * (1.f / 128.f);
    float s2 = 0.f;
#pragma unroll
    for (int i = 0; i < 8; ++i) { const float d = o[i] - mu; s2 += d * d; }
    s2 = row16_sum(s2);
    const float rs = rsqrtf(s2 * (1.f / 128.f) + 1e-5f);
    float y[8];
#pragma unroll
    for (int i = 0; i < 8; ++i) y[i] = silu_f(gg[i]) * (o[i] - mu) * rs;
    *(uint4*)op = make_uint4(pack2(y[0], y[1]), pack2(y[2], y[3]), pack2(y[4], y[5]), pack2(y[6], y[7]));
  }
}

__device__ void ph_ln(const Params& p, int l, int which, int bid, int nb) {
  const int lane = threadIdx.x & 63;
  const int gw = bid * 4 + (threadIdx.x >> 6), nw = nb * 4;
  const float* lg = (which == 1 ? p.ln1_g : p.ln2_g) + (size_t)l * DM;
  const float* lb = (which == 1 ? p.ln1_b : p.ln2_b) + (size_t)l * DM;
  const bool last = (l == NLAYER - 1);
  for (int t = gw; t < TT; t += nw) {
    const float* xr;
    if (l == 0 && which == 1) xr = t < TL ? p.x + (size_t)t * DM : p.ctx + (size_t)(t - TL) * DM;
    else xr = p.xres + (size_t)t * DM;
    const float* yr = p.ybuf + (size_t)t * DM;
    const float* m = p.mod + (size_t)(l * 5 + mod_row(t)) * 6144;
    const float* mg = m + (which == 1 ? 2048 : 5120);
    float v[16];
    float s1 = 0.f;
#pragma unroll
    for (int i = 0; i < 4; ++i) {
      const int col = lane * 4 + 256 * i;
      const float4 xv = *(const float4*)(xr + col);
      const float4 yv = *(const float4*)(yr + col);
      const float4 gv = *(const float4*)(mg + col);
      v[4 * i + 0] = ALPHA_F * xv.x + gv.x * yv.x; v[4 * i + 1] = ALPHA_F * xv.y + gv.y * yv.y;
      v[4 * i + 2] = ALPHA_F * xv.z + gv.z * yv.z; v[4 * i + 3] = ALPHA_F * xv.w + gv.w * yv.w;
      s1 += v[4 * i + 0] + v[4 * i + 1] + v[4 * i + 2] + v[4 * i + 3];
    }
    const float mu = wave_sum(s1) * (1.f / 1024.f);
    float s2 = 0.f;
#pragma unroll
    for (int i = 0; i < 16; ++i) { const float d = v[i] - mu; s2 += d * d; }
    const float rs = rsqrtf(wave_sum(s2) * (1.f / 1024.f) + 1e-5f);
    const float* msh; const float* msc;
    if (which == 1) { msh = m + 3072; msc = m + 4096; }
    else { const float* m2 = p.mod + (size_t)((last ? l : l + 1) * 5 + mod_row(t)) * 6144; msh = m2; msc = m2 + 1024; }
#pragma unroll
    for (int i = 0; i < 4; ++i) {
      const int col = lane * 4 + 256 * i;
      const float4 gg = *(const float4*)(lg + col);
      const float4 bb = *(const float4*)(lb + col);
      float4 o;
      o.x = (v[4 * i + 0] - mu) * rs * gg.x + bb.x; o.y = (v[4 * i + 1] - mu) * rs * gg.y + bb.y;
      o.z = (v[4 * i + 2] - mu) * rs * gg.z + bb.z; o.w = (v[4 * i + 3] - mu) * rs * gg.w + bb.w;
      *(float4*)(p.xres + (size_t)t * DM + col) = o;
      if (which == 2 && last && t < TL) *(float4*)(p.out + (size_t)t * DM + col) = o;
      const float4 sh = *(const float4*)(msh + col);
      const float4 sc = *(const float4*)(msc + col);
      uint2 h;
      h.x = pack2(o.x * (1.f + sc.x) + sh.x, o.y * (1.f + sc.y) + sh.y);
      h.y = pack2(o.z * (1.f + sc.z) + sh.z, o.w * (1.f + sc.w) + sh.w);
      *(uint2*)(p.hA + (size_t)t * DM + col) = h;
    }
  }
}

#define TK_INSERT(V, I, xv, xi)                                        \
  if ((xv) > V[15]) {                                                  \
    V[15] = (xv); I[15] = (xi);                                        \
    _Pragma("unroll") for (int q_ = 15; q_ > 0; --q_) {                \
      const bool sw_ = V[q_] > V[q_ - 1];                              \
      const float tv_ = V[q_]; const int ti_ = I[q_];                  \
      V[q_] = sw_ ? V[q_ - 1] : tv_; I[q_] = sw_ ? I[q_ - 1] : ti_;    \
      V[q_ - 1] = sw_ ? tv_ : V[q_ - 1]; I[q_ - 1] = sw_ ? ti_ : I[q_ - 1]; \
    }                                                                  \
  }

__device__ void ph_topk1(const Params& p, int bid, int nb) {
  const float* scores = (const float*)p.big;
  const int gtid = bid * 256 + threadIdx.x, gn = nb * 256;
  for (int idx = gtid; idx < TT * 16; idx += gn) {
    const float* row = scores + (size_t)idx * 128;
    float V[16]; int I[16];
#pragma unroll
    for (int i = 0; i < 16; ++i) { V[i] = -3.0e38f; I[i] = 0; }
    for (int i4 = 0; i4 < 32; ++i4) {
      const float4 x = *(const float4*)(row + i4 * 4);
      TK_INSERT(V, I, x.x, i4 * 4 + 0)
      TK_INSERT(V, I, x.y, i4 * 4 + 1)
      TK_INSERT(V, I, x.z, i4 * 4 + 2)
      TK_INSERT(V, I, x.w, i4 * 4 + 3)
    }
    float4* dv = (float4*)(p.sv + (size_t)idx * 16);
    dv[0] = make_float4(V[0], V[1], V[2], V[3]); dv[1] = make_float4(V[4], V[5], V[6], V[7]);
    dv[2] = make_float4(V[8], V[9], V[10], V[11]); dv[3] = make_float4(V[12], V[13], V[14], V[15]);
    uint4 di;
    di.x = I[0] | (I[1] << 8) | (I[2] << 16) | (I[3] << 24);
    di.y = I[4] | (I[5] << 8) | (I[6] << 16) | (I[7] << 24);
    di.z = I[8] | (I[9] << 8) | (I[10] << 16) | (I[11] << 24);
    di.w = I[12] | (I[13] << 8) | (I[14] << 16) | (I[15] << 24);
    *(uint4*)(p.si + (size_t)idx * 16) = di;
  }
}

__device__ void ph_topk2(const Params& p, int bid, int nb) {
  const int gtid = bid * 256 + threadIdx.x, gn = nb * 256;
  for (int idx = gtid; idx < TT * 8; idx += gn) {
    float a[16], b[16]; int ia[16], ib[16];
    {
      const float4* pa = (const float4*)(p.sv + (size_t)idx * 32);
#pragma unroll
      for (int i = 0; i < 4; ++i) { const float4 v = pa[i]; a[4 * i] = v.x; a[4 * i + 1] = v.y; a[4 * i + 2] = v.z; a[4 * i + 3] = v.w; }
#pragma unroll
      for (int i = 0; i < 4; ++i) { const float4 v = pa[4 + i]; b[4 * i] = v.x; b[4 * i + 1] = v.y; b[4 * i + 2] = v.z; b[4 * i + 3] = v.w; }
      const uint4 qa = *(const uint4*)(p.si + (size_t)idx * 32), qb = *(const uint4*)(p.si + (size_t)idx * 32 + 16);
      const uint32_t wa[4] = {qa.x, qa.y, qa.z, qa.w}, wb[4] = {qb.x, qb.y, qb.z, qb.w};
#pragma unroll
      for (int i = 0; i < 16; ++i) { ia[i] = (wa[i >> 2] >> (8 * (i & 3))) & 255; ib[i] = (wb[i >> 2] >> (8 * (i & 3))) & 255; }
    }
    float V[16]; int I[16];
#pragma unroll
    for (int i = 0; i < 16; ++i) { V[i] = -3.0e38f; I[i] = 0; }
#pragma unroll
    for (int i = 0; i < 16; ++i) {
#pragma unroll
      for (int j = 0; j < 16; ++j) {
        if ((i + 1) * (j + 1) <= 16) {
          const float cv = a[i] + b[j];
          const int ce = ia[i] * 128 + ib[j];
          TK_INSERT(V, I, cv, ce)
        }
      }
    }
    float e[16], sum = 0.f;
#pragma unroll
    for (int i = 0; i < 16; ++i) { e[i] = __expf(V[i] - V[0]); sum += e[i]; }
    const float inv = 1.f / sum;
    int4* de = (int4*)(p.pe + (size_t)idx * 16);
    float4* dg = (float4*)(p.pg + (size_t)idx * 16);
#pragma unroll
    for (int i = 0; i < 4; ++i) {
      de[i] = make_int4(I[4 * i], I[4 * i + 1], I[4 * i + 2], I[4 * i + 3]);
      dg[i] = make_float4(e[4 * i] * inv, e[4 * i + 1] * inv, e[4 * i + 2] * inv, e[4 * i + 3] * inv);
    }
  }
}

__device__ void ph_gather(const Params& p, int bid, int nb) {
  const int lane = threadIdx.x & 63;
  const int gw = bid * 4 + (threadIdx.x >> 6), nw = nb * 4;
  for (int t = gw; t < TT; t += nw) {
    const bf16_t* hrow = p.hA + (size_t)t * DM;
    const uint4 h0 = *(const uint4*)(hrow + lane * 8), h1 = *(const uint4*)(hrow + 512 + lane * 8);
    float hf[16];
    hf[0] = bflo(h0.x); hf[1] = bfhi(h0.x); hf[2] = bflo(h0.y); hf[3] = bfhi(h0.y);
    hf[4] = bflo(h0.z); hf[5] = bfhi(h0.z); hf[6] = bflo(h0.w); hf[7] = bfhi(h0.w);
    hf[8] = bflo(h1.x); hf[9] = bfhi(h1.x); hf[10] = bflo(h1.y); hf[11] = bfhi(h1.y);
    hf[12] = bflo(h1.z); hf[13] = bfhi(h1.z); hf[14] = bflo(h1.w); hf[15] = bfhi(h1.w);
    float acc[16];
#pragma unroll
    for (int i = 0; i < 16; ++i) acc[i] = 0.f;
    const int e_lo = p.pe[(size_t)t * 128 + lane], e_hi = p.pe[(size_t)t * 128 + 64 + lane];
    const float g_lo = p.pg[(size_t)t * 128 + lane], g_hi = p.pg[(size_t)t * 128 + 64 + lane];
    for (int kb = 0; kb < 128; kb += 4) {
      int e[4]; float gt[4];
      uint4 ua[4], ub[4], va[4], vb[4];
#pragma unroll
      for (int u = 0; u < 4; ++u) {
        const int k = kb + u;
        e[u] = __shfl(k < 64 ? e_lo : e_hi, k & 63);
        gt[u] = __shfl(k < 64 ? g_lo : g_hi, k & 63);
        const bf16_t* ur = p.ubf + (size_t)e[u] * DM;
        const bf16_t* vr = p.vbf + (size_t)e[u] * DM;
        ua[u] = *(const uint4*)(ur + lane * 8); ub[u] = *(const uint4*)(ur + 512 + lane * 8);
        va[u] = *(const uint4*)(vr + lane * 8); vb[u] = *(const uint4*)(vr + 512 + lane * 8);
      }
#pragma unroll
      for (int u = 0; u < 4; ++u) {
        float d = bflo(ua[u].x) * hf[0] + bfhi(ua[u].x) * hf[1] + bflo(ua[u].y) * hf[2] + bfhi(ua[u].y) * hf[3]
                + bflo(ua[u].z) * hf[4] + bfhi(ua[u].z) * hf[5] + bflo(ua[u].w) * hf[6] + bfhi(ua[u].w) * hf[7]
                + bflo(ub[u].x) * hf[8] + bfhi(ub[u].x) * hf[9] + bflo(ub[u].y) * hf[10] + bfhi(ub[u].y) * hf[11]
                + bflo(ub[u].z) * hf[12] + bfhi(ub[u].z) * hf[13] + bflo(ub[u].w) * hf[14] + bfhi(ub[u].w) * hf[15];
        d = wave_sum(d);
        const float a = gt[u] * 0.5f * d * (1.f + erff(d * 0.7071067811865476f));
        acc[0] += a * bflo(va[u].x); acc[1] += a * bfhi(va[u].x); acc[2] += a * bflo(va[u].y); acc[3] += a * bfhi(va[u].y);
        acc[4] += a * bflo(va[u].z); acc[5] += a * bfhi(va[u].z); acc[6] += a * bflo(va[u].w); acc[7] += a * bfhi(va[u].w);
        acc[8] += a * bflo(vb[u].x); acc[9] += a * bfhi(vb[u].x); acc[10] += a * bflo(vb[u].y); acc[11] += a * bfhi(vb[u].y);
        acc[12] += a * bflo(vb[u].z); acc[13] += a * bfhi(vb[u].z); acc[14] += a * bflo(vb[u].w); acc[15] += a * bfhi(vb[u].w);
      }
    }
    float* fr = p.ybuf + (size_t)t * DM;
    *(float4*)(fr + lane * 8) = make_float4(acc[0], acc[1], acc[2], acc[3]);
    *(float4*)(fr + lane * 8 + 4) = make_float4(acc[4], acc[5], acc[6], acc[7]);
    *(float4*)(fr + 512 + lane * 8) = make_float4(acc[8], acc[9], acc[10], acc[11]);
    *(float4*)(fr + 512 + lane * 8 + 4) = make_float4(acc[12], acc[13], acc[14], acc[15]);
  }
}

enum { PH_PRE_A = 0, PH_PRE_B, PH_INIT, PH_GEMM_IN, PH_ELEM, PH_RET_UPD, PH_RET_SCAN, PH_RET_OUT, PH_GEMM_OUT, PH_LN1,
       PH_GEMM_WK, PH_TOPK1, PH_TOPK2, PH_GATHER, PH_LN2, PH_GNORM };

__device__ __forceinline__ void run_phase(const Params& p, int ph, int l, int bid, int nb, char* smem) {
  switch (ph) {
    case PH_PRE_A:
      ph_mod_partial(p, bid, nb, smem);
      for (int ll = 0; ll < NLAYER; ++ll) {
        ph_transpose_cvt(p.w_in + (size_t)ll * DM * NPROJ, p.w_inT + (size_t)ll * NPROJ * DM, DM, NPROJ, bid, nb, smem);
        ph_transpose_cvt(p.w_out + (size_t)ll * DM * DM, p.w_outT + (size_t)ll * DM * DM, DM, DM, bid, nb, smem);
      }
      ph_wk_fold(p, bid, nb, smem);
      break;
    case PH_PRE_B: ph_mod_reduce(p, bid, nb); break;
    case PH_INIT: ph_init_h(p, bid, nb); break;
    case PH_GEMM_IN:
      ph_gemm<true>(p.hA, p.w_inT + (size_t)l * NPROJ * DM, p.big, TT, NPROJ, DM, bid, nb, smem);
      ph_cvt_uv(p, l, bid, nb);
      break;
    case PH_ELEM: ph_elem(p, l, bid, nb); break;
    case PH_RET_UPD: ph_ret_upd(p, bid, nb, smem); break;
    case PH_RET_SCAN: ph_ret_scan(p, bid, nb); break;
    case PH_RET_OUT: ph_ret_out(p, bid, nb, smem); break;
    case PH_GEMM_OUT: ph_gemm<false>(p.cat, p.w_outT + (size_t)l * DM * DM, p.ybuf, TT, DM, DM, bid, nb, smem); break;
    case PH_LN1: ph_ln(p, l, 1, bid, nb); break;
    case PH_GEMM_WK: ph_gemm<false>(p.hA, p.wkT + (size_t)l * 2048 * DM, p.big, TT, 2048, DM, bid, nb, smem); break;
    case PH_TOPK1: ph_topk1(p, bid, nb); break;
    case PH_TOPK2: ph_topk2(p, bid, nb); break;
    case PH_GATHER: ph_gather(p, bid, nb); break;
    case PH_LN2: ph_ln(p, l, 2, bid, nb); break;
    case PH_GNORM: ph_gnorm(p, bid, nb); break;
  }
}

extern __shared__ __attribute__((aligned(16))) char dyn_smem[];

template <int PH>
__global__ void __launch_bounds__(256, 2) k_phase(Params p, int l) {
  run_phase(p, PH, l, blockIdx.x, gridDim.x, dyn_smem);
}

__global__ void k_dump_bf16(const bf16_t* src, float* out, size_t n) {
  for (size_t i = (size_t)blockIdx.x * 256 + threadIdx.x; i < n; i += (size_t)gridDim.x * 256) out[i] = bf2f(src[i]);
}
__global__ void k_dump_cols(const bf16_t* src, int ld, int col0, float* out, size_t n) {
  for (size_t i = (size_t)blockIdx.x * 256 + threadIdx.x; i < n; i += (size_t)gridDim.x * 256) out[i] = bf2f(src[(i >> 10) * ld + col0 + (i & 1023)]);
}
__global__ void k_dump_hash(const uint32_t* src, size_t nwords, float* out, size_t nout, float scale) {
  __shared__ uint32_t red[256];
  const size_t L = (nwords + 1023) / 1024;
  const size_t b0 = (size_t)blockIdx.x * L;
  uint32_t h = 0;
  for (size_t i = threadIdx.x; i < L; i += 256) {
    const size_t j = b0 + i;
    if (j < nwords) h += (src[j] ^ 0x9e3779b9u) * (uint32_t)(2654435761u * (uint32_t)(i + 1) + 12345u);
  }
  red[threadIdx.x] = h;
  __syncthreads();
  for (int o = 128; o > 0; o >>= 1) { if ((int)threadIdx.x < o) red[threadIdx.x] += red[threadIdx.x + o]; __syncthreads(); }
  uint32_t hh = red[0];
  hh ^= hh >> 16; hh *= 0x85ebca6bu; hh ^= hh >> 13;
  const float v = scale * (float)(1u + (hh & 255u));
  const size_t per = nout / 1024;
  for (size_t i = threadIdx.x; i < per; i += 256) out[(size_t)blockIdx.x * per + i] = v;
}
__global__ void k_fill(float* out, size_t n, float v) {
  for (size_t i = (size_t)blockIdx.x * 256 + threadIdx.x; i < n; i += (size_t)gridDim.x * 256) out[i] = v;
}
__global__ void k_dump_f32(const float* src, float* out, size_t n) {
  for (size_t i = (size_t)blockIdx.x * 256 + threadIdx.x; i < n; i += (size_t)gridDim.x * 256) out[i] = src[i];
}
static inline size_t al256(size_t v) { return (v + 255) & ~(size_t)255; }

extern "C" void kernel_launch(void* const* d_in, const int* in_sizes, int n_in, void* d_out, int out_size, void* d_ws,
                              size_t ws_size, hipStream_t stream) {
  static int grid = 0;
  if (grid == 0) {
    int dev = 0, cus = 0, per_cu = 0;
    (void)hipGetDevice(&dev);
    (void)hipDeviceGetAttribute(&cus, hipDeviceAttributeMultiprocessorCount, dev);
#define SETATTR(PH) (void)hipFuncSetAttribute((const void*)k_phase<PH>, hipFuncAttributeMaxDynamicSharedMemorySize, SMEM_BYTES);
    SETATTR(0) SETATTR(1) SETATTR(2) SETATTR(3) SETATTR(4) SETATTR(5) SETATTR(6) SETATTR(7) SETATTR(8) SETATTR(9)
    SETATTR(10) SETATTR(11) SETATTR(12) SETATTR(13) SETATTR(14) SETATTR(15)
    (void)per_cu;
    if (cus <= 0) cus = 256;
    grid = cus * 2;
  }
  Params p{};
  p.x = (const float*)d_in[0]; p.c = (const float*)d_in[1]; p.ctx = (const float*)d_in[2]; p.c_ctx = (const float*)d_in[3];
  p.w_mod = (const float*)d_in[4]; p.b_mod = (const float*)d_in[5]; p.w_in = (const float*)d_in[6]; p.conv_w = (const float*)d_in[7];
  p.w_out = (const float*)d_in[8]; p.ln1_g = (const float*)d_in[9]; p.ln1_b = (const float*)d_in[10]; p.peer_wq = (const float*)d_in[11];
  p.peer_keys = (const float*)d_in[12]; p.peer_u = (const float*)d_in[13]; p.peer_v = (const float*)d_in[14];
  p.ln2_g = (const float*)d_in[15]; p.ln2_b = (const float*)d_in[16];
  p.out = (float*)d_out;
  char* w = (char*)d_ws; size_t off = 0;
  auto take = [&](size_t bytes) { char* r = w + off; off = al256(off + bytes); return r; };
  p.xres = (float*)take((size_t)TT * DM * 4);
  p.hA = (bf16_t*)take((size_t)TT * DM * 2);
  p.big = take((size_t)TT * 2048 * 4);
  p.cat = (bf16_t*)take((size_t)TT * DM * 2);
  p.st = (float*)take((size_t)2 * NCHUNK * 4 * 16384 * 4);
  p.ybuf = (float*)take((size_t)TT * DM * 4);
  p.w_inT = (bf16_t*)take((size_t)NLAYER * NPROJ * DM * 2);
  p.w_outT = (bf16_t*)take((size_t)NLAYER * DM * DM * 2);
  p.wkT = (bf16_t*)take((size_t)NLAYER * 2048 * DM * 2);
  p.ubf = (bf16_t*)take((size_t)NEXP * DM * 2);
  p.vbf = (bf16_t*)take((size_t)NEXP * DM * 2);
  p.mod = (float*)take((size_t)4 * 5 * 6144 * 4);
  p.modp = (float*)take((size_t)8 * 4 * 5 * 6144 * 4);
  p.ropec = (float*)take(128 * 32 * 4);
  p.ropes = (float*)take(128 * 32 * 4);
  p.bar = (unsigned*)take(256);
  p.pad0 = nullptr;
  {
    char* a = (char*)p.st; size_t o2 = 0;
    p.sv = (float*)(a + o2); o2 = al256(o2 + (size_t)TT * 256 * 4);
    p.si = (unsigned char*)(a + o2); o2 = al256(o2 + (size_t)TT * 256);
    p.pe = (int*)(a + o2); o2 = al256(o2 + (size_t)TT * 128 * 4);
    p.pg = (float*)(a + o2); o2 = al256(o2 + (size_t)TT * 128 * 4);
  }
  for (int d = 0; d < 2; ++d)
    for (int h = 0; h < 4; ++h) p.lg2[d][h] = (float)log2(1.0 - exp2(-(5.0 + 0.5 * d + (double)h)));
  if (off > ws_size) { fprintf(stderr, "kernel_launch: workspace too small: need %zu have %zu\n", off, ws_size); return; }

#define launch(PH, L) hipLaunchKernelGGL(k_phase<PH>, dim3(grid), dim3(256), SMEM_BYTES, stream, p, (int)(L))
  const size_t HR = ((size_t)TL * DM / 8) & ~(size_t)1023;
#define HASH(K, PTR, BYTES) if (DBG_STOP == 20) hipLaunchKernelGGL(k_dump_hash, dim3(1024), dim3(256), 0, stream, (const uint32_t*)(PTR), (size_t)(BYTES) / 4, p.out + (size_t)(K) * HR, HR, ((DBG_HMASK >> (K)) & 1) ? 1.0f : 0.0f)
  if (DBG_STOP == 20) hipLaunchKernelGGL(k_fill, dim3(1024), dim3(256), 0, stream, p.out, (size_t)TL * DM, 0.f);
  launch(PH_PRE_A, 0);
  launch(PH_PRE_B, 0);
  launch(PH_INIT, 0);
  HASH(0, p.hA, (size_t)TT * DM * 2);
  HASH(1, p.w_inT, (size_t)NPROJ * DM * 2);
  for (int l = 0; l < NLAYER; ++l) {
    launch(PH_GEMM_IN, l);
    if (l == 0) HASH(2, p.big, (size_t)TT * NPROJ * 2);
    if (DBG_STOP == 6) { hipLaunchKernelGGL(k_dump_bf16, dim3(1024), dim3(256), 0, stream, (const bf16_t*)p.big, p.out, (size_t)TL * DM); return; }
    launch(PH_ELEM, l);
    if (l == 0) HASH(3, p.big, (size_t)TT * NPROJ * 2);
    if (DBG_STOP == 12) { hipLaunchKernelGGL(k_dump_cols, dim3(1024), dim3(256), 0, stream, (const bf16_t*)p.big, NPROJ, 1536, p.out, (size_t)TL * DM); return; }
    if (DBG_STOP == 13) { hipLaunchKernelGGL(k_dump_cols, dim3(1024), dim3(256), 0, stream, (const bf16_t*)p.big, NPROJ, 2560, p.out, (size_t)TL * DM); return; }
    if (DBG_STOP == 7) { hipLaunchKernelGGL(k_dump_bf16, dim3(1024), dim3(256), 0, stream, (const bf16_t*)p.big, p.out, (size_t)TL * DM); return; }
    launch(PH_RET_UPD, l);
    if (l == 0) HASH(4, p.st, (size_t)2 * NCHUNK * 4 * 16384 * 4);
    if (DBG_STOP == 8) { hipLaunchKernelGGL(k_dump_f32, dim3(1024), dim3(256), 0, stream, p.st, p.out, (size_t)TL * DM); return; }
    launch(PH_RET_SCAN, l);
    if (l == 0) HASH(5, p.ybuf, (size_t)2 * NCHUNK * 4 * 16384 * 4);
    if (DBG_STOP == 10) { hipLaunchKernelGGL(k_dump_f32, dim3(1024), dim3(256), 0, stream, p.st + (size_t)NCHUNK * 4 * 16384, p.out, (size_t)TL * DM); return; }
    if (DBG_STOP == 11) { hipLaunchKernelGGL(k_dump_f32, dim3(1024), dim3(256), 0, stream, p.st + (size_t)200 * 4 * 16384, p.out, (size_t)TL * DM); return; }
    if (DBG_STOP == 9) { hipLaunchKernelGGL(k_dump_f32, dim3(1024), dim3(256), 0, stream, p.st, p.out, (size_t)TL * DM); return; }
    launch(PH_RET_OUT, l);
    launch(PH_GNORM, l);
    if (l == 0) HASH(6, p.cat, (size_t)TT * DM * 2);
    if (DBG_STOP == 20) return;
    if (DBG_STOP == 1) { hipLaunchKernelGGL(k_dump_bf16, dim3(1024), dim3(256), 0, stream, p.cat, p.out, (size_t)TL * DM); return; }
    launch(PH_GEMM_OUT, l);
    launch(PH_LN1, l);
    if (DBG_STOP == 2) { hipLaunchKernelGGL(k_dump_f32, dim3(1024), dim3(256), 0, stream, p.xres, p.out, (size_t)TL * DM); return; }
    launch(PH_GEMM_WK, l);
    launch(PH_TOPK1, l);
    launch(PH_TOPK2, l);
    launch(PH_GATHER, l);
    if (DBG_STOP == 3) { hipLaunchKernelGGL(k_dump_f32, dim3(1024), dim3(256), 0, stream, p.ybuf, p.out, (size_t)TL * DM); return; }
    launch(PH_LN2, l);
    if (DBG_STOP == 4) { hipLaunchKernelGGL(k_dump_f32, dim3(1024), dim3(256), 0, stream, p.xres, p.out, (size_t)TL * DM); return; }
  }
}
```

```cpp
#include <hip/hip_runtime.h>
#include <hip/hip_cooperative_groups.h>
#include <stdint.h>
#include <math.h>
#include <stdio.h>
#include <utility>
#include <type_traits>

namespace cg = cooperative_groups;

typedef unsigned short bf16_t;
using bf16x8 = __attribute__((ext_vector_type(8))) short;
using s16x4 = __attribute__((ext_vector_type(4))) short;
using f32x4 = __attribute__((ext_vector_type(4))) float;

#define DM 1024
#define NB 4
#define SEQ 8192
#define TL 32768
#define TC 1024
#define TT 33792
#define NCHUNK 264
#define NPROJ 3584
#define NLAYER 4
#define NEXP 16384
#define ALPHA_F 1.681792830507429f
#define SMEM_BYTES 53248
#ifndef MEGA
#define MEGA 1
#endif
#ifndef DBG_HMASK
#define DBG_HMASK 0x40
#endif
#ifndef DBG_RO
#define DBG_RO 0
#endif
#ifndef DBG_STOP
#define DBG_STOP 0
#endif

struct Params {
  const float *x, *c, *ctx, *c_ctx, *w_mod, *b_mod, *w_in, *conv_w, *w_out, *ln1_g, *ln1_b;
  const float *peer_wq, *peer_keys, *peer_u, *peer_v, *ln2_g, *ln2_b;
  float* out;
  float* xres; bf16_t* hA; char* big; bf16_t* cat; float* st; float* ybuf;
  bf16_t *w_inT, *w_outT, *wkT, *ubf, *vbf;
  float* sv; unsigned char* si; int* pe; float* pg;
  float *mod, *modp, *ropec, *ropes;
  unsigned* bar; unsigned* pad0;
  float lg2[2][4];
};

__device__ __forceinline__ bf16_t f2bf(float f) {
  uint32_t u = __float_as_uint(f);
  u += 0x7fffu + ((u >> 16) & 1u);
  return (bf16_t)(u >> 16);
}
__device__ __forceinline__ float bf2f(bf16_t b) { return __uint_as_float(((uint32_t)b) << 16); }
__device__ __forceinline__ uint32_t pack2(float a, float b) { return (uint32_t)f2bf(a) | ((uint32_t)f2bf(b) << 16); }
__device__ __forceinline__ float bflo(uint32_t w) { return __uint_as_float(w << 16); }
__device__ __forceinline__ float bfhi(uint32_t w) { return __uint_as_float(w & 0xffff0000u); }
__device__ __forceinline__ float wave_sum(float v) {
#pragma unroll
  for (int o = 32; o > 0; o >>= 1) v += __shfl_xor(v, o);
  return v;
}
__device__ __forceinline__ float row16_sum(float v) {
  v += __builtin_bit_cast(float, __builtin_amdgcn_update_dpp(0, __builtin_bit_cast(int, v), 0xB1, 0xF, 0xF, true));
  v += __builtin_bit_cast(float, __builtin_amdgcn_update_dpp(0, __builtin_bit_cast(int, v), 0x4E, 0xF, 0xF, true));
  v += __builtin_bit_cast(float, __builtin_amdgcn_update_dpp(0, __builtin_bit_cast(int, v), 0x141, 0xF, 0xF, true));
  v += __builtin_bit_cast(float, __builtin_amdgcn_update_dpp(0, __builtin_bit_cast(int, v), 0x140, 0xF, 0xF, true));
  return v;
}
__device__ __forceinline__ float silu_f(float v) { return v * __builtin_amdgcn_rcpf(1.f + __expf(-v)); }
__device__ __forceinline__ int mod_row(int t) { return t < TL ? (t >> 13) : 4; }

__device__ __forceinline__ f32x4 zero4() { f32x4 a = {0.f, 0.f, 0.f, 0.f}; asm volatile("" : "+v"(a)); return a; }

__device__ __forceinline__ int opaque_tid() { int t = threadIdx.x; asm volatile("" : "+v"(t)); return t; }
__device__ __forceinline__ int opaque_s(int v) { v = __builtin_amdgcn_readfirstlane(v); asm volatile("" : "+s"(v)); return v; }

template <class F, int... I>
__device__ __forceinline__ void static_for_impl(F&& f, std::integer_sequence<int, I...>) { (f(std::integral_constant<int, I>{}), ...); }
template <int N, class F>
__device__ __forceinline__ void static_for(F&& f) { static_for_impl(f, std::make_integer_sequence<int, N>{}); }

__device__ __forceinline__ unsigned tr_lane_base(unsigned base, unsigned ld, unsigned lane) {
  const unsigned g = lane >> 4, q = (lane & 15u) >> 2, p = lane & 3u;
  return base + (8u * g + q) * ld + 8u * p;
}
template <int O0, int O1, int O2, int O3, int D>
__device__ __forceinline__ void tr_frag4(unsigned a, bf16x8& f0, bf16x8& f1, bf16x8& f2, bf16x8& f3) {
  s16x4 r0, r1, r2, r3, r4, r5, r6, r7;
  asm volatile(
      "ds_read_b64_tr_b16 %0, %8 offset:%9\n\t"
      "ds_read_b64_tr_b16 %1, %8 offset:%10\n\t"
      "ds_read_b64_tr_b16 %2, %8 offset:%11\n\t"
      "ds_read_b64_tr_b16 %3, %8 offset:%12\n\t"
      "ds_read_b64_tr_b16 %4, %8 offset:%13\n\t"
      "ds_read_b64_tr_b16 %5, %8 offset:%14\n\t"
      "ds_read_b64_tr_b16 %6, %8 offset:%15\n\t"
      "ds_read_b64_tr_b16 %7, %8 offset:%16\n\t"
      "s_waitcnt lgkmcnt(0)"
      : "=&v"(r0), "=&v"(r1), "=&v"(r2), "=&v"(r3), "=&v"(r4), "=&v"(r5), "=&v"(r6), "=&v"(r7)
      : "v"(a), "n"(O0), "n"(O0 + D), "n"(O1), "n"(O1 + D), "n"(O2), "n"(O2 + D), "n"(O3), "n"(O3 + D)
      : "memory");
  f0 = __builtin_shufflevector(r0, r1, 0, 1, 2, 3, 4, 5, 6, 7);
  f1 = __builtin_shufflevector(r2, r3, 0, 1, 2, 3, 4, 5, 6, 7);
  f2 = __builtin_shufflevector(r4, r5, 0, 1, 2, 3, 4, 5, 6, 7);
  f3 = __builtin_shufflevector(r6, r7, 0, 1, 2, 3, 4, 5, 6, 7);
}

__device__ __forceinline__ void ph_mod_partial(const Params& p, int bid, int nb, char* smem) {
  const int TIX = opaque_tid(); bid = opaque_s(bid);
  float* sm = (float*)smem;
  const int tid = TIX;
  for (int item = bid; item < 4 * 24 * 8; item += nb) {
    const int ks = item & 7, cb = (item >> 3) % 24, l = item / 192;
    __syncthreads();
    for (int idx = tid; idx < 640; idx += 256) {
      const int r = idx >> 7, k = ks * 128 + (idx & 127);
      const float v = (r < 4) ? p.c[r * DM + k] : p.c_ctx[k];
      sm[idx] = silu_f(v);
    }
    __syncthreads();
    const int col = cb * 256 + tid;
    float acc[5] = {0.f, 0.f, 0.f, 0.f, 0.f};
    const float* w = p.w_mod + ((size_t)l * DM + ks * 128) * 6144 + col;
#pragma unroll 4
    for (int k = 0; k < 128; ++k) {
      const float wv = w[(size_t)k * 6144];
#pragma unroll
      for (int r = 0; r < 5; ++r) acc[r] += sm[r * 128 + k] * wv;
    }
#pragma unroll
    for (int r = 0; r < 5; ++r) p.modp[((size_t)(ks * 4 + l) * 5 + r) * 6144 + col] = acc[r];
  }
}

__device__ __forceinline__ void ph_mod_reduce(const Params& p, int bid, int nb) {
  const int TIX = opaque_tid(); bid = opaque_s(bid);
  const int gtid = bid * 256 + TIX, gn = nb * 256;
  for (int idx = gtid; idx < 4 * 5 * 6144; idx += gn) {
    const int l = idx / (5 * 6144), col = idx % 6144;
    float s = p.b_mod[l * 6144 + col];
#pragma unroll
    for (int ks = 0; ks < 8; ++ks) s += p.modp[(size_t)ks * (4 * 5 * 6144) + idx];
    p.mod[idx] = s;
  }
  for (int idx = gtid; idx < 128 * 32; idx += gn) {
    const int pos = idx >> 5, d = idx & 31;
    const float inv = exp2f(-(float)d * (13.287712379549449f / 32.f));
    const float angf = (float)pos * inv;
    const double a = (double)angf;
    const double kk = rint(a * 0.15915494309189535);
    const double r = a - kk * 6.283185307179586;
    const double r2 = r * r;
    double sn = 1.0, cs = 1.0;
    for (int n = 13; n >= 1; --n) {
      sn = 1.0 - sn * r2 / (double)((2 * n) * (2 * n + 1));
      cs = 1.0 - cs * r2 / (double)((2 * n - 1) * (2 * n));
    }
    p.ropec[idx] = (float)cs;
    p.ropes[idx] = (float)(r * sn);
  }
}

__device__ __forceinline__ void ph_transpose_cvt(const float* src, bf16_t* dst, int K, int N, int bid, int nb, char* smem) {
  const int TIX = opaque_tid(); bid = opaque_s(bid);
  float* tile = (float*)smem;
  const int tid = TIX;
  const int ntn = N >> 6, ntk = K >> 6;
  for (int item = bid; item < ntn * ntk; item += nb) {
    const int kt = item / ntn, nt = item % ntn;
    __syncthreads();
#pragma unroll
    for (int i = 0; i < 4; ++i) {
      const int r = (tid >> 4) + 16 * i, c4 = (tid & 15) * 4;
      const float4 v = *(const float4*)(src + (size_t)(kt * 64 + r) * N + nt * 64 + c4);
      tile[r * 65 + c4 + 0] = v.x; tile[r * 65 + c4 + 1] = v.y; tile[r * 65 + c4 + 2] = v.z; tile[r * 65 + c4 + 3] = v.w;
    }
    __syncthreads();
    const int n = tid >> 2, kseg = (tid & 3) * 16;
    uint32_t w[8];
#pragma unroll
    for (int e = 0; e < 8; ++e) w[e] = pack2(tile[(kseg + 2 * e) * 65 + n], tile[(kseg + 2 * e + 1) * 65 + n]);
    uint4* d = (uint4*)(dst + (size_t)(nt * 64 + n) * K + kt * 64 + kseg);
    d[0] = make_uint4(w[0], w[1], w[2], w[3]);
    d[1] = make_uint4(w[4], w[5], w[6], w[7]);
  }
}

__device__ __forceinline__ void ph_wk_fold(const Params& p, int bid, int nb, char* smem) {
  const int TIX = opaque_tid(); bid = opaque_s(bid);
  float* wq_s = (float*)smem;
  float* key_s = wq_s + 64 * 65;
  const int tid = TIX;
  const int tc = tid >> 4, tn = tid & 15;
  for (int item = bid; item < 4 * 16 * 16; item += nb) {
    const int ct = item & 15, hp = (item >> 4) & 15, l = item >> 8;
    float acc[4][8];
#pragma unroll
    for (int a = 0; a < 4; ++a)
#pragma unroll
      for (int b = 0; b < 8; ++b) acc[a][b] = 0.f;
    for (int dh = 0; dh < 2; ++dh) {
      __syncthreads();
#pragma unroll
      for (int i = 0; i < 4; ++i) {
        const int r = (tid >> 4) + 16 * i, c4 = (tid & 15) * 4;
        const float4 v = *(const float4*)(p.peer_wq + ((size_t)l * DM + ct * 64 + r) * 2048 + hp * 128 + dh * 64 + c4);
        wq_s[r * 65 + c4 + 0] = v.x; wq_s[r * 65 + c4 + 1] = v.y; wq_s[r * 65 + c4 + 2] = v.z; wq_s[r * 65 + c4 + 3] = v.w;
      }
#pragma unroll
      for (int i = 0; i < 8; ++i) {
        const int r = (tid >> 4) + 16 * i, c4 = (tid & 15) * 4;
        const float4 v = *(const float4*)(p.peer_keys + (((size_t)l * 2 + (hp & 1)) * 128 + r) * 128 + dh * 64 + c4);
        key_s[r * 65 + c4 + 0] = v.x; key_s[r * 65 + c4 + 1] = v.y; key_s[r * 65 + c4 + 2] = v.z; key_s[r * 65 + c4 + 3] = v.w;
      }
      __syncthreads();
#pragma unroll 4
      for (int d = 0; d < 64; ++d) {
        float av[4], bv[8];
#pragma unroll
        for (int a = 0; a < 4; ++a) av[a] = wq_s[(tc * 4 + a) * 65 + d];
#pragma unroll
        for (int b = 0; b < 8; ++b) bv[b] = key_s[(tn + 16 * b) * 65 + d];
#pragma unroll
        for (int a = 0; a < 4; ++a)
#pragma unroll
          for (int b = 0; b < 8; ++b) acc[a][b] += av[a] * bv[b];
      }
    }
#pragma unroll
    for (int b = 0; b < 8; ++b) {
      const int row = hp * 128 + tn + 16 * b;
      uint2 o;
      o.x = pack2(acc[0][b], acc[1][b]);
      o.y = pack2(acc[2][b], acc[3][b]);
      *(uint2*)(p.wkT + ((size_t)l * 2048 + row) * DM + ct * 64 + tc * 4) = o;
    }
  }
}

__device__ __forceinline__ void ph_cvt_uv(const Params& p, int l, int bid, int nb) {
  const int TIX = opaque_tid(); bid = opaque_s(bid);
  const size_t n8 = (size_t)NEXP * DM / 8;
  const float* su = p.peer_u + (size_t)l * NEXP * DM;
  const float* sv = p.peer_v + (size_t)l * NEXP * DM;
  for (size_t i = (size_t)bid * 256 + TIX; i < 2 * n8; i += (size_t)nb * 256) {
    const bool isv = i >= n8;
    const size_t j = isv ? i - n8 : i;
    const float4* s = (const float4*)((isv ? sv : su) + j * 8);
    const float4 a = s[0], b = s[1];
    uint4 o = make_uint4(pack2(a.x, a.y), pack2(a.z, a.w), pack2(b.x, b.y), pack2(b.z, b.w));
    *(uint4*)((isv ? p.vbf : p.ubf) + j * 8) = o;
  }
}

__device__ __forceinline__ void ph_init_h(const Params& p, int bid, int nb) {
  const int TIX = opaque_tid(); bid = opaque_s(bid);
  const int lane = TIX & 63;
  const int gw = bid * 4 + (TIX >> 6), nw = nb * 4;
  for (int t = gw; t < TT; t += nw) {
    const float* xr = t < TL ? p.x + (size_t)t * DM : p.ctx + (size_t)(t - TL) * DM;
    const float* m = p.mod + (size_t)(0 * 5 + mod_row(t)) * 6144;
#pragma unroll
    for (int i = 0; i < 4; ++i) {
      const int col = lane * 4 + 256 * i;
      const float4 v = *(const float4*)(xr + col);
      const float4 sh = *(const float4*)(m + col);
      const float4 sc = *(const float4*)(m + 1024 + col);
      uint2 o;
      o.x = pack2(v.x * (1.f + sc.x) + sh.x, v.y * (1.f + sc.y) + sh.y);
      o.y = pack2(v.z * (1.f + sc.z) + sh.z, v.w * (1.f + sc.w) + sh.w);
      *(uint2*)(p.hA + (size_t)t * DM + col) = o;
    }
  }
}

template <bool OUT_BF16>
__device__ __forceinline__ void ph_gemm(const bf16_t* __restrict__ A, const bf16_t* __restrict__ Bt, void* Cout, int M, int N, int K,
                        int bid, int nb, char* smem) {
  const int TIX = opaque_tid(); bid = opaque_s(bid);
  bf16_t* As = (bf16_t*)smem;
  bf16_t* Bs = As + 2 * 128 * 40;
  const int tid = TIX, lane = tid & 63, wave = tid >> 6;
  const int wm = wave >> 1, wn = wave & 1;
  const int ntn = N >> 7, ntm = M >> 7;
  const int nk = K >> 5;
  for (int tile = bid; tile < ntn * ntm; tile += nb) {
    const int m0 = (tile / ntn) << 7, n0 = (tile % ntn) << 7;
    f32x4 acc[4][4];
#pragma unroll
    for (int i = 0; i < 4; ++i)
#pragma unroll
      for (int j = 0; j < 4; ++j) acc[i][j] = zero4();
    uint4 ra[2], rb[2];
    const int lrow0 = tid >> 2, lkc = (tid & 3) * 8;
    const bf16_t* ga = A + (size_t)(m0 + lrow0) * K + lkc;
    const bf16_t* gb = Bt + (size_t)(n0 + lrow0) * K + lkc;
    __syncthreads();
    ra[0] = *(const uint4*)(ga); ra[1] = *(const uint4*)(ga + (size_t)64 * K);
    rb[0] = *(const uint4*)(gb); rb[1] = *(const uint4*)(gb + (size_t)64 * K);
    *(uint4*)(As + lrow0 * 40 + lkc) = ra[0]; *(uint4*)(As + (lrow0 + 64) * 40 + lkc) = ra[1];
    *(uint4*)(Bs + lrow0 * 40 + lkc) = rb[0]; *(uint4*)(Bs + (lrow0 + 64) * 40 + lkc) = rb[1];
    __syncthreads();
    for (int kt = 0; kt < nk; ++kt) {
      const int cur = kt & 1;
      if (kt + 1 < nk) {
        ra[0] = *(const uint4*)(ga + (kt + 1) * 32); ra[1] = *(const uint4*)(ga + (size_t)64 * K + (kt + 1) * 32);
        rb[0] = *(const uint4*)(gb + (kt + 1) * 32); rb[1] = *(const uint4*)(gb + (size_t)64 * K + (kt + 1) * 32);
      }
      const bf16_t* as = As + cur * 128 * 40 + (wm * 64 + (lane & 15)) * 40 + (lane >> 4) * 8;
      const bf16_t* bs = Bs + cur * 128 * 40 + (wn * 64 + (lane & 15)) * 40 + (lane >> 4) * 8;
      bf16x8 af[4], bfr[4];
#pragma unroll
      for (int i = 0; i < 4; ++i) af[i] = *(const bf16x8*)(as + i * 16 * 40);
#pragma unroll
      for (int j = 0; j < 4; ++j) bfr[j] = *(const bf16x8*)(bs + j * 16 * 40);
#pragma unroll
      for (int i = 0; i < 4; ++i)
#pragma unroll
        for (int j = 0; j < 4; ++j) acc[i][j] = __builtin_amdgcn_mfma_f32_16x16x32_bf16(af[i], bfr[j], acc[i][j], 0, 0, 0);
      if (kt + 1 < nk) {
        const int nx = cur ^ 1;
        *(uint4*)(As + nx * 128 * 40 + lrow0 * 40 + lkc) = ra[0]; *(uint4*)(As + nx * 128 * 40 + (lrow0 + 64) * 40 + lkc) = ra[1];
        *(uint4*)(Bs + nx * 128 * 40 + lrow0 * 40 + lkc) = rb[0]; *(uint4*)(Bs + nx * 128 * 40 + (lrow0 + 64) * 40 + lkc) = rb[1];
      }
      __syncthreads();
    }
#pragma unroll
    for (int i = 0; i < 4; ++i)
#pragma unroll
      for (int j = 0; j < 4; ++j)
#pragma unroll
        for (int r = 0; r < 4; ++r) {
          const int row = m0 + wm * 64 + i * 16 + (lane >> 4) * 4 + r;
          const int col = n0 + wn * 64 + j * 16 + (lane & 15);
          if (OUT_BF16) ((bf16_t*)Cout)[(size_t)row * N + col] = f2bf(acc[i][j][r]);
          else ((float*)Cout)[(size_t)row * N + col] = acc[i][j][r];
        }
  }
}

__device__ __forceinline__ void ph_elem(const Params& p, int l, int bid, int nb) {
  const int TIX = opaque_tid(); bid = opaque_s(bid);
  bf16_t* proj = (bf16_t*)p.big;
  const int tid = TIX;
  const int sub = tid & 127;
  for (int tp = bid; tp < TT / 2; tp += nb) {
    const int t = tp * 2 + (tid >> 7);
    bf16_t* row = proj + (size_t)t * NPROJ;
    if (sub < 64) {
      const int ch = sub * 8;
      bool hasl, hasr;
      if (t < TL) { const int i = t & 63; hasl = i != 0; hasr = i != 63; }
      else { const int i = (t - TL) & 255; hasl = i != 0; hasr = i != 255; }
      const uint4 bg = *(const uint4*)(row + ch);
      const uint4 c1 = *(const uint4*)(row + 512 + ch), h1 = *(const uint4*)(row + 1024 + ch);
      uint4 c0 = make_uint4(0, 0, 0, 0), h0 = c0, c2 = c0, h2 = c0;
      if (hasl) { c0 = *(const uint4*)(row - NPROJ + 512 + ch); h0 = *(const uint4*)(row - NPROJ + 1024 + ch); }
      if (hasr) { c2 = *(const uint4*)(row + NPROJ + 512 + ch); h2 = *(const uint4*)(row + NPROJ + 1024 + ch); }
      const uint32_t bgw[4] = {bg.x, bg.y, bg.z, bg.w};
      const uint32_t c0w[4] = {c0.x, c0.y, c0.z, c0.w}, c1w[4] = {c1.x, c1.y, c1.z, c1.w}, c2w[4] = {c2.x, c2.y, c2.z, c2.w};
      const uint32_t h0w[4] = {h0.x, h0.y, h0.z, h0.w}, h1w[4] = {h1.x, h1.y, h1.z, h1.w}, h2w[4] = {h2.x, h2.y, h2.z, h2.w};
      const float* cw = p.conv_w + ((size_t)l * 512 + ch) * 3;
      uint32_t ow[4];
#pragma unroll
      for (int e = 0; e < 4; ++e) {
        const float z0a = bflo(c0w[e]) * bflo(h0w[e]), z1a = bflo(c1w[e]) * bflo(h1w[e]), z2a = bflo(c2w[e]) * bflo(h2w[e]);
        const float z0b = bfhi(c0w[e]) * bfhi(h0w[e]), z1b = bfhi(c1w[e]) * bfhi(h1w[e]), z2b = bfhi(c2w[e]) * bfhi(h2w[e]);
        const float* wa = cw + (2 * e) * 3;
        const float ya = z0a * wa[0] + z1a * wa[1] + z2a * wa[2];
        const float yb = z0b * wa[3] + z1b * wa[4] + z2b * wa[5];
        ow[e] = pack2(bflo(bgw[e]) * ya, bfhi(bgw[e]) * yb);
      }
      *(uint4*)(p.cat + (size_t)t * DM + ch) = make_uint4(ow[0], ow[1], ow[2], ow[3]);
    } else {
      const int it = sub - 64;
      const int hd = it >> 4, isk = (it >> 3) & 1, half = (it >> 2) & 1, dg = it & 3;
      bf16_t* b1 = row + 1536 + isk * 512 + hd * 128 + half * 64 + dg * 8;
      const uint4 u1 = *(const uint4*)b1, u2 = *(const uint4*)(b1 + 32);
      const uint32_t u1w[4] = {u1.x, u1.y, u1.z, u1.w}, u2w[4] = {u2.x, u2.y, u2.z, u2.w};
      const float scl = isk ? 0.08838834764831845f : 1.f;
      float cs[8], sn[8];
      if (t < TL) {
        const int i = t & 8191;
        const int pos = half ? (i & 63) : (i >> 6);
#pragma unroll
        for (int e = 0; e < 8; ++e) { cs[e] = p.ropec[pos * 32 + dg * 8 + e]; sn[e] = p.ropes[pos * 32 + dg * 8 + e]; }
      } else {
#pragma unroll
        for (int e = 0; e < 8; ++e) { cs[e] = 1.f; sn[e] = 0.f; }
      }
      uint32_t o1[4], o2[4];
#pragma unroll
      for (int e = 0; e < 4; ++e) {
        const float a0 = bflo(u1w[e]), a1 = bfhi(u1w[e]), b0 = bflo(u2w[e]), b1v = bfhi(u2w[e]);
        o1[e] = pack2((a0 * cs[2 * e] - b0 * sn[2 * e]) * scl, (a1 * cs[2 * e + 1] - b1v * sn[2 * e + 1]) * scl);
        o2[e] = pack2((a0 * sn[2 * e] + b0 * cs[2 * e]) * scl, (a1 * sn[2 * e + 1] + b1v * cs[2 * e + 1]) * scl);
      }
      *(uint4*)b1 = make_uint4(o1[0], o1[1], o1[2], o1[3]);
      *(uint4*)(b1 + 32) = make_uint4(o2[0], o2[1], o2[2], o2[3]);
    }
  }
}

__device__ __forceinline__ void ph_ret_upd(const Params& p, int bid, int nb, char* smem) {
  const int TIX = opaque_tid(); bid = opaque_s(bid);
  const bf16_t* proj = (const bf16_t*)p.big;
  bf16_t* Vs = (bf16_t*)smem;
  bf16_t* Ks = Vs + 64 * 136;
  const int tid = TIX, lane = tid & 63, wave = tid >> 6;
  const int wm = wave >> 1, wn = wave & 1;
  const unsigned va = tr_lane_base((unsigned)(size_t)Vs, 272u, lane) + wm * 128;
  const unsigned ka = tr_lane_base((unsigned)(size_t)Ks, 272u, lane) + wn * 128;
  for (int item = bid; item < NCHUNK * 4; item += nb) {
    const int c = item >> 2, hd = item & 3;
    const int t0 = c * 128;
    for (int dir = 0; dir < 2; ++dir) {
      const float lg = p.lg2[dir][hd];
      f32x4 acc[4][4];
#pragma unroll
      for (int i = 0; i < 4; ++i)
#pragma unroll
        for (int j = 0; j < 4; ++j) acc[i][j] = zero4();
      for (int half = 0; half < 2; ++half) {
        __syncthreads();
#pragma unroll
        for (int i = 0; i < 4; ++i) {
          const int idx = tid + 256 * i;
          const int r = idx >> 4, ck = (idx & 15) * 8;
          const int s = half * 64 + r;
          const bf16_t* src = proj + (size_t)(t0 + s) * NPROJ + hd * 128 + ck;
          const uint4 vv = *(const uint4*)(src + 2560);
          const uint4 kv = *(const uint4*)(src + 2048);
          const float w = exp2f((dir == 0 ? (float)(127 - s) : (float)s) * lg);
          uint4 ko;
          ko.x = pack2(bflo(kv.x) * w, bfhi(kv.x) * w); ko.y = pack2(bflo(kv.y) * w, bfhi(kv.y) * w);
          ko.z = pack2(bflo(kv.z) * w, bfhi(kv.z) * w); ko.w = pack2(bflo(kv.w) * w, bfhi(kv.w) * w);
          *(uint4*)(Vs + r * 136 + ck) = vv;
          *(uint4*)(Ks + r * 136 + ck) = ko;
        }
        __syncthreads();
        static_for<2>([&](auto KS) {
          constexpr int ks = decltype(KS)::value;
          bf16x8 af[4], bfr[4];
          tr_frag4<ks * 32 * 272 + 0, ks * 32 * 272 + 32, ks * 32 * 272 + 64, ks * 32 * 272 + 96, 4 * 272>(va, af[0], af[1], af[2], af[3]);
          tr_frag4<ks * 32 * 272 + 0, ks * 32 * 272 + 32, ks * 32 * 272 + 64, ks * 32 * 272 + 96, 4 * 272>(ka, bfr[0], bfr[1], bfr[2], bfr[3]);
#pragma unroll
          for (int i = 0; i < 4; ++i)
#pragma unroll
            for (int j = 0; j < 4; ++j) acc[i][j] = __builtin_amdgcn_mfma_f32_16x16x32_bf16(af[i], bfr[j], acc[i][j], 0, 0, 0);
        });
      }
      float* dst = p.st + ((size_t)(dir * NCHUNK + c) * 4 + hd) * 16384;
#pragma unroll
      for (int i = 0; i < 4; ++i)
#pragma unroll
        for (int j = 0; j < 4; ++j)
#pragma unroll
          for (int r = 0; r < 4; ++r) {
            const int row = wm * 64 + i * 16 + (lane >> 4) * 4 + r;
            const int col = wn * 64 + j * 16 + (lane & 15);
            dst[row * 128 + col] = acc[i][j][r];
          }
    }
  }
}

__device__ __forceinline__ void ph_ret_scan(const Params& p, int bid, int nb) {
  const int TIX = opaque_tid(); bid = opaque_s(bid);
  const int gtid = bid * 256 + TIX, gn = nb * 256;
  for (int idx = gtid; idx < 2 * 4 * 4 * 16384; idx += gn) {
    const int e = idx & 16383, hd = (idx >> 14) & 3, b = (idx >> 16) & 3, dir = idx >> 18;
    const float dc = exp2f(128.f * p.lg2[dir][hd]);
    const size_t boff = (size_t)dir * NCHUNK * 4 * 16384 + (size_t)hd * 16384 + e;
    const float* src = p.st + boff;
    float* dst = p.ybuf + boff;
    float carry = 0.f;
    if (dir == 0) {
      for (int n = 0; n < 2; ++n) {
        const size_t o = (size_t)(256 + b * 2 + n) * 4 * 16384;
        const float u = src[o]; dst[o] = carry; carry = carry * dc + u;
      }
      for (int n = 0; n < 64; ++n) {
        const size_t o = (size_t)(b * 64 + n) * 4 * 16384;
        const float u = src[o]; dst[o] = carry; carry = carry * dc + u;
      }
    } else {
      for (int n = 1; n >= 0; --n) {
        const size_t o = (size_t)(256 + b * 2 + n) * 4 * 16384;
        const float u = src[o]; dst[o] = carry; carry = carry * dc + u;
      }
      for (int n = 63; n >= 0; --n) {
        const size_t o = (size_t)(b * 64 + n) * 4 * 16384;
        const float u = src[o]; dst[o] = carry; carry = carry * dc + u;
      }
    }
  }
}

__device__ __forceinline__ void ph_ret_out(const Params& p, int bid, int nb, char* smem) {
  const int TIX = opaque_tid(); bid = opaque_s(bid);
  const bf16_t* proj = (const bf16_t*)p.big;
  bf16_t* buf = (bf16_t*)smem;
  bf16_t* Pb = buf + 128 * 136;
  const int tid = TIX, lane = tid & 63, wave = tid >> 6;
  const unsigned ba = tr_lane_base((unsigned)(size_t)buf, 272u, lane);
  const int g = lane >> 4, l15 = lane & 15;
  bf16_t* Pw = Pb + wave * 16 * 136;
  for (int item = bid; item < NCHUNK * 8; item += nb) {
    const int c = item >> 3, hd = (item >> 1) & 3, rh = item & 1;
    const int t0 = c * 128;
    const int rw = rh * 64 + wave * 16;
    const float lgf = p.lg2[0][hd], lgb = p.lg2[1][hd];
    bf16x8 qf[4];
#pragma unroll
    for (int ks = 0; ks < 4; ++ks)
      qf[ks] = *(const bf16x8*)(proj + (size_t)(t0 + rw + l15) * NPROJ + 1536 + hd * 128 + ks * 32 + g * 8);
    f32x4 acc[8];
    if (!(DBG_RO & 4)) {
    __syncthreads();
#pragma unroll
    for (int i = 0; i < 8; ++i) {
      const int idx = tid + 256 * i; const int r = idx >> 4, ck = (idx & 15) * 8;
      *(uint4*)(buf + r * 136 + ck) = *(const uint4*)(proj + (size_t)(t0 + r) * NPROJ + 2048 + hd * 128 + ck);
    }
    __syncthreads();
#pragma unroll
    for (int nt = 0; nt < 8; ++nt) acc[nt] = zero4();
#pragma unroll
    for (int ks = 0; ks < 4; ++ks) {
#pragma unroll
      for (int nt = 0; nt < 8; ++nt) {
        const bf16x8 bfr = *(const bf16x8*)(buf + (nt * 16 + l15) * 136 + ks * 32 + g * 8);
        acc[nt] = __builtin_amdgcn_mfma_f32_16x16x32_bf16(qf[ks], bfr, acc[nt], 0, 0, 0);
      }
    }
#pragma unroll
    for (int nt = 0; nt < 8; ++nt)
#pragma unroll
      for (int r = 0; r < 4; ++r) {
        const int tl = g * 4 + r;
        const int t = rw + tl, s = nt * 16 + l15;
        const float d = (s <= t) ? exp2f((float)(t - s) * lgf) : exp2f((float)(s - t) * lgb);
        Pw[tl * 136 + s] = f2bf(acc[nt][r] * d);
      }
    __syncthreads();
#pragma unroll
    for (int i = 0; i < 8; ++i) {
      const int idx = tid + 256 * i; const int r = idx >> 4, ck = (idx & 15) * 8;
      *(uint4*)(buf + r * 136 + ck) = *(const uint4*)(proj + (size_t)(t0 + r) * NPROJ + 2560 + hd * 128 + ck);
    }
    __syncthreads();
    }
    f32x4 o[8];
#pragma unroll
    for (int nt = 0; nt < 8; ++nt) o[nt] = zero4();
    if (!(DBG_RO & 1)) static_for<4>([&](auto KS) {
      constexpr int ks = decltype(KS)::value;
      const bf16x8 pf = *(const bf16x8*)(Pw + l15 * 136 + ks * 32 + g * 8);
      static_for<2>([&](auto NH) {
        constexpr int nh = decltype(NH)::value;
        bf16x8 bfr[4];
        tr_frag4<ks * 32 * 272 + nh * 128 + 0, ks * 32 * 272 + nh * 128 + 32, ks * 32 * 272 + nh * 128 + 64, ks * 32 * 272 + nh * 128 + 96, 4 * 272>(
            ba, bfr[0], bfr[1], bfr[2], bfr[3]);
#pragma unroll
        for (int j = 0; j < 4; ++j) o[nh * 4 + j] = __builtin_amdgcn_mfma_f32_16x16x32_bf16(pf, bfr[j], o[nh * 4 + j], 0, 0, 0);
      });
    });
    if (!(DBG_RO & 2)) for (int dir = 0; dir < 2; ++dir) {
      __syncthreads();
      const float* ssrc = p.ybuf + ((size_t)(dir * NCHUNK + c) * 4 + hd) * 16384;
#pragma unroll
      for (int i = 0; i < 16; ++i) {
        const int idx = tid + 256 * i; const int r = idx >> 5, c4 = (idx & 31) * 4;
        const float4 v = *(const float4*)(ssrc + r * 128 + c4);
        uint2 w; w.x = pack2(v.x, v.y); w.y = pack2(v.z, v.w);
        *(uint2*)(buf + r * 136 + c4) = w;
      }
      __syncthreads();
      float fr[4];
#pragma unroll
      for (int r = 0; r < 4; ++r) {
        const int t = rw + g * 4 + r;
        fr[r] = (dir == 0) ? exp2f((float)(t + 1) * lgf) : exp2f((float)(128 - t) * lgb);
      }
#pragma unroll
      for (int nt = 0; nt < 8; ++nt) acc[nt] = zero4();
      __builtin_amdgcn_sched_barrier(0);
#pragma unroll
      for (int ks = 0; ks < 4; ++ks) {
#pragma unroll
        for (int nt = 0; nt < 8; ++nt) {
          const bf16x8 bfr = *(const bf16x8*)(buf + (nt * 16 + l15) * 136 + ks * 32 + g * 8);
          acc[nt] = __builtin_amdgcn_mfma_f32_16x16x32_bf16(qf[ks], bfr, acc[nt], 0, 0, 0);
        }
      }
      __builtin_amdgcn_sched_barrier(0);
      asm volatile("s_nop 15\n\ts_nop 15\n\ts_nop 15\n\ts_nop 15" ::: "memory");
      __builtin_amdgcn_sched_barrier(0);
#pragma unroll
      for (int r = 0; r < 4; ++r) {
#pragma unroll
        for (int nt = 0; nt < 8; ++nt) o[nt][r] += fr[r] * acc[nt][r];
      }
    }
#pragma unroll
    for (int r = 0; r < 4; ++r) {
      const int t = t0 + rw + g * 4 + r;
#pragma unroll
      for (int nt = 0; nt < 8; ++nt) p.cat[(size_t)t * DM + 512 + hd * 128 + nt * 16 + l15] = f2bf(o[nt][r]);
    }
  }
}

__device__ __forceinline__ void ph_gnorm(const Params& p, int bid, int nb) {
  const int TIX = opaque_tid(); bid = opaque_s(bid);
  const bf16_t* proj = (const bf16_t*)p.big;
  const int lane = TIX & 63;
  const int gw = bid * 4 + (TIX >> 6), nw = nb * 4;
  for (int t = gw; t < TT; t += nw) {
    bf16_t* op = p.cat + (size_t)t * DM + 512 + lane * 8;
    const uint4 ov = *(const uint4*)op;
    const uint4 gv = *(const uint4*)(proj + (size_t)t * NPROJ + 3072 + lane * 8);
    float o[8], gg[8];
    o[0] = bflo(ov.x); o[1] = bfhi(ov.x); o[2] = bflo(ov.y); o[3] = bfhi(ov.y);
    o[4] = bflo(ov.z); o[5] = bfhi(ov.z); o[6] = bflo(ov.w); o[7] = bfhi(ov.w);
    gg[0] = bflo(gv.x); gg[1] = bfhi(gv.x); gg[2] = bflo(gv.y); gg[3] = bfhi(gv.y);
    gg[4] = bflo(gv.z); gg[5] = bfhi(gv.z); gg[6] = bflo(gv.w); gg[7] = bfhi(gv.w);
    float s1 = 0.f;
#pragma unroll
    for (int i = 0; i < 8; ++i) s1 += o[i];
    s1 = row16_sum(s1);
    const float mu = s1 * (1.f / 128.f);
    float s2 = 0.f;
#pragma unroll
    for (int i = 0; i < 8; ++i) { const float d = o[i] - mu; s2 += d * d; }
    s2 = row16_sum(s2);
    const float rs = rsqrtf(s2 * (1.f / 128.f) + 1e-5f);
    float y[8];
#pragma unroll
    for (int i = 0; i < 8; ++i) y[i] = silu_f(gg[i]) * (o[i] - mu) * rs;
    *(uint4*)op = make_uint4(pack2(y[0], y[1]), pack2(y[2], y[3]), pack2(y[4], y[5]), pack2(y[6], y[7]));
  }
}

__device__ __forceinline__ void ph_ln(const Params& p, int l, int which, int bid, int nb) {
  const int TIX = opaque_tid(); bid = opaque_s(bid);
  const int lane = TIX & 63;
  const int gw = bid * 4 + (TIX >> 6), nw = nb * 4;
  const float* lg = (which == 1 ? p.ln1_g : p.ln2_g) + (size_t)l * DM;
  const float* lb = (which == 1 ? p.ln1_b : p.ln2_b) + (size_t)l * DM;
  const bool last = (l == NLAYER - 1);
  for (int t = gw; t < TT; t += nw) {
    const float* xr;
    if (l == 0 && which == 1) xr = t < TL ? p.x + (size_t)t * DM : p.ctx + (size_t)(t - TL) * DM;
    else xr = p.xres + (size_t)t * DM;
    const float* yr = p.ybuf + (size_t)t * DM;
    const float* m = p.mod + (size_t)(l * 5 + mod_row(t)) * 6144;
    const float* mg = m + (which == 1 ? 2048 : 5120);
    float v[16];
    float s1 = 0.f;
#pragma unroll
    for (int i = 0; i < 4; ++i) {
      const int col = lane * 4 + 256 * i;
      const float4 xv = *(const float4*)(xr + col);
      const float4 yv = *(const float4*)(yr + col);
      const float4 gv = *(const float4*)(mg + col);
      v[4 * i + 0] = ALPHA_F * xv.x + gv.x * yv.x; v[4 * i + 1] = ALPHA_F * xv.y + gv.y * yv.y;
      v[4 * i + 2] = ALPHA_F * xv.z + gv.z * yv.z; v[4 * i + 3] = ALPHA_F * xv.w + gv.w * yv.w;
      s1 += v[4 * i + 0] + v[4 * i + 1] + v[4 * i + 2] + v[4 * i + 3];
    }
    const float mu = wave_sum(s1) * (1.f / 1024.f);
    float s2 = 0.f;
#pragma unroll
    for (int i = 0; i < 16; ++i) { const float d = v[i] - mu; s2 += d * d; }
    const float rs = rsqrtf(wave_sum(s2) * (1.f / 1024.f) + 1e-5f);
    const float* msh; const float* msc;
    if (which == 1) { msh = m + 3072; msc = m + 4096; }
    else { const float* m2 = p.mod + (size_t)((last ? l : l + 1) * 5 + mod_row(t)) * 6144; msh = m2; msc = m2 + 1024; }
#pragma unroll
    for (int i = 0; i < 4; ++i) {
      const int col = lane * 4 + 256 * i;
      const float4 gg = *(const float4*)(lg + col);
      const float4 bb = *(const float4*)(lb + col);
      float4 o;
      o.x = (v[4 * i + 0] - mu) * rs * gg.x + bb.x; o.y = (v[4 * i + 1] - mu) * rs * gg.y + bb.y;
      o.z = (v[4 * i + 2] - mu) * rs * gg.z + bb.z; o.w = (v[4 * i + 3] - mu) * rs * gg.w + bb.w;
      *(float4*)(p.xres + (size_t)t * DM + col) = o;
      if (which == 2 && last && t < TL) *(float4*)(p.out + (size_t)t * DM + col) = o;
      const float4 sh = *(const float4*)(msh + col);
      const float4 sc = *(const float4*)(msc + col);
      uint2 h;
      h.x = pack2(o.x * (1.f + sc.x) + sh.x, o.y * (1.f + sc.y) + sh.y);
      h.y = pack2(o.z * (1.f + sc.z) + sh.z, o.w * (1.f + sc.w) + sh.w);
      *(uint2*)(p.hA + (size_t)t * DM + col) = h;
    }
  }
}

#define TK_INSERT(V, I, xv, xi)                                        \
  if ((xv) > V[15]) {                                                  \
    V[15] = (xv); I[15] = (xi);                                        \
    _Pragma("unroll") for (int q_ = 15; q_ > 0; --q_) {                \
      const bool sw_ = V[q_] > V[q_ - 1];                              \
      const float tv_ = V[q_]; const int ti_ = I[q_];                  \
      V[q_] = sw_ ? V[q_ - 1] : tv_; I[q_] = sw_ ? I[q_ - 1] : ti_;    \
      V[q_ - 1] = sw_ ? tv_ : V[q_ - 1]; I[q_ - 1] = sw_ ? ti_ : I[q_ - 1]; \
    }                                                                  \
  }

__device__ __forceinline__ void ph_topk1(const Params& p, int bid, int nb) {
  const int TIX = opaque_tid(); bid = opaque_s(bid);
  const float* scores = (const float*)p.big;
  const int gtid = bid * 256 + TIX, gn = nb * 256;
  for (int idx = gtid; idx < TT * 16; idx += gn) {
    const float* row = scores + (size_t)idx * 128;
    float V[16]; int I[16];
#pragma unroll
    for (int i = 0; i < 16; ++i) { V[i] = -3.0e38f; I[i] = 0; }
    for (int i4 = 0; i4 < 32; ++i4) {
      const float4 x = *(const float4*)(row + i4 * 4);
      TK_INSERT(V, I, x.x, i4 * 4 + 0)
      TK_INSERT(V, I, x.y, i4 * 4 + 1)
      TK_INSERT(V, I, x.z, i4 * 4 + 2)
      TK_INSERT(V, I, x.w, i4 * 4 + 3)
    }
    float4* dv = (float4*)(p.sv + (size_t)idx * 16);
    dv[0] = make_float4(V[0], V[1], V[2], V[3]); dv[1] = make_float4(V[4], V[5], V[6], V[7]);
    dv[2] = make_float4(V[8], V[9], V[10], V[11]); dv[3] = make_float4(V[12], V[13], V[14], V[15]);
    uint4 di;
    di.x = I[0] | (I[1] << 8) | (I[2] << 16) | (I[3] << 24);
    di.y = I[4] | (I[5] << 8) | (I[6] << 16) | (I[7] << 24);
    di.z = I[8] | (I[9] << 8) | (I[10] << 16) | (I[11] << 24);
    di.w = I[12] | (I[13] << 8) | (I[14] << 16) | (I[15] << 24);
    *(uint4*)(p.si + (size_t)idx * 16) = di;
  }
}

__device__ __forceinline__ void ph_topk2(const Params& p, int bid, int nb) {
  const int TIX = opaque_tid(); bid = opaque_s(bid);
  const int gtid = bid * 256 + TIX, gn = nb * 256;
  for (int idx = gtid; idx < TT * 8; idx += gn) {
    float a[16], b[16]; int ia[16], ib[16];
    {
      const float4* pa = (const float4*)(p.sv + (size_t)idx * 32);
#pragma unroll
      for (int i = 0; i < 4; ++i) { const float4 v = pa[i]; a[4 * i] = v.x; a[4 * i + 1] = v.y; a[4 * i + 2] = v.z; a[4 * i + 3] = v.w; }
#pragma unroll
      for (int i = 0; i < 4; ++i) { const float4 v = pa[4 + i]; b[4 * i] = v.x; b[4 * i + 1] = v.y; b[4 * i + 2] = v.z; b[4 * i + 3] = v.w; }
      const uint4 qa = *(const uint4*)(p.si + (size_t)idx * 32), qb = *(const uint4*)(p.si + (size_t)idx * 32 + 16);
      const uint32_t wa[4] = {qa.x, qa.y, qa.z, qa.w}, wb[4] = {qb.x, qb.y, qb.z, qb.w};
#pragma unroll
      for (int i = 0; i < 16; ++i) { ia[i] = (wa[i >> 2] >> (8 * (i & 3))) & 255; ib[i] = (wb[i >> 2] >> (8 * (i & 3))) & 255; }
    }
    float V[16]; int I[16];
#pragma unroll
    for (int i = 0; i < 16; ++i) { V[i] = -3.0e38f; I[i] = 0; }
#pragma unroll
    for (int i = 0; i < 16; ++i) {
#pragma unroll
      for (int j = 0; j < 16; ++j) {
        if ((i + 1) * (j + 1) <= 16) {
          const float cv = a[i] + b[j];
          const int ce = ia[i] * 128 + ib[j];
          TK_INSERT(V, I, cv, ce)
        }
      }
    }
    float e[16], sum = 0.f;
#pragma unroll
    for (int i = 0; i < 16; ++i) { e[i] = __expf(V[i] - V[0]); sum += e[i]; }
    const float inv = 1.f / sum;
    int4* de = (int4*)(p.pe + (size_t)idx * 16);
    float4* dg = (float4*)(p.pg + (size_t)idx * 16);
#pragma unroll
    for (int i = 0; i < 4; ++i) {
      de[i] = make_int4(I[4 * i], I[4 * i + 1], I[4 * i + 2], I[4 * i + 3]);
      dg[i] = make_float4(e[4 * i] * inv, e[4 * i + 1] * inv, e[4 * i + 2] * inv, e[4 * i + 3] * inv);
    }
  }
}

__device__ __forceinline__ void ph_gather(const Params& p, int bid, int nb) {
  const int TIX = opaque_tid(); bid = opaque_s(bid);
  const int lane = TIX & 63;
  const int gw = bid * 4 + (TIX >> 6), nw = nb * 4;
  for (int t = gw; t < TT; t += nw) {
    const bf16_t* hrow = p.hA + (size_t)t * DM;
    const uint4 h0 = *(const uint4*)(hrow + lane * 8), h1 = *(const uint4*)(hrow + 512 + lane * 8);
    float hf[16];
    hf[0] = bflo(h0.x); hf[1] = bfhi(h0.x); hf[2] = bflo(h0.y); hf[3] = bfhi(h0.y);
    hf[4] = bflo(h0.z); hf[5] = bfhi(h0.z); hf[6] = bflo(h0.w); hf[7] = bfhi(h0.w);
    hf[8] = bflo(h1.x); hf[9] = bfhi(h1.x); hf[10] = bflo(h1.y); hf[11] = bfhi(h1.y);
    hf[12] = bflo(h1.z); hf[13] = bfhi(h1.z); hf[14] = bflo(h1.w); hf[15] = bfhi(h1.w);
    float acc[16];
#pragma unroll
    for (int i = 0; i < 16; ++i) acc[i] = 0.f;
    const int e_lo = p.pe[(size_t)t * 128 + lane], e_hi = p.pe[(size_t)t * 128 + 64 + lane];
    const float g_lo = p.pg[(size_t)t * 128 + lane], g_hi = p.pg[(size_t)t * 128 + 64 + lane];
    for (int kb = 0; kb < 128; kb += 4) {
      int e[4]; float gt[4];
      uint4 ua[4], ub[4], va[4], vb[4];
#pragma unroll
      for (int u = 0; u < 4; ++u) {
        const int k = kb + u;
        e[u] = __shfl(k < 64 ? e_lo : e_hi, k & 63);
        gt[u] = __shfl(k < 64 ? g_lo : g_hi, k & 63);
        const bf16_t* ur = p.ubf + (size_t)e[u] * DM;
        const bf16_t* vr = p.vbf + (size_t)e[u] * DM;
        ua[u] = *(const uint4*)(ur + lane * 8); ub[u] = *(const uint4*)(ur + 512 + lane * 8);
        va[u] = *(const uint4*)(vr + lane * 8); vb[u] = *(const uint4*)(vr + 512 + lane * 8);
      }
#pragma unroll
      for (int u = 0; u < 4; ++u) {
        float d = bflo(ua[u].x) * hf[0] + bfhi(ua[u].x) * hf[1] + bflo(ua[u].y) * hf[2] + bfhi(ua[u].y) * hf[3]
                + bflo(ua[u].z) * hf[4] + bfhi(ua[u].z) * hf[5] + bflo(ua[u].w) * hf[6] + bfhi(ua[u].w) * hf[7]
                + bflo(ub[u].x) * hf[8] + bfhi(ub[u].x) * hf[9] + bflo(ub[u].y) * hf[10] + bfhi(ub[u].y) * hf[11]
                + bflo(ub[u].z) * hf[12] + bfhi(ub[u].z) * hf[13] + bflo(ub[u].w) * hf[14] + bfhi(ub[u].w) * hf[15];
        d = wave_sum(d);
        const float a = gt[u] * 0.5f * d * (1.f + erff(d * 0.7071067811865476f));
        acc[0] += a * bflo(va[u].x); acc[1] += a * bfhi(va[u].x); acc[2] += a * bflo(va[u].y); acc[3] += a * bfhi(va[u].y);
        acc[4] += a * bflo(va[u].z); acc[5] += a * bfhi(va[u].z); acc[6] += a * bflo(va[u].w); acc[7] += a * bfhi(va[u].w);
        acc[8] += a * bflo(vb[u].x); acc[9] += a * bfhi(vb[u].x); acc[10] += a * bflo(vb[u].y); acc[11] += a * bfhi(vb[u].y);
        acc[12] += a * bflo(vb[u].z); acc[13] += a * bfhi(vb[u].z); acc[14] += a * bflo(vb[u].w); acc[15] += a * bfhi(vb[u].w);
      }
    }
    float* fr = p.ybuf + (size_t)t * DM;
    *(float4*)(fr + lane * 8) = make_float4(acc[0], acc[1], acc[2], acc[3]);
    *(float4*)(fr + lane * 8 + 4) = make_float4(acc[4], acc[5], acc[6], acc[7]);
    *(float4*)(fr + 512 + lane * 8) = make_float4(acc[8], acc[9], acc[10], acc[11]);
    *(float4*)(fr + 512 + lane * 8 + 4) = make_float4(acc[12], acc[13], acc[14], acc[15]);
  }
}

enum { PH_PRE_A = 0, PH_PRE_B, PH_INIT, PH_GEMM_IN, PH_ELEM, PH_RET_UPD, PH_RET_SCAN, PH_RET_OUT, PH_GEMM_OUT, PH_LN1,
       PH_GEMM_WK, PH_TOPK1, PH_TOPK2, PH_GATHER, PH_LN2, PH_GNORM };

__device__ __forceinline__ void run_phase(const Params& p, int ph, int l, int bid, int nb, char* smem) {
  switch (ph) {
    case PH_PRE_A:
      ph_mod_partial(p, bid, nb, smem);
      for (int ll = 0; ll < NLAYER; ++ll) {
        ph_transpose_cvt(p.w_in + (size_t)ll * DM * NPROJ, p.w_inT + (size_t)ll * NPROJ * DM, DM, NPROJ, bid, nb, smem);
        ph_transpose_cvt(p.w_out + (size_t)ll * DM * DM, p.w_outT + (size_t)ll * DM * DM, DM, DM, bid, nb, smem);
      }
      ph_wk_fold(p, bid, nb, smem);
      break;
    case PH_PRE_B: ph_mod_reduce(p, bid, nb); break;
    case PH_INIT: ph_init_h(p, bid, nb); break;
    case PH_GEMM_IN:
      ph_gemm<true>(p.hA, p.w_inT + (size_t)l * NPROJ * DM, p.big, TT, NPROJ, DM, bid, nb, smem);
      ph_cvt_uv(p, l, bid, nb);
      break;
    case PH_ELEM: ph_elem(p, l, bid, nb); break;
    case PH_RET_UPD: ph_ret_upd(p, bid, nb, smem); break;
    case PH_RET_SCAN: ph_ret_scan(p, bid, nb); break;
    case PH_RET_OUT: ph_ret_out(p, bid, nb, smem); break;
    case PH_GEMM_OUT: ph_gemm<false>(p.cat, p.w_outT + (size_t)l * DM * DM, p.ybuf, TT, DM, DM, bid, nb, smem); break;
    case PH_LN1: ph_ln(p, l, 1, bid, nb); break;
    case PH_GEMM_WK: ph_gemm<false>(p.hA, p.wkT + (size_t)l * 2048 * DM, p.big, TT, 2048, DM, bid, nb, smem); break;
    case PH_TOPK1: ph_topk1(p, bid, nb); break;
    case PH_TOPK2: ph_topk2(p, bid, nb); break;
    case PH_GATHER: ph_gather(p, bid, nb); break;
    case PH_LN2: ph_ln(p, l, 2, bid, nb); break;
    case PH_GNORM: ph_gnorm(p, bid, nb); break;
  }
}

extern __shared__ __attribute__((aligned(16))) char dyn_smem[];

template <int PH>
__global__ void __launch_bounds__(256, 2) k_phase(Params p, int l) {
  run_phase(p, PH, l, blockIdx.x, gridDim.x, dyn_smem);
}

__global__ void __launch_bounds__(256, 2) k_mega(Params p) {
  cg::grid_group grid = cg::this_grid();
  const int bid = blockIdx.x, nb = gridDim.x;
  run_phase(p, PH_PRE_A, 0, bid, nb, dyn_smem); grid.sync();
  run_phase(p, PH_PRE_B, 0, bid, nb, dyn_smem); grid.sync();
  run_phase(p, PH_INIT, 0, bid, nb, dyn_smem); grid.sync();
  for (int l = 0; l < NLAYER; ++l) {
    run_phase(p, PH_GEMM_IN, l, bid, nb, dyn_smem); grid.sync();
    run_phase(p, PH_ELEM, l, bid, nb, dyn_smem); grid.sync();
    run_phase(p, PH_RET_UPD, l, bid, nb, dyn_smem); grid.sync();
    run_phase(p, PH_RET_SCAN, l, bid, nb, dyn_smem); grid.sync();
    run_phase(p, PH_RET_OUT, l, bid, nb, dyn_smem); grid.sync();
    run_phase(p, PH_GNORM, l, bid, nb, dyn_smem); grid.sync();
    run_phase(p, PH_GEMM_OUT, l, bid, nb, dyn_smem); grid.sync();
    run_phase(p, PH_LN1, l, bid, nb, dyn_smem); grid.sync();
    run_phase(p, PH_GEMM_WK, l, bid, nb, dyn_smem); grid.sync();
    run_phase(p, PH_TOPK1, l, bid, nb, dyn_smem); grid.sync();
    run_phase(p, PH_TOPK2, l, bid, nb, dyn_smem); grid.sync();
    run_phase(p, PH_GATHER, l, bid, nb, dyn_smem); grid.sync();
    run_phase(p, PH_LN2, l, bid, nb, dyn_smem);
    if (l + 1 < NLAYER) grid.sync();
  }
}

__global__ void k_dump_bf16(const bf16_t* src, float* out, size_t n) {
  for (size_t i = (size_t)blockIdx.x * 256 + threadIdx.x; i < n; i += (size_t)gridDim.x * 256) out[i] = bf2f(src[i]);
}
__global__ void k_dump_cols(const bf16_t* src, int ld, int col0, float* out, size_t n) {
  for (size_t i = (size_t)blockIdx.x * 256 + threadIdx.x; i < n; i += (size_t)gridDim.x * 256) out[i] = bf2f(src[(i >> 10) * ld + col0 + (i & 1023)]);
}
__global__ void k_dump_hash(const uint32_t* src, size_t nwords, float* out, size_t nout, float scale) {
  __shared__ uint32_t red[256];
  const size_t L = (nwords + 1023) / 1024;
  const size_t b0 = (size_t)blockIdx.x * L;
  uint32_t h = 0;
  for (size_t i = threadIdx.x; i < L; i += 256) {
    const size_t j = b0 + i;
    if (j < nwords) h += (src[j] ^ 0x9e3779b9u) * (uint32_t)(2654435761u * (uint32_t)(i + 1) + 12345u);
  }
  red[threadIdx.x] = h;
  __syncthreads();
  for (int o = 128; o > 0; o >>= 1) { if ((int)threadIdx.x < o) red[threadIdx.x] += red[threadIdx.x + o]; __syncthreads(); }
  uint32_t hh = red[0];
  hh ^= hh >> 16; hh *= 0x85ebca6bu; hh ^= hh >> 13;
  const float v = scale * (float)(1u + (hh & 255u));
  const size_t per = nout / 1024;
  for (size_t i = threadIdx.x; i < per; i += 256) out[(size_t)blockIdx.x * per + i] = v;
}
__global__ void k_fill(float* out, size_t n, float v) {
  for (size_t i = (size_t)blockIdx.x * 256 + threadIdx.x; i < n; i += (size_t)gridDim.x * 256) out[i] = v;
}
__global__ void k_dump_f32(const float* src, float* out, size_t n) {
  for (size_t i = (size_t)blockIdx.x * 256 + threadIdx.x; i < n; i += (size_t)gridDim.x * 256) out[i] = src[i];
}
static inline size_t al256(size_t v) { return (v + 255) & ~(size_t)255; }

extern "C" void kernel_launch(void* const* d_in, const int* in_sizes, int n_in, void* d_out, int out_size, void* d_ws,
                              size_t ws_size, hipStream_t stream) {
  static int grid = 0, mgrid = 0;
  if (grid == 0) {
    int dev = 0, cus = 0, per_cu = 0;
    (void)hipGetDevice(&dev);
    (void)hipDeviceGetAttribute(&cus, hipDeviceAttributeMultiprocessorCount, dev);
#define SETATTR(PH) (void)hipFuncSetAttribute((const void*)k_phase<PH>, hipFuncAttributeMaxDynamicSharedMemorySize, SMEM_BYTES);
    SETATTR(0) SETATTR(1) SETATTR(2) SETATTR(3) SETATTR(4) SETATTR(5) SETATTR(6) SETATTR(7) SETATTR(8) SETATTR(9)
    SETATTR(10) SETATTR(11) SETATTR(12) SETATTR(13) SETATTR(14) SETATTR(15)
    if (cus <= 0) cus = 256;
    grid = cus * 2;
    (void)hipFuncSetAttribute((const void*)k_mega, hipFuncAttributeMaxDynamicSharedMemorySize, SMEM_BYTES);
    if (hipOccupancyMaxActiveBlocksPerMultiprocessor(&per_cu, (const void*)k_mega, 256, SMEM_BYTES) != hipSuccess || per_cu < 1) per_cu = 1;
    if (per_cu > 2) per_cu = 2;
    mgrid = cus * per_cu;
  }
  Params p{};
  p.x = (const float*)d_in[0]; p.c = (const float*)d_in[1]; p.ctx = (const float*)d_in[2]; p.c_ctx = (const float*)d_in[3];
  p.w_mod = (const float*)d_in[4]; p.b_mod = (const float*)d_in[5]; p.w_in = (const float*)d_in[6]; p.conv_w = (const float*)d_in[7];
  p.w_out = (const float*)d_in[8]; p.ln1_g = (const float*)d_in[9]; p.ln1_b = (const float*)d_in[10]; p.peer_wq = (const float*)d_in[11];
  p.peer_keys = (const float*)d_in[12]; p.peer_u = (const float*)d_in[13]; p.peer_v = (const float*)d_in[14];
  p.ln2_g = (const float*)d_in[15]; p.ln2_b = (const float*)d_in[16];
  p.out = (float*)d_out;
  char* w = (char*)d_ws; size_t off = 0;
  auto take = [&](size_t bytes) { char* r = w + off; off = al256(off + bytes); return r; };
  p.xres = (float*)take((size_t)TT * DM * 4);
  p.hA = (bf16_t*)take((size_t)TT * DM * 2);
  p.big = take((size_t)TT * 2048 * 4);
  p.cat = (bf16_t*)take((size_t)TT * DM * 2);
  p.st = (float*)take((size_t)2 * NCHUNK * 4 * 16384 * 4);
  p.ybuf = (float*)take((size_t)TT * DM * 4);
  p.w_inT = (bf16_t*)take((size_t)NLAYER * NPROJ * DM * 2);
  p.w_outT = (bf16_t*)take((size_t)NLAYER * DM * DM * 2);
  p.wkT = (bf16_t*)take((size_t)NLAYER * 2048 * DM * 2);
  p.ubf = (bf16_t*)take((size_t)NEXP * DM * 2);
  p.vbf = (bf16_t*)take((size_t)NEXP * DM * 2);
  p.mod = (float*)take((size_t)4 * 5 * 6144 * 4);
  p.modp = (float*)take((size_t)8 * 4 * 5 * 6144 * 4);
  p.ropec = (float*)take(128 * 32 * 4);
  p.ropes = (float*)take(128 * 32 * 4);
  p.bar = (unsigned*)take(256);
  p.pad0 = nullptr;
  {
    char* a = (char*)p.st; size_t o2 = 0;
    p.sv = (float*)(a + o2); o2 = al256(o2 + (size_t)TT * 256 * 4);
    p.si = (unsigned char*)(a + o2); o2 = al256(o2 + (size_t)TT * 256);
    p.pe = (int*)(a + o2); o2 = al256(o2 + (size_t)TT * 128 * 4);
    p.pg = (float*)(a + o2); o2 = al256(o2 + (size_t)TT * 128 * 4);
  }
  for (int d = 0; d < 2; ++d)
    for (int h = 0; h < 4; ++h) p.lg2[d][h] = (float)log2(1.0 - exp2(-(5.0 + 0.5 * d + (double)h)));
  if (off > ws_size) { fprintf(stderr, "kernel_launch: workspace too small: need %zu have %zu\n", off, ws_size); return; }

#if MEGA
  {
    void* args[] = {(void*)&p};
    hipError_t e = hipLaunchCooperativeKernel((const void*)k_mega, dim3(mgrid), dim3(256), args, SMEM_BYTES, stream);
    if (e != hipSuccess) fprintf(stderr, "kernel_launch: cooperative launch failed: %s (grid %d)\n", hipGetErrorString(e), mgrid);
    return;
  }
#endif
#define launch(PH, L) hipLaunchKernelGGL(k_phase<PH>, dim3(grid), dim3(256), SMEM_BYTES, stream, p, (int)(L))
  const size_t HR = ((size_t)TL * DM / 8) & ~(size_t)1023;
#define HASH(K, PTR, BYTES) if (DBG_STOP == 20) hipLaunchKernelGGL(k_dump_hash, dim3(1024), dim3(256), 0, stream, (const uint32_t*)(PTR), (size_t)(BYTES) / 4, p.out + (size_t)(K) * HR, HR, ((DBG_HMASK >> (K)) & 1) ? 1.0f : 0.0f)
  if (DBG_STOP == 20) hipLaunchKernelGGL(k_fill, dim3(1024), dim3(256), 0, stream, p.out, (size_t)TL * DM, 0.f);
  launch(PH_PRE_A, 0);
  launch(PH_PRE_B, 0);
  launch(PH_INIT, 0);
  HASH(0, p.hA, (size_t)TT * DM * 2);
  HASH(1, p.w_inT, (size_t)NPROJ * DM * 2);
  for (int l = 0; l < NLAYER; ++l) {
    launch(PH_GEMM_IN, l);
    if (l == 0) HASH(2, p.big, (size_t)TT * NPROJ * 2);
    if (DBG_STOP == 6) { hipLaunchKernelGGL(k_dump_bf16, dim3(1024), dim3(256), 0, stream, (const bf16_t*)p.big, p.out, (size_t)TL * DM); return; }
    launch(PH_ELEM, l);
    if (l == 0) HASH(3, p.big, (size_t)TT * NPROJ * 2);
    if (DBG_STOP == 12) { hipLaunchKernelGGL(k_dump_cols, dim3(1024), dim3(256), 0, stream, (const bf16_t*)p.big, NPROJ, 1536, p.out, (size_t)TL * DM); return; }
    if (DBG_STOP == 13) { hipLaunchKernelGGL(k_dump_cols, dim3(1024), dim3(256), 0, stream, (const bf16_t*)p.big, NPROJ, 2560, p.out, (size_t)TL * DM); return; }
    if (DBG_STOP == 7) { hipLaunchKernelGGL(k_dump_bf16, dim3(1024), dim3(256), 0, stream, (const bf16_t*)p.big, p.out, (size_t)TL * DM); return; }
    launch(PH_RET_UPD, l);
    if (l == 0) HASH(4, p.st, (size_t)2 * NCHUNK * 4 * 16384 * 4);
    if (DBG_STOP == 8) { hipLaunchKernelGGL(k_dump_f32, dim3(1024), dim3(256), 0, stream, p.st, p.out, (size_t)TL * DM); return; }
    launch(PH_RET_SCAN, l);
    if (l == 0) HASH(5, p.ybuf, (size_t)2 * NCHUNK * 4 * 16384 * 4);
    if (DBG_STOP == 10) { hipLaunchKernelGGL(k_dump_f32, dim3(1024), dim3(256), 0, stream, p.st + (size_t)NCHUNK * 4 * 16384, p.out, (size_t)TL * DM); return; }
    if (DBG_STOP == 11) { hipLaunchKernelGGL(k_dump_f32, dim3(1024), dim3(256), 0, stream, p.st + (size_t)200 * 4 * 16384, p.out, (size_t)TL * DM); return; }
    if (DBG_STOP == 9) { hipLaunchKernelGGL(k_dump_f32, dim3(1024), dim3(256), 0, stream, p.st, p.out, (size_t)TL * DM); return; }
    launch(PH_RET_OUT, l);
    launch(PH_GNORM, l);
    if (l == 0) HASH(6, p.cat, (size_t)TT * DM * 2);
    if (DBG_STOP == 20) return;
    if (DBG_STOP == 1) { hipLaunchKernelGGL(k_dump_bf16, dim3(1024), dim3(256), 0, stream, p.cat, p.out, (size_t)TL * DM); return; }
    launch(PH_GEMM_OUT, l);
    launch(PH_LN1, l);
    if (DBG_STOP == 2) { hipLaunchKernelGGL(k_dump_f32, dim3(1024), dim3(256), 0, stream, p.xres, p.out, (size_t)TL * DM); return; }
    launch(PH_GEMM_WK, l);
    launch(PH_TOPK1, l);
    launch(PH_TOPK2, l);
    launch(PH_GATHER, l);
    if (DBG_STOP == 3) { hipLaunchKernelGGL(k_dump_f32, dim3(1024), dim3(256), 0, stream, p.ybuf, p.out, (size_t)TL * DM); return; }
    launch(PH_LN2, l);
    if (DBG_STOP == 4) { hipLaunchKernelGGL(k_dump_f32, dim3(1024), dim3(256), 0, stream, p.xres, p.out, (size_t)TL * DM); return; }
  }
}
```

```cpp
#include <hip/hip_runtime.h>
#include <hip/hip_cooperative_groups.h>
#include <stdint.h>
#include <math.h>
#include <stdio.h>
#include <utility>
#include <type_traits>

namespace cg = cooperative_groups;

typedef unsigned short bf16_t;
using bf16x8 = __attribute__((ext_vector_type(8))) short;
using s16x4 = __attribute__((ext_vector_type(4))) short;
using f32x4 = __attribute__((ext_vector_type(4))) float;

#define DM 1024
#define NB 4
#define SEQ 8192
#define TL 32768
#define TC 1024
#define TT 33792
#define NCHUNK 264
#define NPROJ 3584
#define NLAYER 4
#define NEXP 16384
#define ALPHA_F 1.681792830507429f
#define SMEM_BYTES 53248
#ifndef MEGA
#define MEGA 1
#endif
#ifndef DBG_HMASK
#define DBG_HMASK 0x40
#endif
#ifndef DBG_RO
#define DBG_RO 0
#endif
#ifndef DBG_STOP
#define DBG_STOP 0
#endif

struct Params {
  const float *x, *c, *ctx, *c_ctx, *w_mod, *b_mod, *w_in, *conv_w, *w_out, *ln1_g, *ln1_b;
  const float *peer_wq, *peer_keys, *peer_u, *peer_v, *ln2_g, *ln2_b;
  float* out;
  float* xres; bf16_t* hA; char* big; bf16_t* cat; float* st; float* ybuf;
  bf16_t *w_inT, *w_outT, *wkT, *ubf, *vbf;
  float* sv; unsigned char* si; int* pe; float* pg;
  float *mod, *modp, *ropec, *ropes;
  unsigned* bar; unsigned* pad0;
  float lg2[2][4];
};

__device__ __forceinline__ bf16_t f2bf(float f) {
  uint32_t u = __float_as_uint(f);
  u += 0x7fffu + ((u >> 16) & 1u);
  return (bf16_t)(u >> 16);
}
__device__ __forceinline__ float bf2f(bf16_t b) { return __uint_as_float(((uint32_t)b) << 16); }
__device__ __forceinline__ uint32_t pack2(float a, float b) { return (uint32_t)f2bf(a) | ((uint32_t)f2bf(b) << 16); }
__device__ __forceinline__ float bflo(uint32_t w) { return __uint_as_float(w << 16); }
__device__ __forceinline__ float bfhi(uint32_t w) { return __uint_as_float(w & 0xffff0000u); }
__device__ __forceinline__ float wave_sum(float v) {
#pragma unroll
  for (int o = 32; o > 0; o >>= 1) v += __shfl_xor(v, o);
  return v;
}
__device__ __forceinline__ float row16_sum(float v) {
  v += __builtin_bit_cast(float, __builtin_amdgcn_update_dpp(0, __builtin_bit_cast(int, v), 0xB1, 0xF, 0xF, true));
  v += __builtin_bit_cast(float, __builtin_amdgcn_update_dpp(0, __builtin_bit_cast(int, v), 0x4E, 0xF, 0xF, true));
  v += __builtin_bit_cast(float, __builtin_amdgcn_update_dpp(0, __builtin_bit_cast(int, v), 0x141, 0xF, 0xF, true));
  v += __builtin_bit_cast(float, __builtin_amdgcn_update_dpp(0, __builtin_bit_cast(int, v), 0x140, 0xF, 0xF, true));
  return v;
}
__device__ __forceinline__ float silu_f(float v) { return v * __builtin_amdgcn_rcpf(1.f + __expf(-v)); }
__device__ __forceinline__ int mod_row(int t) { return t < TL ? (t >> 13) : 4; }

__device__ __forceinline__ f32x4 zero4() { f32x4 a = {0.f, 0.f, 0.f, 0.f}; asm volatile("" : "+v"(a)); return a; }

__device__ __forceinline__ int opaque_tid() { int t = threadIdx.x; asm volatile("" : "+v"(t)); return t; }
__device__ __forceinline__ int opaque_s(int v) { v = __builtin_amdgcn_readfirstlane(v); asm volatile("" : "+s"(v)); return v; }

template <class F, int... I>
__device__ __forceinline__ void static_for_impl(F&& f, std::integer_sequence<int, I...>) { (f(std::integral_constant<int, I>{}), ...); }
template <int N, class F>
__device__ __forceinline__ void static_for(F&& f) { static_for_impl(f, std::make_integer_sequence<int, N>{}); }

__device__ __forceinline__ unsigned tr_lane_base(unsigned base, unsigned ld, unsigned lane) {
  const unsigned g = lane >> 4, q = (lane & 15u) >> 2, p = lane & 3u;
  return base + (8u * g + q) * ld + 8u * p;
}
template <int O0, int O1, int O2, int O3, int D>
__device__ __forceinline__ void tr_frag4(unsigned a, bf16x8& f0, bf16x8& f1, bf16x8& f2, bf16x8& f3) {
  s16x4 r0, r1, r2, r3, r4, r5, r6, r7;
  asm volatile(
      "ds_read_b64_tr_b16 %0, %8 offset:%9\n\t"
      "ds_read_b64_tr_b16 %1, %8 offset:%10\n\t"
      "ds_read_b64_tr_b16 %2, %8 offset:%11\n\t"
      "ds_read_b64_tr_b16 %3, %8 offset:%12\n\t"
      "ds_read_b64_tr_b16 %4, %8 offset:%13\n\t"
      "ds_read_b64_tr_b16 %5, %8 offset:%14\n\t"
      "ds_read_b64_tr_b16 %6, %8 offset:%15\n\t"
      "ds_read_b64_tr_b16 %7, %8 offset:%16\n\t"
      "s_waitcnt lgkmcnt(0)"
      : "=&v"(r0), "=&v"(r1), "=&v"(r2), "=&v"(r3), "=&v"(r4), "=&v"(r5), "=&v"(r6), "=&v"(r7)
      : "v"(a), "n"(O0), "n"(O0 + D), "n"(O1), "n"(O1 + D), "n"(O2), "n"(O2 + D), "n"(O3), "n"(O3 + D)
      : "memory");
  f0 = __builtin_shufflevector(r0, r1, 0, 1, 2, 3, 4, 5, 6, 7);
  f1 = __builtin_shufflevector(r2, r3, 0, 1, 2, 3, 4, 5, 6, 7);
  f2 = __builtin_shufflevector(r4, r5, 0, 1, 2, 3, 4, 5, 6, 7);
  f3 = __builtin_shufflevector(r6, r7, 0, 1, 2, 3, 4, 5, 6, 7);
}

__device__ __forceinline__ void ph_mod_partial(const Params& p, int bid, int nb, char* smem) {
  const int TIX = opaque_tid(); bid = opaque_s(bid);
  float* sm = (float*)smem;
  const int tid = TIX;
  for (int item = bid; item < 4 * 24 * 8; item += nb) {
    const int ks = item & 7, cb = (item >> 3) % 24, l = item / 192;
    __syncthreads();
    for (int idx = tid; idx < 640; idx += 256) {
      const int r = idx >> 7, k = ks * 128 + (idx & 127);
      const float v = (r < 4) ? p.c[r * DM + k] : p.c_ctx[k];
      sm[idx] = silu_f(v);
    }
    __syncthreads();
    const int col = cb * 256 + tid;
    float acc[5] = {0.f, 0.f, 0.f, 0.f, 0.f};
    const float* w = p.w_mod + ((size_t)l * DM + ks * 128) * 6144 + col;
#pragma unroll 4
    for (int k = 0; k < 128; ++k) {
      const float wv = w[(size_t)k * 6144];
#pragma unroll
      for (int r = 0; r < 5; ++r) acc[r] += sm[r * 128 + k] * wv;
    }
#pragma unroll
    for (int r = 0; r < 5; ++r) p.modp[((size_t)(ks * 4 + l) * 5 + r) * 6144 + col] = acc[r];
  }
}

__device__ __forceinline__ void ph_mod_reduce(const Params& p, int bid, int nb) {
  const int TIX = opaque_tid(); bid = opaque_s(bid);
  const int gtid = bid * 256 + TIX, gn = nb * 256;
  for (int idx = gtid; idx < 4 * 5 * 6144; idx += gn) {
    const int l = idx / (5 * 6144), col = idx % 6144;
    float s = p.b_mod[l * 6144 + col];
#pragma unroll
    for (int ks = 0; ks < 8; ++ks) s += p.modp[(size_t)ks * (4 * 5 * 6144) + idx];
    p.mod[idx] = s;
  }
  for (int idx = gtid; idx < 128 * 32; idx += gn) {
    const int pos = idx >> 5, d = idx & 31;
    const float inv = exp2f(-(float)d * (13.287712379549449f / 32.f));
    const float angf = (float)pos * inv;
    const double a = (double)angf;
    const double kk = rint(a * 0.15915494309189535);
    const double r = a - kk * 6.283185307179586;
    const double r2 = r * r;
    double sn = 1.0, cs = 1.0;
    for (int n = 13; n >= 1; --n) {
      sn = 1.0 - sn * r2 / (double)((2 * n) * (2 * n + 1));
      cs = 1.0 - cs * r2 / (double)((2 * n - 1) * (2 * n));
    }
    p.ropec[idx] = (float)cs;
    p.ropes[idx] = (float)(r * sn);
  }
}

__device__ __forceinline__ void ph_transpose_cvt(const float* src, bf16_t* dst, int K, int N, int bid, int nb, char* smem) {
  const int TIX = opaque_tid(); bid = opaque_s(bid);
  float* tile = (float*)smem;
  const int tid = TIX;
  const int ntn = N >> 6, ntk = K >> 6;
  for (int item = bid; item < ntn * ntk; item += nb) {
    const int kt = item / ntn, nt = item % ntn;
    __syncthreads();
#pragma unroll
    for (int i = 0; i < 4; ++i) {
      const int r = (tid >> 4) + 16 * i, c4 = (tid & 15) * 4;
      const float4 v = *(const float4*)(src + (size_t)(kt * 64 + r) * N + nt * 64 + c4);
      tile[r * 65 + c4 + 0] = v.x; tile[r * 65 + c4 + 1] = v.y; tile[r * 65 + c4 + 2] = v.z; tile[r * 65 + c4 + 3] = v.w;
    }
    __syncthreads();
    const int n = tid >> 2, kseg = (tid & 3) * 16;
    uint32_t w[8];
#pragma unroll
    for (int e = 0; e < 8; ++e) w[e] = pack2(tile[(kseg + 2 * e) * 65 + n], tile[(kseg + 2 * e + 1) * 65 + n]);
    uint4* d = (uint4*)(dst + (size_t)(nt * 64 + n) * K + kt * 64 + kseg);
    d[0] = make_uint4(w[0], w[1], w[2], w[3]);
    d[1] = make_uint4(w[4], w[5], w[6], w[7]);
  }
}

__device__ __forceinline__ void ph_wk_fold(const Params& p, int bid, int nb, char* smem) {
  const int TIX = opaque_tid(); bid = opaque_s(bid);
  float* wq_s = (float*)smem;
  float* key_s = wq_s + 64 * 65;
  const int tid = TIX;
  const int tc = tid >> 4, tn = tid & 15;
  for (int item = bid; item < 4 * 16 * 16; item += nb) {
    const int ct = item & 15, hp = (item >> 4) & 15, l = item >> 8;
    float acc[4][8];
#pragma unroll
    for (int a = 0; a < 4; ++a)
#pragma unroll
      for (int b = 0; b < 8; ++b) acc[a][b] = 0.f;
    for (int dh = 0; dh < 2; ++dh) {
      __syncthreads();
#pragma unroll
      for (int i = 0; i < 4; ++i) {
        const int r = (tid >> 4) + 16 * i, c4 = (tid & 15) * 4;
        const float4 v = *(const float4*)(p.peer_wq + ((size_t)l * DM + ct * 64 + r) * 2048 + hp * 128 + dh * 64 + c4);
        wq_s[r * 65 + c4 + 0] = v.x; wq_s[r * 65 + c4 + 1] = v.y; wq_s[r * 65 + c4 + 2] = v.z; wq_s[r * 65 + c4 + 3] = v.w;
      }
#pragma unroll
      for (int i = 0; i < 8; ++i) {
        const int r = (tid >> 4) + 16 * i, c4 = (tid & 15) * 4;
        const float4 v = *(const float4*)(p.peer_keys + (((size_t)l * 2 + (hp & 1)) * 128 + r) * 128 + dh * 64 + c4);
        key_s[r * 65 + c4 + 0] = v.x; key_s[r * 65 + c4 + 1] = v.y; key_s[r * 65 + c4 + 2] = v.z; key_s[r * 65 + c4 + 3] = v.w;
      }
      __syncthreads();
#pragma unroll 4
      for (int d = 0; d < 64; ++d) {
        float av[4], bv[8];
#pragma unroll
        for (int a = 0; a < 4; ++a) av[a] = wq_s[(tc * 4 + a) * 65 + d];
#pragma unroll
        for (int b = 0; b < 8; ++b) bv[b] = key_s[(tn + 16 * b) * 65 + d];
#pragma unroll
        for (int a = 0; a < 4; ++a)
#pragma unroll
          for (int b = 0; b < 8; ++b) acc[a][b] += av[a] * bv[b];
      }
    }
#pragma unroll
    for (int b = 0; b < 8; ++b) {
      const int row = hp * 128 + tn + 16 * b;
      uint2 o;
      o.x = pack2(acc[0][b], acc[1][b]);
      o.y = pack2(acc[2][b], acc[3][b]);
      *(uint2*)(p.wkT + ((size_t)l * 2048 + row) * DM + ct * 64 + tc * 4) = o;
    }
  }
}

#define SCALE_U 128.f
#define SCALE_V 8.f
__device__ __forceinline__ uint32_t pack_fp8x4(float a, float b, float c, float d) {
  int w = 0;
  w = __builtin_amdgcn_cvt_pk_fp8_f32(a, b, w, false);
  w = __builtin_amdgcn_cvt_pk_fp8_f32(c, d, w, true);
  return (uint32_t)w;
}
__device__ __forceinline__ void ph_cvt_uv(const Params& p, int l, int bid, int nb) {
  const int TIX = opaque_tid(); bid = opaque_s(bid);
  const size_t n16 = (size_t)NEXP * DM / 16;
  const float* su = p.peer_u + (size_t)l * NEXP * DM;
  const float* sv = p.peer_v + (size_t)l * NEXP * DM;
  for (size_t i = (size_t)bid * 256 + TIX; i < 2 * n16; i += (size_t)nb * 256) {
    const bool isv = i >= n16;
    const size_t j = isv ? i - n16 : i;
    const float sc = isv ? SCALE_V : SCALE_U;
    const float4* s4 = (const float4*)((isv ? sv : su) + j * 16);
    const float4 a0 = s4[0], a1 = s4[1], a2 = s4[2], a3 = s4[3];
    uint4 o;
    o.x = pack_fp8x4(a0.x * sc, a0.y * sc, a0.z * sc, a0.w * sc);
    o.y = pack_fp8x4(a1.x * sc, a1.y * sc, a1.z * sc, a1.w * sc);
    o.z = pack_fp8x4(a2.x * sc, a2.y * sc, a2.z * sc, a2.w * sc);
    o.w = pack_fp8x4(a3.x * sc, a3.y * sc, a3.z * sc, a3.w * sc);
    *(uint4*)((unsigned char*)(isv ? p.vbf : p.ubf) + j * 16) = o;
  }
}

__device__ __forceinline__ void ph_init_h(const Params& p, int bid, int nb) {
  const int TIX = opaque_tid(); bid = opaque_s(bid);
  const int lane = TIX & 63;
  const int gw = bid * 4 + (TIX >> 6), nw = nb * 4;
  for (int t = gw; t < TT; t += nw) {
    const float* xr = t < TL ? p.x + (size_t)t * DM : p.ctx + (size_t)(t - TL) * DM;
    const float* m = p.mod + (size_t)(0 * 5 + mod_row(t)) * 6144;
#pragma unroll
    for (int i = 0; i < 4; ++i) {
      const int col = lane * 4 + 256 * i;
      const float4 v = *(const float4*)(xr + col);
      const float4 sh = *(const float4*)(m + col);
      const float4 sc = *(const float4*)(m + 1024 + col);
      uint2 o;
      o.x = pack2(v.x * (1.f + sc.x) + sh.x, v.y * (1.f + sc.y) + sh.y);
      o.y = pack2(v.z * (1.f + sc.z) + sh.z, v.w * (1.f + sc.w) + sh.w);
      *(uint2*)(p.hA + (size_t)t * DM + col) = o;
    }
  }
}

template <bool OUT_BF16>
__device__ __forceinline__ void ph_gemm(const bf16_t* __restrict__ A, const bf16_t* __restrict__ Bt, void* Cout, int M, int N, int K,
                        int bid, int nb, char* smem) {
  const int TIX = opaque_tid(); bid = opaque_s(bid);
  bf16_t* As = (bf16_t*)smem;
  bf16_t* Bs = As + 2 * 128 * 40;
  const int tid = TIX, lane = tid & 63, wave = tid >> 6;
  const int wm = wave >> 1, wn = wave & 1;
  const int ntn = N >> 7, ntm = M >> 7;
  const int nk = K >> 5;
  for (int tile = bid; tile < ntn * ntm; tile += nb) {
    const int m0 = (tile / ntn) << 7, n0 = (tile % ntn) << 7;
    f32x4 acc[4][4];
#pragma unroll
    for (int i = 0; i < 4; ++i)
#pragma unroll
      for (int j = 0; j < 4; ++j) acc[i][j] = zero4();
    uint4 ra[2], rb[2];
    const int lrow0 = tid >> 2, lkc = (tid & 3) * 8;
    const bf16_t* ga = A + (size_t)(m0 + lrow0) * K + lkc;
    const bf16_t* gb = Bt + (size_t)(n0 + lrow0) * K + lkc;
    __syncthreads();
    ra[0] = *(const uint4*)(ga); ra[1] = *(const uint4*)(ga + (size_t)64 * K);
    rb[0] = *(const uint4*)(gb); rb[1] = *(const uint4*)(gb + (size_t)64 * K);
    *(uint4*)(As + lrow0 * 40 + lkc) = ra[0]; *(uint4*)(As + (lrow0 + 64) * 40 + lkc) = ra[1];
    *(uint4*)(Bs + lrow0 * 40 + lkc) = rb[0]; *(uint4*)(Bs + (lrow0 + 64) * 40 + lkc) = rb[1];
    __syncthreads();
    for (int kt = 0; kt < nk; ++kt) {
      const int cur = kt & 1;
      if (kt + 1 < nk) {
        ra[0] = *(const uint4*)(ga + (kt + 1) * 32); ra[1] = *(const uint4*)(ga + (size_t)64 * K + (kt + 1) * 32);
        rb[0] = *(const uint4*)(gb + (kt + 1) * 32); rb[1] = *(const uint4*)(gb + (size_t)64 * K + (kt + 1) * 32);
      }
      const bf16_t* as = As + cur * 128 * 40 + (wm * 64 + (lane & 15)) * 40 + (lane >> 4) * 8;
      const bf16_t* bs = Bs + cur * 128 * 40 + (wn * 64 + (lane & 15)) * 40 + (lane >> 4) * 8;
      bf16x8 af[4], bfr[4];
#pragma unroll
      for (int i = 0; i < 4; ++i) af[i] = *(const bf16x8*)(as + i * 16 * 40);
#pragma unroll
      for (int j = 0; j < 4; ++j) bfr[j] = *(const bf16x8*)(bs + j * 16 * 40);
#pragma unroll
      for (int i = 0; i < 4; ++i)
#pragma unroll
        for (int j = 0; j < 4; ++j) acc[i][j] = __builtin_amdgcn_mfma_f32_16x16x32_bf16(af[i], bfr[j], acc[i][j], 0, 0, 0);
      if (kt + 1 < nk) {
        const int nx = cur ^ 1;
        *(uint4*)(As + nx * 128 * 40 + lrow0 * 40 + lkc) = ra[0]; *(uint4*)(As + nx * 128 * 40 + (lrow0 + 64) * 40 + lkc) = ra[1];
        *(uint4*)(Bs + nx * 128 * 40 + lrow0 * 40 + lkc) = rb[0]; *(uint4*)(Bs + nx * 128 * 40 + (lrow0 + 64) * 40 + lkc) = rb[1];
      }
      __syncthreads();
    }
#pragma unroll
    for (int i = 0; i < 4; ++i)
#pragma unroll
      for (int j = 0; j < 4; ++j)
#pragma unroll
        for (int r = 0; r < 4; ++r) {
          const int row = m0 + wm * 64 + i * 16 + (lane >> 4) * 4 + r;
          const int col = n0 + wn * 64 + j * 16 + (lane & 15);
          if (OUT_BF16) ((bf16_t*)Cout)[(size_t)row * N + col] = f2bf(acc[i][j][r]);
          else ((float*)Cout)[(size_t)row * N + col] = acc[i][j][r];
        }
  }
}

__device__ __forceinline__ void ph_elem(const Params& p, int l, int bid, int nb) {
  const int TIX = opaque_tid(); bid = opaque_s(bid);
  bf16_t* proj = (bf16_t*)p.big;
  const int tid = TIX;
  const int sub = tid & 127;
  for (int tp = bid; tp < TT / 2; tp += nb) {
    const int t = tp * 2 + (tid >> 7);
    bf16_t* row = proj + (size_t)t * NPROJ;
    if (sub < 64) {
      const int ch = sub * 8;
      bool hasl, hasr;
      if (t < TL) { const int i = t & 63; hasl = i != 0; hasr = i != 63; }
      else { const int i = (t - TL) & 255; hasl = i != 0; hasr = i != 255; }
      const uint4 bg = *(const uint4*)(row + ch);
      const uint4 c1 = *(const uint4*)(row + 512 + ch), h1 = *(const uint4*)(row + 1024 + ch);
      uint4 c0 = make_uint4(0, 0, 0, 0), h0 = c0, c2 = c0, h2 = c0;
      if (hasl) { c0 = *(const uint4*)(row - NPROJ + 512 + ch); h0 = *(const uint4*)(row - NPROJ + 1024 + ch); }
      if (hasr) { c2 = *(const uint4*)(row + NPROJ + 512 + ch); h2 = *(const uint4*)(row + NPROJ + 1024 + ch); }
      const uint32_t bgw[4] = {bg.x, bg.y, bg.z, bg.w};
      const uint32_t c0w[4] = {c0.x, c0.y, c0.z, c0.w}, c1w[4] = {c1.x, c1.y, c1.z, c1.w}, c2w[4] = {c2.x, c2.y, c2.z, c2.w};
      const uint32_t h0w[4] = {h0.x, h0.y, h0.z, h0.w}, h1w[4] = {h1.x, h1.y, h1.z, h1.w}, h2w[4] = {h2.x, h2.y, h2.z, h2.w};
      const float* cw = p.conv_w + ((size_t)l * 512 + ch) * 3;
      uint32_t ow[4];
#pragma unroll
      for (int e = 0; e < 4; ++e) {
        const float z0a = bflo(c0w[e]) * bflo(h0w[e]), z1a = bflo(c1w[e]) * bflo(h1w[e]), z2a = bflo(c2w[e]) * bflo(h2w[e]);
        const float z0b = bfhi(c0w[e]) * bfhi(h0w[e]), z1b = bfhi(c1w[e]) * bfhi(h1w[e]), z2b = bfhi(c2w[e]) * bfhi(h2w[e]);
        const float* wa = cw + (2 * e) * 3;
        const float ya = z0a * wa[0] + z1a * wa[1] + z2a * wa[2];
        const float yb = z0b * wa[3] + z1b * wa[4] + z2b * wa[5];
        ow[e] = pack2(bflo(bgw[e]) * ya, bfhi(bgw[e]) * yb);
      }
      *(uint4*)(p.cat + (size_t)t * DM + ch) = make_uint4(ow[0], ow[1], ow[2], ow[3]);
    } else {
      const int it = sub - 64;
      const int hd = it >> 4, isk = (it >> 3) & 1, half = (it >> 2) & 1, dg = it & 3;
      bf16_t* b1 = row + 1536 + isk * 512 + hd * 128 + half * 64 + dg * 8;
      const uint4 u1 = *(const uint4*)b1, u2 = *(const uint4*)(b1 + 32);
      const uint32_t u1w[4] = {u1.x, u1.y, u1.z, u1.w}, u2w[4] = {u2.x, u2.y, u2.z, u2.w};
      const float scl = isk ? 0.08838834764831845f : 1.f;
      float cs[8], sn[8];
      if (t < TL) {
        const int i = t & 8191;
        const int pos = half ? (i & 63) : (i >> 6);
#pragma unroll
        for (int e = 0; e < 8; ++e) { cs[e] = p.ropec[pos * 32 + dg * 8 + e]; sn[e] = p.ropes[pos * 32 + dg * 8 + e]; }
      } else {
#pragma unroll
        for (int e = 0; e < 8; ++e) { cs[e] = 1.f; sn[e] = 0.f; }
      }
      uint32_t o1[4], o2[4];
#pragma unroll
      for (int e = 0; e < 4; ++e) {
        const float a0 = bflo(u1w[e]), a1 = bfhi(u1w[e]), b0 = bflo(u2w[e]), b1v = bfhi(u2w[e]);
        o1[e] = pack2((a0 * cs[2 * e] - b0 * sn[2 * e]) * scl, (a1 * cs[2 * e + 1] - b1v * sn[2 * e + 1]) * scl);
        o2[e] = pack2((a0 * sn[2 * e] + b0 * cs[2 * e]) * scl, (a1 * sn[2 * e + 1] + b1v * cs[2 * e + 1]) * scl);
      }
      *(uint4*)b1 = make_uint4(o1[0], o1[1], o1[2], o1[3]);
      *(uint4*)(b1 + 32) = make_uint4(o2[0], o2[1], o2[2], o2[3]);
    }
  }
}

__device__ __forceinline__ void ph_ret_upd(const Params& p, int bid, int nb, char* smem) {
  const int TIX = opaque_tid(); bid = opaque_s(bid);
  const bf16_t* proj = (const bf16_t*)p.big;
  bf16_t* Vs = (bf16_t*)smem;
  bf16_t* Ks = Vs + 64 * 136;
  const int tid = TIX, lane = tid & 63, wave = tid >> 6;
  const int wm = wave >> 1, wn = wave & 1;
  const unsigned va = tr_lane_base((unsigned)(size_t)Vs, 272u, lane) + wm * 128;
  const unsigned ka = tr_lane_base((unsigned)(size_t)Ks, 272u, lane) + wn * 128;
  for (int item = bid; item < NCHUNK * 4; item += nb) {
    const int c = item >> 2, hd = item & 3;
    const int t0 = c * 128;
    for (int dir = 0; dir < 2; ++dir) {
      const float lg = p.lg2[dir][hd];
      f32x4 acc[4][4];
#pragma unroll
      for (int i = 0; i < 4; ++i)
#pragma unroll
        for (int j = 0; j < 4; ++j) acc[i][j] = zero4();
      for (int half = 0; half < 2; ++half) {
        __syncthreads();
#pragma unroll
        for (int i = 0; i < 4; ++i) {
          const int idx = tid + 256 * i;
          const int r = idx >> 4, ck = (idx & 15) * 8;
          const int s = half * 64 + r;
          const bf16_t* src = proj + (size_t)(t0 + s) * NPROJ + hd * 128 + ck;
          const uint4 vv = *(const uint4*)(src + 2560);
          const uint4 kv = *(const uint4*)(src + 2048);
          const float w = exp2f((dir == 0 ? (float)(127 - s) : (float)s) * lg);
          uint4 ko;
          ko.x = pack2(bflo(kv.x) * w, bfhi(kv.x) * w); ko.y = pack2(bflo(kv.y) * w, bfhi(kv.y) * w);
          ko.z = pack2(bflo(kv.z) * w, bfhi(kv.z) * w); ko.w = pack2(bflo(kv.w) * w, bfhi(kv.w) * w);
          *(uint4*)(Vs + r * 136 + ck) = vv;
          *(uint4*)(Ks + r * 136 + ck) = ko;
        }
        __syncthreads();
        static_for<2>([&](auto KS) {
          constexpr int ks = decltype(KS)::value;
          bf16x8 af[4], bfr[4];
          tr_frag4<ks * 32 * 272 + 0, ks * 32 * 272 + 32, ks * 32 * 272 + 64, ks * 32 * 272 + 96, 4 * 272>(va, af[0], af[1], af[2], af[3]);
          tr_frag4<ks * 32 * 272 + 0, ks * 32 * 272 + 32, ks * 32 * 272 + 64, ks * 32 * 272 + 96, 4 * 272>(ka, bfr[0], bfr[1], bfr[2], bfr[3]);
#pragma unroll
          for (int i = 0; i < 4; ++i)
#pragma unroll
            for (int j = 0; j < 4; ++j) acc[i][j] = __builtin_amdgcn_mfma_f32_16x16x32_bf16(af[i], bfr[j], acc[i][j], 0, 0, 0);
        });
      }
      float* dst = p.st + ((size_t)(dir * NCHUNK + c) * 4 + hd) * 16384;
#pragma unroll
      for (int i = 0; i < 4; ++i)
#pragma unroll
        for (int j = 0; j < 4; ++j)
#pragma unroll
          for (int r = 0; r < 4; ++r) {
            const int row = wm * 64 + i * 16 + (lane >> 4) * 4 + r;
            const int col = wn * 64 + j * 16 + (lane & 15);
            dst[row * 128 + col] = acc[i][j][r];
          }
    }
  }
}

__device__ __forceinline__ void ph_ret_scan(const Params& p, int bid, int nb) {
  const int TIX = opaque_tid(); bid = opaque_s(bid);
  const int gtid = bid * 256 + TIX, gn = nb * 256;
  for (int idx = gtid; idx < 2 * 4 * 4 * 16384; idx += gn) {
    const int e = idx & 16383, hd = (idx >> 14) & 3, b = (idx >> 16) & 3, dir = idx >> 18;
    const float dc = exp2f(128.f * p.lg2[dir][hd]);
    const size_t boff = (size_t)dir * NCHUNK * 4 * 16384 + (size_t)hd * 16384 + e;
    const float* src = p.st + boff;
    float* dst = p.ybuf + boff;
    float carry = 0.f;
    if (dir == 0) {
      for (int n = 0; n < 2; ++n) {
        const size_t o = (size_t)(256 + b * 2 + n) * 4 * 16384;
        const float u = src[o]; dst[o] = carry; carry = carry * dc + u;
      }
      for (int n = 0; n < 64; ++n) {
        const size_t o = (size_t)(b * 64 + n) * 4 * 16384;
        const float u = src[o]; dst[o] = carry; carry = carry * dc + u;
      }
    } else {
      for (int n = 1; n >= 0; --n) {
        const size_t o = (size_t)(256 + b * 2 + n) * 4 * 16384;
        const float u = src[o]; dst[o] = carry; carry = carry * dc + u;
      }
      for (int n = 63; n >= 0; --n) {
        const size_t o = (size_t)(b * 64 + n) * 4 * 16384;
        const float u = src[o]; dst[o] = carry; carry = carry * dc + u;
      }
    }
  }
}

__device__ __forceinline__ void ph_ret_out(const Params& p, int bid, int nb, char* smem) {
  const int TIX = opaque_tid(); bid = opaque_s(bid);
  const bf16_t* proj = (const bf16_t*)p.big;
  bf16_t* buf = (bf16_t*)smem;
  bf16_t* Pb = buf + 128 * 136;
  const int tid = TIX, lane = tid & 63, wave = tid >> 6;
  const unsigned ba = tr_lane_base((unsigned)(size_t)buf, 272u, lane);
  const int g = lane >> 4, l15 = lane & 15;
  bf16_t* Pw = Pb + wave * 16 * 136;
  for (int item = bid; item < NCHUNK * 8; item += nb) {
    const int c = item >> 3, hd = (item >> 1) & 3, rh = item & 1;
    const int t0 = c * 128;
    const int rw = rh * 64 + wave * 16;
    const float lgf = p.lg2[0][hd], lgb = p.lg2[1][hd];
    bf16x8 qf[4];
#pragma unroll
    for (int ks = 0; ks < 4; ++ks)
      qf[ks] = *(const bf16x8*)(proj + (size_t)(t0 + rw + l15) * NPROJ + 1536 + hd * 128 + ks * 32 + g * 8);
    f32x4 acc[8];
    if (!(DBG_RO & 4)) {
    __syncthreads();
#pragma unroll
    for (int i = 0; i < 8; ++i) {
      const int idx = tid + 256 * i; const int r = idx >> 4, ck = (idx & 15) * 8;
      *(uint4*)(buf + r * 136 + ck) = *(const uint4*)(proj + (size_t)(t0 + r) * NPROJ + 2048 + hd * 128 + ck);
    }
    __syncthreads();
#pragma unroll
    for (int nt = 0; nt < 8; ++nt) acc[nt] = zero4();
#pragma unroll
    for (int ks = 0; ks < 4; ++ks) {
#pragma unroll
      for (int nt = 0; nt < 8; ++nt) {
        const bf16x8 bfr = *(const bf16x8*)(buf + (nt * 16 + l15) * 136 + ks * 32 + g * 8);
        acc[nt] = __builtin_amdgcn_mfma_f32_16x16x32_bf16(qf[ks], bfr, acc[nt], 0, 0, 0);
      }
    }
#pragma unroll
    for (int nt = 0; nt < 8; ++nt)
#pragma unroll
      for (int r = 0; r < 4; ++r) {
        const int tl = g * 4 + r;
        const int t = rw + tl, s = nt * 16 + l15;
        const float d = (s <= t) ? exp2f((float)(t - s) * lgf) : exp2f((float)(s - t) * lgb);
        Pw[tl * 136 + s] = f2bf(acc[nt][r] * d);
      }
    __syncthreads();
#pragma unroll
    for (int i = 0; i < 8; ++i) {
      const int idx = tid + 256 * i; const int r = idx >> 4, ck = (idx & 15) * 8;
      *(uint4*)(buf + r * 136 + ck) = *(const uint4*)(proj + (size_t)(t0 + r) * NPROJ + 2560 + hd * 128 + ck);
    }
    __syncthreads();
    }
    f32x4 o[8];
#pragma unroll
    for (int nt = 0; nt < 8; ++nt) o[nt] = zero4();
    if (!(DBG_RO & 1)) static_for<4>([&](auto KS) {
      constexpr int ks = decltype(KS)::value;
      const bf16x8 pf = *(const bf16x8*)(Pw + l15 * 136 + ks * 32 + g * 8);
      static_for<2>([&](auto NH) {
        constexpr int nh = decltype(NH)::value;
        bf16x8 bfr[4];
        tr_frag4<ks * 32 * 272 + nh * 128 + 0, ks * 32 * 272 + nh * 128 + 32, ks * 32 * 272 + nh * 128 + 64, ks * 32 * 272 + nh * 128 + 96, 4 * 272>(
            ba, bfr[0], bfr[1], bfr[2], bfr[3]);
#pragma unroll
        for (int j = 0; j < 4; ++j) o[nh * 4 + j] = __builtin_amdgcn_mfma_f32_16x16x32_bf16(pf, bfr[j], o[nh * 4 + j], 0, 0, 0);
      });
    });
    if (!(DBG_RO & 2)) for (int dir = 0; dir < 2; ++dir) {
      __syncthreads();
      const float* ssrc = p.ybuf + ((size_t)(dir * NCHUNK + c) * 4 + hd) * 16384;
#pragma unroll
      for (int i = 0; i < 16; ++i) {
        const int idx = tid + 256 * i; const int r = idx >> 5, c4 = (idx & 31) * 4;
        const float4 v = *(const float4*)(ssrc + r * 128 + c4);
        uint2 w; w.x = pack2(v.x, v.y); w.y = pack2(v.z, v.w);
        *(uint2*)(buf + r * 136 + c4) = w;
      }
      __syncthreads();
      float fr[4];
#pragma unroll
      for (int r = 0; r < 4; ++r) {
        const int t = rw + g * 4 + r;
        fr[r] = (dir == 0) ? exp2f((float)(t + 1) * lgf) : exp2f((float)(128 - t) * lgb);
      }
#pragma unroll
      for (int nt = 0; nt < 8; ++nt) acc[nt] = zero4();
      __builtin_amdgcn_sched_barrier(0);
#pragma unroll
      for (int ks = 0; ks < 4; ++ks) {
#pragma unroll
        for (int nt = 0; nt < 8; ++nt) {
          const bf16x8 bfr = *(const bf16x8*)(buf + (nt * 16 + l15) * 136 + ks * 32 + g * 8);
          acc[nt] = __builtin_amdgcn_mfma_f32_16x16x32_bf16(qf[ks], bfr, acc[nt], 0, 0, 0);
        }
      }
      __builtin_amdgcn_sched_barrier(0);
      asm volatile("s_nop 15\n\ts_nop 15\n\ts_nop 15\n\ts_nop 15" ::: "memory");
      __builtin_amdgcn_sched_barrier(0);
#pragma unroll
      for (int r = 0; r < 4; ++r) {
#pragma unroll
        for (int nt = 0; nt < 8; ++nt) o[nt][r] += fr[r] * acc[nt][r];
      }
    }
#pragma unroll
    for (int r = 0; r < 4; ++r) {
      const int t = t0 + rw + g * 4 + r;
#pragma unroll
      for (int nt = 0; nt < 8; ++nt) p.cat[(size_t)t * DM + 512 + hd * 128 + nt * 16 + l15] = f2bf(o[nt][r]);
    }
  }
}

__device__ __forceinline__ void ph_gnorm(const Params& p, int bid, int nb) {
  const int TIX = opaque_tid(); bid = opaque_s(bid);
  const bf16_t* proj = (const bf16_t*)p.big;
  const int lane = TIX & 63;
  const int gw = bid * 4 + (TIX >> 6), nw = nb * 4;
  for (int t = gw; t < TT; t += nw) {
    bf16_t* op = p.cat + (size_t)t * DM + 512 + lane * 8;
    const uint4 ov = *(const uint4*)op;
    const uint4 gv = *(const uint4*)(proj + (size_t)t * NPROJ + 3072 + lane * 8);
    float o[8], gg[8];
    o[0] = bflo(ov.x); o[1] = bfhi(ov.x); o[2] = bflo(ov.y); o[3] = bfhi(ov.y);
    o[4] = bflo(ov.z); o[5] = bfhi(ov.z); o[6] = bflo(ov.w); o[7] = bfhi(ov.w);
    gg[0] = bflo(gv.x); gg[1] = bfhi(gv.x); gg[2] = bflo(gv.y); gg[3] = bfhi(gv.y);
    gg[4] = bflo(gv.z); gg[5] = bfhi(gv.z); gg[6] = bflo(gv.w); gg[7] = bfhi(gv.w);
    float s1 = 0.f;
#pragma unroll
    for (int i = 0; i < 8; ++i) s1 += o[i];
    s1 = row16_sum(s1);
    const float mu = s1 * (1.f / 128.f);
    float s2 = 0.f;
#pragma unroll
    for (int i = 0; i < 8; ++i) { const float d = o[i] - mu; s2 += d * d; }
    s2 = row16_sum(s2);
    const float rs = rsqrtf(s2 * (1.f / 128.f) + 1e-5f);
    float y[8];
#pragma unroll
    for (int i = 0; i < 8; ++i) y[i] = silu_f(gg[i]) * (o[i] - mu) * rs;
    *(uint4*)op = make_uint4(pack2(y[0], y[1]), pack2(y[2], y[3]), pack2(y[4], y[5]), pack2(y[6], y[7]));
  }
}

__device__ __forceinline__ void ph_ln(const Params& p, int l, int which, int bid, int nb) {
  const int TIX = opaque_tid(); bid = opaque_s(bid);
  const int lane = TIX & 63;
  const int gw = bid * 4 + (TIX >> 6), nw = nb * 4;
  const float* lg = (which == 1 ? p.ln1_g : p.ln2_g) + (size_t)l * DM;
  const float* lb = (which == 1 ? p.ln1_b : p.ln2_b) + (size_t)l * DM;
  const bool last = (l == NLAYER - 1);
  for (int t = gw; t < TT; t += nw) {
    const float* xr;
    if (l == 0 && which == 1) xr = t < TL ? p.x + (size_t)t * DM : p.ctx + (size_t)(t - TL) * DM;
    else xr = p.xres + (size_t)t * DM;
    const float* yr = p.ybuf + (size_t)t * DM;
    const float* m = p.mod + (size_t)(l * 5 + mod_row(t)) * 6144;
    const float* mg = m + (which == 1 ? 2048 : 5120);
    float v[16];
    float s1 = 0.f;
#pragma unroll
    for (int i = 0; i < 4; ++i) {
      const int col = lane * 4 + 256 * i;
      const float4 xv = *(const float4*)(xr + col);
      const float4 yv = *(const float4*)(yr + col);
      const float4 gv = *(const float4*)(mg + col);
      v[4 * i + 0] = ALPHA_F * xv.x + gv.x * yv.x; v[4 * i + 1] = ALPHA_F * xv.y + gv.y * yv.y;
      v[4 * i + 2] = ALPHA_F * xv.z + gv.z * yv.z; v[4 * i + 3] = ALPHA_F * xv.w + gv.w * yv.w;
      s1 += v[4 * i + 0] + v[4 * i + 1] + v[4 * i + 2] + v[4 * i + 3];
    }
    const float mu = wave_sum(s1) * (1.f / 1024.f);
    float s2 = 0.f;
#pragma unroll
    for (int i = 0; i < 16; ++i) { const float d = v[i] - mu; s2 += d * d; }
    const float rs = rsqrtf(wave_sum(s2) * (1.f / 1024.f) + 1e-5f);
    const float* msh; const float* msc;
    if (which == 1) { msh = m + 3072; msc = m + 4096; }
    else { const float* m2 = p.mod + (size_t)((last ? l : l + 1) * 5 + mod_row(t)) * 6144; msh = m2; msc = m2 + 1024; }
#pragma unroll
    for (int i = 0; i < 4; ++i) {
      const int col = lane * 4 + 256 * i;
      const float4 gg = *(const float4*)(lg + col);
      const float4 bb = *(const float4*)(lb + col);
      float4 o;
      o.x = (v[4 * i + 0] - mu) * rs * gg.x + bb.x; o.y = (v[4 * i + 1] - mu) * rs * gg.y + bb.y;
      o.z = (v[4 * i + 2] - mu) * rs * gg.z + bb.z; o.w = (v[4 * i + 3] - mu) * rs * gg.w + bb.w;
      *(float4*)(p.xres + (size_t)t * DM + col) = o;
      if (which == 2 && last && t < TL) *(float4*)(p.out + (size_t)t * DM + col) = o;
      const float4 sh = *(const float4*)(msh + col);
      const float4 sc = *(const float4*)(msc + col);
      uint2 h;
      h.x = pack2(o.x * (1.f + sc.x) + sh.x, o.y * (1.f + sc.y) + sh.y);
      h.y = pack2(o.z * (1.f + sc.z) + sh.z, o.w * (1.f + sc.w) + sh.w);
      *(uint2*)(p.hA + (size_t)t * DM + col) = h;
    }
  }
}

#define TK_INSERT(V, I, xv, xi)                                        \
  if ((xv) > V[15]) {                                                  \
    V[15] = (xv); I[15] = (xi);                                        \
    _Pragma("unroll") for (int q_ = 15; q_ > 0; --q_) {                \
      const bool sw_ = V[q_] > V[q_ - 1];                              \
      const float tv_ = V[q_]; const int ti_ = I[q_];                  \
      V[q_] = sw_ ? V[q_ - 1] : tv_; I[q_] = sw_ ? I[q_ - 1] : ti_;    \
      V[q_ - 1] = sw_ ? tv_ : V[q_ - 1]; I[q_ - 1] = sw_ ? ti_ : I[q_ - 1]; \
    }                                                                  \
  }

__device__ __forceinline__ void ph_topk1(const Params& p, int bid, int nb) {
  const int TIX = opaque_tid(); bid = opaque_s(bid);
  const float* scores = (const float*)p.big;
  const int gtid = bid * 256 + TIX, gn = nb * 256;
  for (int idx = gtid; idx < TT * 16; idx += gn) {
    const float* row = scores + (size_t)idx * 128;
    float V[16]; int I[16];
#pragma unroll
    for (int i = 0; i < 16; ++i) { V[i] = -3.0e38f; I[i] = 0; }
    for (int i4 = 0; i4 < 32; ++i4) {
      const float4 x = *(const float4*)(row + i4 * 4);
      TK_INSERT(V, I, x.x, i4 * 4 + 0)
      TK_INSERT(V, I, x.y, i4 * 4 + 1)
      TK_INSERT(V, I, x.z, i4 * 4 + 2)
      TK_INSERT(V, I, x.w, i4 * 4 + 3)
    }
    float4* dv = (float4*)(p.sv + (size_t)idx * 16);
    dv[0] = make_float4(V[0], V[1], V[2], V[3]); dv[1] = make_float4(V[4], V[5], V[6], V[7]);
    dv[2] = make_float4(V[8], V[9], V[10], V[11]); dv[3] = make_float4(V[12], V[13], V[14], V[15]);
    uint4 di;
    di.x = I[0] | (I[1] << 8) | (I[2] << 16) | (I[3] << 24);
    di.y = I[4] | (I[5] << 8) | (I[6] << 16) | (I[7] << 24);
    di.z = I[8] | (I[9] << 8) | (I[10] << 16) | (I[11] << 24);
    di.w = I[12] | (I[13] << 8) | (I[14] << 16) | (I[15] << 24);
    *(uint4*)(p.si + (size_t)idx * 16) = di;
  }
}

__device__ __forceinline__ void ph_topk2(const Params& p, int bid, int nb) {
  const int TIX = opaque_tid(); bid = opaque_s(bid);
  const int gtid = bid * 256 + TIX, gn = nb * 256;
  for (int idx = gtid; idx < TT * 8; idx += gn) {
    float a[16], b[16]; int ia[16], ib[16];
    {
      const float4* pa = (const float4*)(p.sv + (size_t)idx * 32);
#pragma unroll
      for (int i = 0; i < 4; ++i) { const float4 v = pa[i]; a[4 * i] = v.x; a[4 * i + 1] = v.y; a[4 * i + 2] = v.z; a[4 * i + 3] = v.w; }
#pragma unroll
      for (int i = 0; i < 4; ++i) { const float4 v = pa[4 + i]; b[4 * i] = v.x; b[4 * i + 1] = v.y; b[4 * i + 2] = v.z; b[4 * i + 3] = v.w; }
      const uint4 qa = *(const uint4*)(p.si + (size_t)idx * 32), qb = *(const uint4*)(p.si + (size_t)idx * 32 + 16);
      const uint32_t wa[4] = {qa.x, qa.y, qa.z, qa.w}, wb[4] = {qb.x, qb.y, qb.z, qb.w};
#pragma unroll
      for (int i = 0; i < 16; ++i) { ia[i] = (wa[i >> 2] >> (8 * (i & 3))) & 255; ib[i] = (wb[i >> 2] >> (8 * (i & 3))) & 255; }
    }
    float V[16]; int I[16];
#pragma unroll
    for (int i = 0; i < 16; ++i) { V[i] = -3.0e38f; I[i] = 0; }
#pragma unroll
    for (int i = 0; i < 16; ++i) {
#pragma unroll
      for (int j = 0; j < 16; ++j) {
        if ((i + 1) * (j + 1) <= 16) {
          const float cv = a[i] + b[j];
          const int ce = ia[i] * 128 + ib[j];
          TK_INSERT(V, I, cv, ce)
        }
      }
    }
    float e[16], sum = 0.f;
#pragma unroll
    for (int i = 0; i < 16; ++i) { e[i] = __expf(V[i] - V[0]); sum += e[i]; }
    const float inv = 1.f / sum;
    int4* de = (int4*)(p.pe + (size_t)idx * 16);
    float4* dg = (float4*)(p.pg + (size_t)idx * 16);
#pragma unroll
    for (int i = 0; i < 4; ++i) {
      de[i] = make_int4(I[4 * i], I[4 * i + 1], I[4 * i + 2], I[4 * i + 3]);
      dg[i] = make_float4(e[4 * i] * inv, e[4 * i + 1] * inv, e[4 * i + 2] * inv, e[4 * i + 3] * inv);
    }
  }
}

typedef float f32x2 __attribute__((ext_vector_type(2)));
__device__ __forceinline__ float wave_sum_fast(float v) {
  v = row16_sum(v);
  v += __shfl_xor(v, 16);
  v += __shfl_xor(v, 32);
  return v;
}
#define FP8_DOT(W, H0, H1, H2, H3, D)                                                            \
  { const f32x2 t0_ = __builtin_amdgcn_cvt_pk_f32_fp8((int)(W), false);                          \
    const f32x2 t1_ = __builtin_amdgcn_cvt_pk_f32_fp8((int)(W), true);                           \
    D += t0_.x * (H0) + t0_.y * (H1) + t1_.x * (H2) + t1_.y * (H3); }
#define FP8_AXPY(W, A, C0, C1, C2, C3)                                                           \
  { const f32x2 t0_ = __builtin_amdgcn_cvt_pk_f32_fp8((int)(W), false);                          \
    const f32x2 t1_ = __builtin_amdgcn_cvt_pk_f32_fp8((int)(W), true);                           \
    C0 += (A) * t0_.x; C1 += (A) * t0_.y; C2 += (A) * t1_.x; C3 += (A) * t1_.y; }

__device__ __forceinline__ void ph_gather_ln2(const Params& p, int l, int bid, int nb) {
  const int TIX = opaque_tid(); bid = opaque_s(bid);
  const int lane = TIX & 63;
  const int gw = bid * 4 + (TIX >> 6), nw = nb * 4;
  const unsigned char* ut = (const unsigned char*)p.ubf;
  const unsigned char* vt = (const unsigned char*)p.vbf;
  const bool last = (l == NLAYER - 1);
  const float* lg = p.ln2_g + (size_t)l * DM + lane * 16;
  const float* lb = p.ln2_b + (size_t)l * DM + lane * 16;
  for (int t = gw; t < TT; t += nw) {
    const bf16_t* hrow = p.hA + (size_t)t * DM + lane * 16;
    const uint4 h0 = *(const uint4*)hrow, h1 = *(const uint4*)(hrow + 8);
    float hf[16];
    hf[0] = bflo(h0.x); hf[1] = bfhi(h0.x); hf[2] = bflo(h0.y); hf[3] = bfhi(h0.y);
    hf[4] = bflo(h0.z); hf[5] = bfhi(h0.z); hf[6] = bflo(h0.w); hf[7] = bfhi(h0.w);
    hf[8] = bflo(h1.x); hf[9] = bfhi(h1.x); hf[10] = bflo(h1.y); hf[11] = bfhi(h1.y);
    hf[12] = bflo(h1.z); hf[13] = bfhi(h1.z); hf[14] = bflo(h1.w); hf[15] = bfhi(h1.w);
    float acc[16];
#pragma unroll
    for (int i = 0; i < 16; ++i) acc[i] = 0.f;
    const int e_lo = p.pe[(size_t)t * 128 + lane], e_hi = p.pe[(size_t)t * 128 + 64 + lane];
    const float g_lo = p.pg[(size_t)t * 128 + lane], g_hi = p.pg[(size_t)t * 128 + 64 + lane];
    for (int kb = 0; kb < 128; kb += 8) {
      float gt[8];
      uint4 uw[8], vw[8];
#pragma unroll
      for (int u = 0; u < 8; ++u) {
        const int k = kb + u;
        const int e = __shfl(k < 64 ? e_lo : e_hi, k & 63);
        gt[u] = __shfl(k < 64 ? g_lo : g_hi, k & 63);
        uw[u] = *(const uint4*)(ut + (size_t)e * DM + lane * 16);
        vw[u] = *(const uint4*)(vt + (size_t)e * DM + lane * 16);
      }
      float d[8];
#pragma unroll
      for (int u = 0; u < 8; ++u) {
        float dd = 0.f;
        FP8_DOT(uw[u].x, hf[0], hf[1], hf[2], hf[3], dd)
        FP8_DOT(uw[u].y, hf[4], hf[5], hf[6], hf[7], dd)
        FP8_DOT(uw[u].z, hf[8], hf[9], hf[10], hf[11], dd)
        FP8_DOT(uw[u].w, hf[12], hf[13], hf[14], hf[15], dd)
        d[u] = dd;
      }
#pragma unroll
      for (int u = 0; u < 8; ++u) d[u] = wave_sum_fast(d[u]) * (1.f / SCALE_U);
#pragma unroll
      for (int u = 0; u < 8; ++u) {
        const float a = gt[u] * 0.5f * d[u] * (1.f + erff(d[u] * 0.7071067811865476f)) * (1.f / SCALE_V);
        FP8_AXPY(vw[u].x, a, acc[0], acc[1], acc[2], acc[3])
        FP8_AXPY(vw[u].y, a, acc[4], acc[5], acc[6], acc[7])
        FP8_AXPY(vw[u].z, a, acc[8], acc[9], acc[10], acc[11])
        FP8_AXPY(vw[u].w, a, acc[12], acc[13], acc[14], acc[15])
      }
    }
    const float* xr = p.xres + (size_t)t * DM + lane * 16;
    const float* m = p.mod + (size_t)(l * 5 + mod_row(t)) * 6144 + lane * 16;
    float v[16];
    float s1 = 0.f;
#pragma unroll
    for (int i = 0; i < 4; ++i) {
      const float4 xv = *(const float4*)(xr + 4 * i);
      const float4 gv = *(const float4*)(m + 5120 + 4 * i);
      v[4 * i + 0] = ALPHA_F * xv.x + gv.x * acc[4 * i + 0]; v[4 * i + 1] = ALPHA_F * xv.y + gv.y * acc[4 * i + 1];
      v[4 * i + 2] = ALPHA_F * xv.z + gv.z * acc[4 * i + 2]; v[4 * i + 3] = ALPHA_F * xv.w + gv.w * acc[4 * i + 3];
      s1 += v[4 * i + 0] + v[4 * i + 1] + v[4 * i + 2] + v[4 * i + 3];
    }
    const float mu = wave_sum(s1) * (1.f / 1024.f);
    float s2 = 0.f;
#pragma unroll
    for (int i = 0; i < 16; ++i) { const float dlt = v[i] - mu; s2 += dlt * dlt; }
    const float rs = rsqrtf(wave_sum(s2) * (1.f / 1024.f) + 1e-5f);
    const float* m2 = p.mod + (size_t)((last ? l : l + 1) * 5 + mod_row(t)) * 6144 + lane * 16;
    uint32_t hw[8];
#pragma unroll
    for (int i = 0; i < 4; ++i) {
      const float4 gg = *(const float4*)(lg + 4 * i);
      const float4 bb = *(const float4*)(lb + 4 * i);
      float4 o;
      o.x = (v[4 * i + 0] - mu) * rs * gg.x + bb.x; o.y = (v[4 * i + 1] - mu) * rs * gg.y + bb.y;
      o.z = (v[4 * i + 2] - mu) * rs * gg.z + bb.z; o.w = (v[4 * i + 3] - mu) * rs * gg.w + bb.w;
      *(float4*)(p.xres + (size_t)t * DM + lane * 16 + 4 * i) = o;
      if (last && t < TL) *(float4*)(p.out + (size_t)t * DM + lane * 16 + 4 * i) = o;
      const float4 sh = *(const float4*)(m2 + 4 * i);
      const float4 sc = *(const float4*)(m2 + 1024 + 4 * i);
      hw[2 * i] = pack2(o.x * (1.f + sc.x) + sh.x, o.y * (1.f + sc.y) + sh.y);
      hw[2 * i + 1] = pack2(o.z * (1.f + sc.z) + sh.z, o.w * (1.f + sc.w) + sh.w);
    }
    bf16_t* hd = p.hA + (size_t)t * DM + lane * 16;
    *(uint4*)hd = make_uint4(hw[0], hw[1], hw[2], hw[3]);
    *(uint4*)(hd + 8) = make_uint4(hw[4], hw[5], hw[6], hw[7]);
  }
}

enum { PH_PRE_A = 0, PH_PRE_B, PH_INIT, PH_GEMM_IN, PH_ELEM, PH_RET_UPD, PH_RET_SCAN, PH_RET_OUT, PH_GEMM_OUT, PH_LN1,
       PH_GEMM_WK, PH_TOPK1, PH_TOPK2, PH_GATHER, PH_LN2, PH_GNORM };

__device__ __forceinline__ void run_phase(const Params& p, int ph, int l, int bid, int nb, char* smem) {
  switch (ph) {
    case PH_PRE_A:
      ph_mod_partial(p, bid, nb, smem);
      for (int ll = 0; ll < NLAYER; ++ll) {
        ph_transpose_cvt(p.w_in + (size_t)ll * DM * NPROJ, p.w_inT + (size_t)ll * NPROJ * DM, DM, NPROJ, bid, nb, smem);
        ph_transpose_cvt(p.w_out + (size_t)ll * DM * DM, p.w_outT + (size_t)ll * DM * DM, DM, DM, bid, nb, smem);
      }
      ph_wk_fold(p, bid, nb, smem);
      break;
    case PH_PRE_B: ph_mod_reduce(p, bid, nb); break;
    case PH_INIT: ph_init_h(p, bid, nb); break;
    case PH_GEMM_IN:
      ph_gemm<true>(p.hA, p.w_inT + (size_t)l * NPROJ * DM, p.big, TT, NPROJ, DM, bid, nb, smem);
      ph_cvt_uv(p, l, bid, nb);
      break;
    case PH_ELEM: ph_elem(p, l, bid, nb); break;
    case PH_RET_UPD: ph_ret_upd(p, bid, nb, smem); break;
    case PH_RET_SCAN: ph_ret_scan(p, bid, nb); break;
    case PH_RET_OUT: ph_ret_out(p, bid, nb, smem); break;
    case PH_GEMM_OUT: ph_gemm<false>(p.cat, p.w_outT + (size_t)l * DM * DM, p.ybuf, TT, DM, DM, bid, nb, smem); break;
    case PH_LN1: ph_ln(p, l, 1, bid, nb); break;
    case PH_GEMM_WK: ph_gemm<false>(p.hA, p.wkT + (size_t)l * 2048 * DM, p.big, TT, 2048, DM, bid, nb, smem); break;
    case PH_TOPK1: ph_topk1(p, bid, nb); break;
    case PH_TOPK2: ph_topk2(p, bid, nb); break;
    case PH_GATHER: ph_gather_ln2(p, l, bid, nb); break;
    case PH_LN2: break;
    case PH_GNORM: ph_gnorm(p, bid, nb); break;
  }
}

extern __shared__ __attribute__((aligned(16))) char dyn_smem[];

template <int PH>
__global__ void __launch_bounds__(256, 2) k_phase(Params p, int l) {
  run_phase(p, PH, l, blockIdx.x, gridDim.x, dyn_smem);
}

__device__ __forceinline__ void grid_barrier(unsigned* bar, unsigned target) {
  asm volatile("s_waitcnt vmcnt(0) lgkmcnt(0)" ::: "memory");
  __syncthreads();
  if (threadIdx.x == 0) {
    __builtin_amdgcn_fence(__ATOMIC_RELEASE, "agent");
    asm volatile("s_waitcnt vmcnt(0)" ::: "memory");
    __hip_atomic_fetch_add(bar, 1u, __ATOMIC_RELAXED, __HIP_MEMORY_SCOPE_AGENT);
    while (__hip_atomic_load(bar, __ATOMIC_RELAXED, __HIP_MEMORY_SCOPE_AGENT) < target) __builtin_amdgcn_s_sleep(1);
    __builtin_amdgcn_fence(__ATOMIC_ACQUIRE, "agent");
    asm volatile("s_waitcnt vmcnt(0)" ::: "memory");
  }
  __syncthreads();
}

__global__ void __launch_bounds__(256, 2) k_mega(Params p) {
  cg::grid_group grid = cg::this_grid();
  const int bid = blockIdx.x, nb = gridDim.x;
  unsigned epoch = 0;
#define GSYNC() do { ++epoch; grid_barrier(p.bar, epoch * (unsigned)nb); } while (0)
  grid.sync();
  run_phase(p, PH_PRE_A, 0, bid, nb, dyn_smem); GSYNC();
  run_phase(p, PH_PRE_B, 0, bid, nb, dyn_smem); GSYNC();
  run_phase(p, PH_INIT, 0, bid, nb, dyn_smem); GSYNC();
  for (int l = 0; l < NLAYER; ++l) {
    run_phase(p, PH_GEMM_IN, l, bid, nb, dyn_smem); GSYNC();
    run_phase(p, PH_ELEM, l, bid, nb, dyn_smem); GSYNC();
    run_phase(p, PH_RET_UPD, l, bid, nb, dyn_smem); GSYNC();
    run_phase(p, PH_RET_SCAN, l, bid, nb, dyn_smem); GSYNC();
    run_phase(p, PH_RET_OUT, l, bid, nb, dyn_smem); GSYNC();
    run_phase(p, PH_GNORM, l, bid, nb, dyn_smem); GSYNC();
    run_phase(p, PH_GEMM_OUT, l, bid, nb, dyn_smem); GSYNC();
    run_phase(p, PH_LN1, l, bid, nb, dyn_smem); GSYNC();
    run_phase(p, PH_GEMM_WK, l, bid, nb, dyn_smem); GSYNC();
    run_phase(p, PH_TOPK1, l, bid, nb, dyn_smem); GSYNC();
    run_phase(p, PH_TOPK2, l, bid, nb, dyn_smem); GSYNC();
    run_phase(p, PH_GATHER, l, bid, nb, dyn_smem);
    if (l + 1 < NLAYER) GSYNC();
  }
#undef GSYNC
}

__global__ void k_dump_bf16(const bf16_t* src, float* out, size_t n) {
  for (size_t i = (size_t)blockIdx.x * 256 + threadIdx.x; i < n; i += (size_t)gridDim.x * 256) out[i] = bf2f(src[i]);
}
__global__ void k_dump_cols(const bf16_t* src, int ld, int col0, float* out, size_t n) {
  for (size_t i = (size_t)blockIdx.x * 256 + threadIdx.x; i < n; i += (size_t)gridDim.x * 256) out[i] = bf2f(src[(i >> 10) * ld + col0 + (i & 1023)]);
}
__global__ void k_dump_hash(const uint32_t* src, size_t nwords, float* out, size_t nout, float scale) {
  __shared__ uint32_t red[256];
  const size_t L = (nwords + 1023) / 1024;
  const size_t b0 = (size_t)blockIdx.x * L;
  uint32_t h = 0;
  for (size_t i = threadIdx.x; i < L; i += 256) {
    const size_t j = b0 + i;
    if (j < nwords) h += (src[j] ^ 0x9e3779b9u) * (uint32_t)(2654435761u * (uint32_t)(i + 1) + 12345u);
  }
  red[threadIdx.x] = h;
  __syncthreads();
  for (int o = 128; o > 0; o >>= 1) { if ((int)threadIdx.x < o) red[threadIdx.x] += red[threadIdx.x + o]; __syncthreads(); }
  uint32_t hh = red[0];
  hh ^= hh >> 16; hh *= 0x85ebca6bu; hh ^= hh >> 13;
  const float v = scale * (float)(1u + (hh & 255u));
  const size_t per = nout / 1024;
  for (size_t i = threadIdx.x; i < per; i += 256) out[(size_t)blockIdx.x * per + i] = v;
}
__global__ void k_fill(float* out, size_t n, float v) {
  for (size_t i = (size_t)blockIdx.x * 256 + threadIdx.x; i < n; i += (size_t)gridDim.x * 256) out[i] = v;
}
__global__ void k_dump_f32(const float* src, float* out, size_t n) {
  for (size_t i = (size_t)blockIdx.x * 256 + threadIdx.x; i < n; i += (size_t)gridDim.x * 256) out[i] = src[i];
}
static inline size_t al256(size_t v) { return (v + 255) & ~(size_t)255; }

extern "C" void kernel_launch(void* const* d_in, const int* in_sizes, int n_in, void* d_out, int out_size, void* d_ws,
                              size_t ws_size, hipStream_t stream) {
  static int grid = 0, mgrid = 0;
  if (grid == 0) {
    int dev = 0, cus = 0, per_cu = 0;
    (void)hipGetDevice(&dev);
    (void)hipDeviceGetAttribute(&cus, hipDeviceAttributeMultiprocessorCount, dev);
#define SETATTR(PH) (void)hipFuncSetAttribute((const void*)k_phase<PH>, hipFuncAttributeMaxDynamicSharedMemorySize, SMEM_BYTES);
    SETATTR(0) SETATTR(1) SETATTR(2) SETATTR(3) SETATTR(4) SETATTR(5) SETATTR(6) SETATTR(7) SETATTR(8) SETATTR(9)
    SETATTR(10) SETATTR(11) SETATTR(12) SETATTR(13) SETATTR(14) SETATTR(15)
    if (cus <= 0) cus = 256;
    grid = cus * 2;
    (void)hipFuncSetAttribute((const void*)k_mega, hipFuncAttributeMaxDynamicSharedMemorySize, SMEM_BYTES);
    if (hipOccupancyMaxActiveBlocksPerMultiprocessor(&per_cu, (const void*)k_mega, 256, SMEM_BYTES) != hipSuccess || per_cu < 1) per_cu = 1;
    if (per_cu > 2) per_cu = 2;
    mgrid = cus * per_cu;
  }
  Params p{};
  p.x = (const float*)d_in[0]; p.c = (const float*)d_in[1]; p.ctx = (const float*)d_in[2]; p.c_ctx = (const float*)d_in[3];
  p.w_mod = (const float*)d_in[4]; p.b_mod = (const float*)d_in[5]; p.w_in = (const float*)d_in[6]; p.conv_w = (const float*)d_in[7];
  p.w_out = (const float*)d_in[8]; p.ln1_g = (const float*)d_in[9]; p.ln1_b = (const float*)d_in[10]; p.peer_wq = (const float*)d_in[11];
  p.peer_keys = (const float*)d_in[12]; p.peer_u = (const float*)d_in[13]; p.peer_v = (const float*)d_in[14];
  p.ln2_g = (const float*)d_in[15]; p.ln2_b = (const float*)d_in[16];
  p.out = (float*)d_out;
  char* w = (char*)d_ws; size_t off = 0;
  auto take = [&](size_t bytes) { char* r = w + off; off = al256(off + bytes); return r; };
  p.xres = (float*)take((size_t)TT * DM * 4);
  p.hA = (bf16_t*)take((size_t)TT * DM * 2);
  p.big = take((size_t)TT * 2048 * 4);
  p.cat = (bf16_t*)take((size_t)TT * DM * 2);
  p.st = (float*)take((size_t)2 * NCHUNK * 4 * 16384 * 4);
  p.ybuf = (float*)take((size_t)TT * DM * 4);
  p.w_inT = (bf16_t*)take((size_t)NLAYER * NPROJ * DM * 2);
  p.w_outT = (bf16_t*)take((size_t)NLAYER * DM * DM * 2);
  p.wkT = (bf16_t*)take((size_t)NLAYER * 2048 * DM * 2);
  p.ubf = (bf16_t*)take((size_t)NEXP * DM * 2);
  p.vbf = (bf16_t*)take((size_t)NEXP * DM * 2);
  p.mod = (float*)take((size_t)4 * 5 * 6144 * 4);
  p.modp = (float*)take((size_t)8 * 4 * 5 * 6144 * 4);
  p.ropec = (float*)take(128 * 32 * 4);
  p.ropes = (float*)take(128 * 32 * 4);
  p.bar = (unsigned*)take(256);
  p.pad0 = nullptr;
  {
    char* a = (char*)p.st; size_t o2 = 0;
    p.sv = (float*)(a + o2); o2 = al256(o2 + (size_t)TT * 256 * 4);
    p.si = (unsigned char*)(a + o2); o2 = al256(o2 + (size_t)TT * 256);
    p.pe = (int*)(a + o2); o2 = al256(o2 + (size_t)TT * 128 * 4);
    p.pg = (float*)(a + o2); o2 = al256(o2 + (size_t)TT * 128 * 4);
  }
  for (int d = 0; d < 2; ++d)
    for (int h = 0; h < 4; ++h) p.lg2[d][h] = (float)log2(1.0 - exp2(-(5.0 + 0.5 * d + (double)h)));
  if (off > ws_size) { fprintf(stderr, "kernel_launch: workspace too small: need %zu have %zu\n", off, ws_size); return; }

#if MEGA
  {
    (void)hipMemsetAsync(p.bar, 0, 256, stream);
    void* args[] = {(void*)&p};
    hipError_t e = hipLaunchCooperativeKernel((const void*)k_mega, dim3(mgrid), dim3(256), args, SMEM_BYTES, stream);
    if (e != hipSuccess) fprintf(stderr, "kernel_launch: cooperative launch failed: %s (grid %d)\n", hipGetErrorString(e), mgrid);
    return;
  }
#endif
#define launch(PH, L) hipLaunchKernelGGL(k_phase<PH>, dim3(grid), dim3(256), SMEM_BYTES, stream, p, (int)(L))
  const size_t HR = ((size_t)TL * DM / 8) & ~(size_t)1023;
#define HASH(K, PTR, BYTES) if (DBG_STOP == 20) hipLaunchKernelGGL(k_dump_hash, dim3(1024), dim3(256), 0, stream, (const uint32_t*)(PTR), (size_t)(BYTES) / 4, p.out + (size_t)(K) * HR, HR, ((DBG_HMASK >> (K)) & 1) ? 1.0f : 0.0f)
  if (DBG_STOP == 20) hipLaunchKernelGGL(k_fill, dim3(1024), dim3(256), 0, stream, p.out, (size_t)TL * DM, 0.f);
  launch(PH_PRE_A, 0);
  launch(PH_PRE_B, 0);
  launch(PH_INIT, 0);
  HASH(0, p.hA, (size_t)TT * DM * 2);
  HASH(1, p.w_inT, (size_t)NPROJ * DM * 2);
  for (int l = 0; l < NLAYER; ++l) {
    launch(PH_GEMM_IN, l);
    if (l == 0) HASH(2, p.big, (size_t)TT * NPROJ * 2);
    if (DBG_STOP == 6) { hipLaunchKernelGGL(k_dump_bf16, dim3(1024), dim3(256), 0, stream, (const bf16_t*)p.big, p.out, (size_t)TL * DM); return; }
    launch(PH_ELEM, l);
    if (l == 0) HASH(3, p.big, (size_t)TT * NPROJ * 2);
    if (DBG_STOP == 12) { hipLaunchKernelGGL(k_dump_cols, dim3(1024), dim3(256), 0, stream, (const bf16_t*)p.big, NPROJ, 1536, p.out, (size_t)TL * DM); return; }
    if (DBG_STOP == 13) { hipLaunchKernelGGL(k_dump_cols, dim3(1024), dim3(256), 0, stream, (const bf16_t*)p.big, NPROJ, 2560, p.out, (size_t)TL * DM); return; }
    if (DBG_STOP == 7) { hipLaunchKernelGGL(k_dump_bf16, dim3(1024), dim3(256), 0, stream, (const bf16_t*)p.big, p.out, (size_t)TL * DM); return; }
    launch(PH_RET_UPD, l);
    if (l == 0) HASH(4, p.st, (size_t)2 * NCHUNK * 4 * 16384 * 4);
    if (DBG_STOP == 8) { hipLaunchKernelGGL(k_dump_f32, dim3(1024), dim3(256), 0, stream, p.st, p.out, (size_t)TL * DM); return; }
    launch(PH_RET_SCAN, l);
    if (l == 0) HASH(5, p.ybuf, (size_t)2 * NCHUNK * 4 * 16384 * 4);
    if (DBG_STOP == 10) { hipLaunchKernelGGL(k_dump_f32, dim3(1024), dim3(256), 0, stream, p.st + (size_t)NCHUNK * 4 * 16384, p.out, (size_t)TL * DM); return; }
    if (DBG_STOP == 11) { hipLaunchKernelGGL(k_dump_f32, dim3(1024), dim3(256), 0, stream, p.st + (size_t)200 * 4 * 16384, p.out, (size_t)TL * DM); return; }
    if (DBG_STOP == 9) { hipLaunchKernelGGL(k_dump_f32, dim3(1024), dim3(256), 0, stream, p.st, p.out, (size_t)TL * DM); return; }
    launch(PH_RET_OUT, l);
    launch(PH_GNORM, l);
    if (l == 0) HASH(6, p.cat, (size_t)TT * DM * 2);
    if (DBG_STOP == 20) return;
    if (DBG_STOP == 1) { hipLaunchKernelGGL(k_dump_bf16, dim3(1024), dim3(256), 0, stream, p.cat, p.out, (size_t)TL * DM); return; }
    launch(PH_GEMM_OUT, l);
    launch(PH_LN1, l);
    if (DBG_STOP == 2) { hipLaunchKernelGGL(k_dump_f32, dim3(1024), dim3(256), 0, stream, p.xres, p.out, (size_t)TL * DM); return; }
    launch(PH_GEMM_WK, l);
    launch(PH_TOPK1, l);
    launch(PH_TOPK2, l);
    launch(PH_GATHER, l);
    if (1) continue;
    if (DBG_STOP == 3) { hipLaunchKernelGGL(k_dump_f32, dim3(1024), dim3(256), 0, stream, p.ybuf, p.out, (size_t)TL * DM); return; }
    launch(PH_LN2, l);
    if (DBG_STOP == 4) { hipLaunchKernelGGL(k_dump_f32, dim3(1024), dim3(256), 0, stream, p.xres, p.out, (size_t)TL * DM); return; }
  }
}
```

```cpp
#include <hip/hip_runtime.h>
#include <hip/hip_cooperative_groups.h>
#include <stdint.h>
#include <math.h>
#include <stdio.h>
#include <utility>
#include <type_traits>

namespace cg = cooperative_groups;

typedef unsigned short bf16_t;
using bf16x8 = __attribute__((ext_vector_type(8))) short;
using s16x4 = __attribute__((ext_vector_type(4))) short;
using f32x4 = __attribute__((ext_vector_type(4))) float;

#define DM 1024
#define NB 4
#define SEQ 8192
#define TL 32768
#define TC 1024
#define TT 33792
#define NCHUNK 264
#define NPROJ 3584
#define NLAYER 4
#define NEXP 16384
#define ALPHA_F 1.681792830507429f
#define SMEM_BYTES 66064
#ifndef MEGA
#define MEGA 1
#endif
#ifndef DBG_HMASK
#define DBG_HMASK 0x40
#endif
#ifndef DBG_RO
#define DBG_RO 0
#endif
#ifndef DBG_STOP
#define DBG_STOP 0
#endif

struct Params {
  const float *x, *c, *ctx, *c_ctx, *w_mod, *b_mod, *w_in, *conv_w, *w_out, *ln1_g, *ln1_b;
  const float *peer_wq, *peer_keys, *peer_u, *peer_v, *ln2_g, *ln2_b;
  float* out;
  float* xres; bf16_t* hA; char* big; bf16_t* cat; float* st; float* ybuf;
  bf16_t *w_inT, *w_outT, *wkT, *ubf, *vbf;
  float* sv; unsigned char* si; int* pe; float* pg;
  float *mod, *modp, *ropec, *ropes;
  unsigned* bar; unsigned* pad0;
  float lg2[2][4];
};

__device__ __forceinline__ bf16_t f2bf(float f) {
  uint32_t u = __float_as_uint(f);
  u += 0x7fffu + ((u >> 16) & 1u);
  return (bf16_t)(u >> 16);
}
__device__ __forceinline__ float bf2f(bf16_t b) { return __uint_as_float(((uint32_t)b) << 16); }
__device__ __forceinline__ uint32_t pack2(float a, float b) { return (uint32_t)f2bf(a) | ((uint32_t)f2bf(b) << 16); }
__device__ __forceinline__ float bflo(uint32_t w) { return __uint_as_float(w << 16); }
__device__ __forceinline__ float bfhi(uint32_t w) { return __uint_as_float(w & 0xffff0000u); }
__device__ __forceinline__ float wave_sum(float v) {
#pragma unroll
  for (int o = 32; o > 0; o >>= 1) v += __shfl_xor(v, o);
  return v;
}
__device__ __forceinline__ float row16_sum(float v) {
  v += __builtin_bit_cast(float, __builtin_amdgcn_update_dpp(0, __builtin_bit_cast(int, v), 0xB1, 0xF, 0xF, true));
  v += __builtin_bit_cast(float, __builtin_amdgcn_update_dpp(0, __builtin_bit_cast(int, v), 0x4E, 0xF, 0xF, true));
  v += __builtin_bit_cast(float, __builtin_amdgcn_update_dpp(0, __builtin_bit_cast(int, v), 0x141, 0xF, 0xF, true));
  v += __builtin_bit_cast(float, __builtin_amdgcn_update_dpp(0, __builtin_bit_cast(int, v), 0x140, 0xF, 0xF, true));
  return v;
}
__device__ __forceinline__ float silu_f(float v) { return v * __builtin_amdgcn_rcpf(1.f + __expf(-v)); }
__device__ __forceinline__ int mod_row(int t) { return t < TL ? (t >> 13) : 4; }

__device__ __forceinline__ f32x4 zero4() { f32x4 a = {0.f, 0.f, 0.f, 0.f}; asm volatile("" : "+v"(a)); return a; }

__device__ __forceinline__ int opaque_tid() { int t = threadIdx.x; asm volatile("" : "+v"(t)); return t; }
__device__ __forceinline__ int opaque_s(int v) { v = __builtin_amdgcn_readfirstlane(v); asm volatile("" : "+s"(v)); return v; }

template <class F, int... I>
__device__ __forceinline__ void static_for_impl(F&& f, std::integer_sequence<int, I...>) { (f(std::integral_constant<int, I>{}), ...); }
template <int N, class F>
__device__ __forceinline__ void static_for(F&& f) { static_for_impl(f, std::make_integer_sequence<int, N>{}); }

__device__ __forceinline__ unsigned tr_lane_base(unsigned base, unsigned ld, unsigned lane) {
  const unsigned g = lane >> 4, q = (lane & 15u) >> 2, p = lane & 3u;
  return base + (8u * g + q) * ld + 8u * p;
}
template <int O0, int O1, int O2, int O3, int D>
__device__ __forceinline__ void tr_frag4(unsigned a, bf16x8& f0, bf16x8& f1, bf16x8& f2, bf16x8& f3) {
  s16x4 r0, r1, r2, r3, r4, r5, r6, r7;
  asm volatile(
      "ds_read_b64_tr_b16 %0, %8 offset:%9\n\t"
      "ds_read_b64_tr_b16 %1, %8 offset:%10\n\t"
      "ds_read_b64_tr_b16 %2, %8 offset:%11\n\t"
      "ds_read_b64_tr_b16 %3, %8 offset:%12\n\t"
      "ds_read_b64_tr_b16 %4, %8 offset:%13\n\t"
      "ds_read_b64_tr_b16 %5, %8 offset:%14\n\t"
      "ds_read_b64_tr_b16 %6, %8 offset:%15\n\t"
      "ds_read_b64_tr_b16 %7, %8 offset:%16\n\t"
      "s_waitcnt lgkmcnt(0)"
      : "=&v"(r0), "=&v"(r1), "=&v"(r2), "=&v"(r3), "=&v"(r4), "=&v"(r5), "=&v"(r6), "=&v"(r7)
      : "v"(a), "n"(O0), "n"(O0 + D), "n"(O1), "n"(O1 + D), "n"(O2), "n"(O2 + D), "n"(O3), "n"(O3 + D)
      : "memory");
  f0 = __builtin_shufflevector(r0, r1, 0, 1, 2, 3, 4, 5, 6, 7);
  f1 = __builtin_shufflevector(r2, r3, 0, 1, 2, 3, 4, 5, 6, 7);
  f2 = __builtin_shufflevector(r4, r5, 0, 1, 2, 3, 4, 5, 6, 7);
  f3 = __builtin_shufflevector(r6, r7, 0, 1, 2, 3, 4, 5, 6, 7);
}

__device__ __forceinline__ void ph_mod_partial(const Params& p, int bid, int nb, char* smem) {
  const int TIX = opaque_tid(); bid = opaque_s(bid);
  float* sm = (float*)smem;
  const int tid = TIX;
  for (int item = bid; item < 4 * 24 * 8; item += nb) {
    const int ks = item & 7, cb = (item >> 3) % 24, l = item / 192;
    __syncthreads();
    for (int idx = tid; idx < 640; idx += 256) {
      const int r = idx >> 7, k = ks * 128 + (idx & 127);
      const float v = (r < 4) ? p.c[r * DM + k] : p.c_ctx[k];
      sm[idx] = silu_f(v);
    }
    __syncthreads();
    const int col = cb * 256 + tid;
    float acc[5] = {0.f, 0.f, 0.f, 0.f, 0.f};
    const float* w = p.w_mod + ((size_t)l * DM + ks * 128) * 6144 + col;
#pragma unroll 4
    for (int k = 0; k < 128; ++k) {
      const float wv = w[(size_t)k * 6144];
#pragma unroll
      for (int r = 0; r < 5; ++r) acc[r] += sm[r * 128 + k] * wv;
    }
#pragma unroll
    for (int r = 0; r < 5; ++r) p.modp[((size_t)(ks * 4 + l) * 5 + r) * 6144 + col] = acc[r];
  }
}

__device__ __forceinline__ void ph_mod_reduce(const Params& p, int bid, int nb) {
  const int TIX = opaque_tid(); bid = opaque_s(bid);
  const int gtid = bid * 256 + TIX, gn = nb * 256;
  for (int idx = gtid; idx < 4 * 5 * 6144; idx += gn) {
    const int l = idx / (5 * 6144), col = idx % 6144;
    float s = p.b_mod[l * 6144 + col];
#pragma unroll
    for (int ks = 0; ks < 8; ++ks) s += p.modp[(size_t)ks * (4 * 5 * 6144) + idx];
    p.mod[idx] = s;
  }
  for (int idx = gtid; idx < 128 * 32; idx += gn) {
    const int pos = idx >> 5, d = idx & 31;
    const float inv = exp2f(-(float)d * (13.287712379549449f / 32.f));
    const float angf = (float)pos * inv;
    const double a = (double)angf;
    const double kk = rint(a * 0.15915494309189535);
    const double r = a - kk * 6.283185307179586;
    const double r2 = r * r;
    double sn = 1.0, cs = 1.0;
    for (int n = 13; n >= 1; --n) {
      sn = 1.0 - sn * r2 / (double)((2 * n) * (2 * n + 1));
      cs = 1.0 - cs * r2 / (double)((2 * n - 1) * (2 * n));
    }
    p.ropec[idx] = (float)cs;
    p.ropes[idx] = (float)(r * sn);
  }
}

__device__ __forceinline__ void ph_transpose_cvt(const float* src, bf16_t* dst, int K, int N, int bid, int nb, char* smem) {
  const int TIX = opaque_tid(); bid = opaque_s(bid);
  float* tile = (float*)smem;
  const int tid = TIX;
  const int ntn = N >> 6, ntk = K >> 6;
  for (int item = bid; item < ntn * ntk; item += nb) {
    const int kt = item / ntn, nt = item % ntn;
    __syncthreads();
#pragma unroll
    for (int i = 0; i < 4; ++i) {
      const int r = (tid >> 4) + 16 * i, c4 = (tid & 15) * 4;
      const float4 v = *(const float4*)(src + (size_t)(kt * 64 + r) * N + nt * 64 + c4);
      tile[r * 65 + c4 + 0] = v.x; tile[r * 65 + c4 + 1] = v.y; tile[r * 65 + c4 + 2] = v.z; tile[r * 65 + c4 + 3] = v.w;
    }
    __syncthreads();
    const int n = tid >> 2, kseg = (tid & 3) * 16;
    uint32_t w[8];
#pragma unroll
    for (int e = 0; e < 8; ++e) w[e] = pack2(tile[(kseg + 2 * e) * 65 + n], tile[(kseg + 2 * e + 1) * 65 + n]);
    uint4* d = (uint4*)(dst + (size_t)(nt * 64 + n) * K + kt * 64 + kseg);
    d[0] = make_uint4(w[0], w[1], w[2], w[3]);
    d[1] = make_uint4(w[4], w[5], w[6], w[7]);
  }
}

__device__ __forceinline__ void ph_wk_fold(const Params& p, int bid, int nb, char* smem) {
  const int TIX = opaque_tid(); bid = opaque_s(bid);
  float* wq_s = (float*)smem;
  float* key_s = wq_s + 64 * 65;
  const int tid = TIX;
  const int tc = tid >> 4, tn = tid & 15;
  for (int item = bid; item < 4 * 16 * 16; item += nb) {
    const int ct = item & 15, hp = (item >> 4) & 15, l = item >> 8;
    float acc[4][8];
#pragma unroll
    for (int a = 0; a < 4; ++a)
#pragma unroll
      for (int b = 0; b < 8; ++b) acc[a][b] = 0.f;
    for (int dh = 0; dh < 2; ++dh) {
      __syncthreads();
#pragma unroll
      for (int i = 0; i < 4; ++i) {
        const int r = (tid >> 4) + 16 * i, c4 = (tid & 15) * 4;
        const float4 v = *(const float4*)(p.peer_wq + ((size_t)l * DM + ct * 64 + r) * 2048 + hp * 128 + dh * 64 + c4);
        wq_s[r * 65 + c4 + 0] = v.x; wq_s[r * 65 + c4 + 1] = v.y; wq_s[r * 65 + c4 + 2] = v.z; wq_s[r * 65 + c4 + 3] = v.w;
      }
#pragma unroll
      for (int i = 0; i < 8; ++i) {
        const int r = (tid >> 4) + 16 * i, c4 = (tid & 15) * 4;
        const float4 v = *(const float4*)(p.peer_keys + (((size_t)l * 2 + (hp & 1)) * 128 + r) * 128 + dh * 64 + c4);
        key_s[r * 65 + c4 + 0] = v.x; key_s[r * 65 + c4 + 1] = v.y; key_s[r * 65 + c4 + 2] = v.z; key_s[r * 65 + c4 + 3] = v.w;
      }
      __syncthreads();
#pragma unroll 4
      for (int d = 0; d < 64; ++d) {
        float av[4], bv[8];
#pragma unroll
        for (int a = 0; a < 4; ++a) av[a] = wq_s[(tc * 4 + a) * 65 + d];
#pragma unroll
        for (int b = 0; b < 8; ++b) bv[b] = key_s[(tn + 16 * b) * 65 + d];
#pragma unroll
        for (int a = 0; a < 4; ++a)
#pragma unroll
          for (int b = 0; b < 8; ++b) acc[a][b] += av[a] * bv[b];
      }
    }
#pragma unroll
    for (int b = 0; b < 8; ++b) {
      const int row = hp * 128 + tn + 16 * b;
      uint2 o;
      o.x = pack2(acc[0][b], acc[1][b]);
      o.y = pack2(acc[2][b], acc[3][b]);
      *(uint2*)(p.wkT + ((size_t)l * 2048 + row) * DM + ct * 64 + tc * 4) = o;
    }
  }
}

#define SCALE_U 128.f
#define SCALE_V 8.f
__device__ __forceinline__ uint32_t pack_fp8x4(float a, float b, float c, float d) {
  int w = 0;
  w = __builtin_amdgcn_cvt_pk_fp8_f32(a, b, w, false);
  w = __builtin_amdgcn_cvt_pk_fp8_f32(c, d, w, true);
  return (uint32_t)w;
}
__device__ __forceinline__ void ph_cvt_uv(const Params& p, int l, int bid, int nb) {
  const int TIX = opaque_tid(); bid = opaque_s(bid);
  const size_t n16 = (size_t)NEXP * DM / 16;
  const float* su = p.peer_u + (size_t)l * NEXP * DM;
  const float* sv = p.peer_v + (size_t)l * NEXP * DM;
  for (size_t i = (size_t)bid * 256 + TIX; i < 2 * n16; i += (size_t)nb * 256) {
    const bool isv = i >= n16;
    const size_t j = isv ? i - n16 : i;
    const float sc = isv ? SCALE_V : SCALE_U;
    const float4* s4 = (const float4*)((isv ? sv : su) + j * 16);
    const float4 a0 = s4[0], a1 = s4[1], a2 = s4[2], a3 = s4[3];
    uint4 o;
    o.x = pack_fp8x4(a0.x * sc, a0.y * sc, a0.z * sc, a0.w * sc);
    o.y = pack_fp8x4(a1.x * sc, a1.y * sc, a1.z * sc, a1.w * sc);
    o.z = pack_fp8x4(a2.x * sc, a2.y * sc, a2.z * sc, a2.w * sc);
    o.w = pack_fp8x4(a3.x * sc, a3.y * sc, a3.z * sc, a3.w * sc);
    *(uint4*)((unsigned char*)(isv ? p.vbf : p.ubf) + j * 16) = o;
  }
}

__device__ __forceinline__ void ph_init_h(const Params& p, int bid, int nb) {
  const int TIX = opaque_tid(); bid = opaque_s(bid);
  const int lane = TIX & 63;
  const int gw = bid * 4 + (TIX >> 6), nw = nb * 4;
  for (int t = gw; t < TT; t += nw) {
    const float* xr = t < TL ? p.x + (size_t)t * DM : p.ctx + (size_t)(t - TL) * DM;
    const float* m = p.mod + (size_t)(0 * 5 + mod_row(t)) * 6144;
#pragma unroll
    for (int i = 0; i < 4; ++i) {
      const int col = lane * 4 + 256 * i;
      const float4 v = *(const float4*)(xr + col);
      const float4 sh = *(const float4*)(m + col);
      const float4 sc = *(const float4*)(m + 1024 + col);
      uint2 o;
      o.x = pack2(v.x * (1.f + sc.x) + sh.x, v.y * (1.f + sc.y) + sh.y);
      o.y = pack2(v.z * (1.f + sc.z) + sh.z, v.w * (1.f + sc.w) + sh.w);
      *(uint2*)(p.hA + (size_t)t * DM + col) = o;
    }
  }
}

__device__ __forceinline__ void gemm_tile_acc(const bf16_t* __restrict__ A, const bf16_t* __restrict__ Bt, int K, int m0, int n0,
                                              char* smem, int tid, f32x4 (&acc)[4][4]) {
  bf16_t* As = (bf16_t*)smem;
  bf16_t* Bs = As + 2 * 128 * 40;
  const int lane = tid & 63, wave = tid >> 6;
  const int wm = wave >> 1, wn = wave & 1;
  const int nk = K >> 5;
#pragma unroll
  for (int i = 0; i < 4; ++i)
#pragma unroll
    for (int j = 0; j < 4; ++j) acc[i][j] = zero4();
  uint4 ra[2], rb[2];
  const int lrow0 = tid >> 2, lkc = (tid & 3) * 8;
  const bf16_t* ga = A + (size_t)(m0 + lrow0) * K + lkc;
  const bf16_t* gb = Bt + (size_t)(n0 + lrow0) * K + lkc;
  __syncthreads();
  ra[0] = *(const uint4*)(ga); ra[1] = *(const uint4*)(ga + (size_t)64 * K);
  rb[0] = *(const uint4*)(gb); rb[1] = *(const uint4*)(gb + (size_t)64 * K);
  *(uint4*)(As + lrow0 * 40 + lkc) = ra[0]; *(uint4*)(As + (lrow0 + 64) * 40 + lkc) = ra[1];
  *(uint4*)(Bs + lrow0 * 40 + lkc) = rb[0]; *(uint4*)(Bs + (lrow0 + 64) * 40 + lkc) = rb[1];
  __syncthreads();
  for (int kt = 0; kt < nk; ++kt) {
    const int cur = kt & 1;
    if (kt + 1 < nk) {
      ra[0] = *(const uint4*)(ga + (kt + 1) * 32); ra[1] = *(const uint4*)(ga + (size_t)64 * K + (kt + 1) * 32);
      rb[0] = *(const uint4*)(gb + (kt + 1) * 32); rb[1] = *(const uint4*)(gb + (size_t)64 * K + (kt + 1) * 32);
    }
    const bf16_t* as = As + cur * 128 * 40 + (wm * 64 + (lane & 15)) * 40 + (lane >> 4) * 8;
    const bf16_t* bs = Bs + cur * 128 * 40 + (wn * 64 + (lane & 15)) * 40 + (lane >> 4) * 8;
    bf16x8 af[4], bfr[4];
#pragma unroll
    for (int i = 0; i < 4; ++i) af[i] = *(const bf16x8*)(as + i * 16 * 40);
#pragma unroll
    for (int j = 0; j < 4; ++j) bfr[j] = *(const bf16x8*)(bs + j * 16 * 40);
#pragma unroll
    for (int i = 0; i < 4; ++i)
#pragma unroll
      for (int j = 0; j < 4; ++j) acc[i][j] = __builtin_amdgcn_mfma_f32_16x16x32_bf16(af[i], bfr[j], acc[i][j], 0, 0, 0);
    if (kt + 1 < nk) {
      const int nx = cur ^ 1;
      *(uint4*)(As + nx * 128 * 40 + lrow0 * 40 + lkc) = ra[0]; *(uint4*)(As + nx * 128 * 40 + (lrow0 + 64) * 40 + lkc) = ra[1];
      *(uint4*)(Bs + nx * 128 * 40 + lrow0 * 40 + lkc) = rb[0]; *(uint4*)(Bs + nx * 128 * 40 + (lrow0 + 64) * 40 + lkc) = rb[1];
    }
    __syncthreads();
  }
}

template <bool OUT_BF16>
__device__ __forceinline__ void ph_gemm(const bf16_t* __restrict__ A, const bf16_t* __restrict__ Bt, void* Cout, int M, int N, int K,
                        int bid, int nb, char* smem) {
  const int TIX = opaque_tid(); bid = opaque_s(bid);
  const int tid = TIX, lane = tid & 63, wave = tid >> 6;
  const int wm = wave >> 1, wn = wave & 1;
  const int ntn = N >> 7, ntm = M >> 7;
  for (int tile = bid; tile < ntn * ntm; tile += nb) {
    const int m0 = (tile / ntn) << 7, n0 = (tile % ntn) << 7;
    f32x4 acc[4][4];
    gemm_tile_acc(A, Bt, K, m0, n0, smem, tid, acc);
#pragma unroll
    for (int i = 0; i < 4; ++i)
#pragma unroll
      for (int j = 0; j < 4; ++j)
#pragma unroll
        for (int r = 0; r < 4; ++r) {
          const int row = m0 + wm * 64 + i * 16 + (lane >> 4) * 4 + r;
          const int col = n0 + wn * 64 + j * 16 + (lane & 15);
          if (OUT_BF16) ((bf16_t*)Cout)[(size_t)row * N + col] = f2bf(acc[i][j][r]);
          else ((float*)Cout)[(size_t)row * N + col] = acc[i][j][r];
        }
  }
}

__device__ __forceinline__ void ph_elem(const Params& p, int l, int bid, int nb) {
  const int TIX = opaque_tid(); bid = opaque_s(bid);
  bf16_t* proj = (bf16_t*)p.big;
  const int tid = TIX;
  const int sub = tid & 127;
  for (int tp = bid; tp < TT / 2; tp += nb) {
    const int t = tp * 2 + (tid >> 7);
    bf16_t* row = proj + (size_t)t * NPROJ;
    if (sub < 64) {
      const int ch = sub * 8;
      bool hasl, hasr;
      if (t < TL) { const int i = t & 63; hasl = i != 0; hasr = i != 63; }
      else { const int i = (t - TL) & 255; hasl = i != 0; hasr = i != 255; }
      const uint4 bg = *(const uint4*)(row + ch);
      const uint4 c1 = *(const uint4*)(row + 512 + ch), h1 = *(const uint4*)(row + 1024 + ch);
      uint4 c0 = make_uint4(0, 0, 0, 0), h0 = c0, c2 = c0, h2 = c0;
      if (hasl) { c0 = *(const uint4*)(row - NPROJ + 512 + ch); h0 = *(const uint4*)(row - NPROJ + 1024 + ch); }
      if (hasr) { c2 = *(const uint4*)(row + NPROJ + 512 + ch); h2 = *(const uint4*)(row + NPROJ + 1024 + ch); }
      const uint32_t bgw[4] = {bg.x, bg.y, bg.z, bg.w};
      const uint32_t c0w[4] = {c0.x, c0.y, c0.z, c0.w}, c1w[4] = {c1.x, c1.y, c1.z, c1.w}, c2w[4] = {c2.x, c2.y, c2.z, c2.w};
      const uint32_t h0w[4] = {h0.x, h0.y, h0.z, h0.w}, h1w[4] = {h1.x, h1.y, h1.z, h1.w}, h2w[4] = {h2.x, h2.y, h2.z, h2.w};
      const float* cw = p.conv_w + ((size_t)l * 512 + ch) * 3;
      uint32_t ow[4];
#pragma unroll
      for (int e = 0; e < 4; ++e) {
        const float z0a = bflo(c0w[e]) * bflo(h0w[e]), z1a = bflo(c1w[e]) * bflo(h1w[e]), z2a = bflo(c2w[e]) * bflo(h2w[e]);
        const float z0b = bfhi(c0w[e]) * bfhi(h0w[e]), z1b = bfhi(c1w[e]) * bfhi(h1w[e]), z2b = bfhi(c2w[e]) * bfhi(h2w[e]);
        const float* wa = cw + (2 * e) * 3;
        const float ya = z0a * wa[0] + z1a * wa[1] + z2a * wa[2];
        const float yb = z0b * wa[3] + z1b * wa[4] + z2b * wa[5];
        ow[e] = pack2(bflo(bgw[e]) * ya, bfhi(bgw[e]) * yb);
      }
      *(uint4*)(p.cat + (size_t)t * DM + ch) = make_uint4(ow[0], ow[1], ow[2], ow[3]);
    } else {
      const int it = sub - 64;
      const int hd = it >> 4, isk = (it >> 3) & 1, half = (it >> 2) & 1, dg = it & 3;
      bf16_t* b1 = row + 1536 + isk * 512 + hd * 128 + half * 64 + dg * 8;
      const uint4 u1 = *(const uint4*)b1, u2 = *(const uint4*)(b1 + 32);
      const uint32_t u1w[4] = {u1.x, u1.y, u1.z, u1.w}, u2w[4] = {u2.x, u2.y, u2.z, u2.w};
      const float scl = isk ? 0.08838834764831845f : 1.f;
      float cs[8], sn[8];
      if (t < TL) {
        const int i = t & 8191;
        const int pos = half ? (i & 63) : (i >> 6);
#pragma unroll
        for (int e = 0; e < 8; ++e) { cs[e] = p.ropec[pos * 32 + dg * 8 + e]; sn[e] = p.ropes[pos * 32 + dg * 8 + e]; }
      } else {
#pragma unroll
        for (int e = 0; e < 8; ++e) { cs[e] = 1.f; sn[e] = 0.f; }
      }
      uint32_t o1[4], o2[4];
#pragma unroll
      for (int e = 0; e < 4; ++e) {
        const float a0 = bflo(u1w[e]), a1 = bfhi(u1w[e]), b0 = bflo(u2w[e]), b1v = bfhi(u2w[e]);
        o1[e] = pack2((a0 * cs[2 * e] - b0 * sn[2 * e]) * scl, (a1 * cs[2 * e + 1] - b1v * sn[2 * e + 1]) * scl);
        o2[e] = pack2((a0 * sn[2 * e] + b0 * cs[2 * e]) * scl, (a1 * sn[2 * e + 1] + b1v * cs[2 * e + 1]) * scl);
      }
      *(uint4*)b1 = make_uint4(o1[0], o1[1], o1[2], o1[3]);
      *(uint4*)(b1 + 32) = make_uint4(o2[0], o2[1], o2[2], o2[3]);
    }
  }
}

__device__ __forceinline__ void ph_ret_upd(const Params& p, int bid, int nb, char* smem) {
  const int TIX = opaque_tid(); bid = opaque_s(bid);
  const bf16_t* proj = (const bf16_t*)p.big;
  bf16_t* Vs = (bf16_t*)smem;
  bf16_t* Ks = Vs + 64 * 136;
  const int tid = TIX, lane = tid & 63, wave = tid >> 6;
  const int wm = wave >> 1, wn = wave & 1;
  const unsigned va = tr_lane_base((unsigned)(size_t)Vs, 272u, lane) + wm * 128;
  const unsigned ka = tr_lane_base((unsigned)(size_t)Ks, 272u, lane) + wn * 128;
  for (int item = bid; item < NCHUNK * 4; item += nb) {
    const int c = item >> 2, hd = item & 3;
    const int t0 = c * 128;
    for (int dir = 0; dir < 2; ++dir) {
      const float lg = p.lg2[dir][hd];
      f32x4 acc[4][4];
#pragma unroll
      for (int i = 0; i < 4; ++i)
#pragma unroll
        for (int j = 0; j < 4; ++j) acc[i][j] = zero4();
      for (int half = 0; half < 2; ++half) {
        __syncthreads();
#pragma unroll
        for (int i = 0; i < 4; ++i) {
          const int idx = tid + 256 * i;
          const int r = idx >> 4, ck = (idx & 15) * 8;
          const int s = half * 64 + r;
          const bf16_t* src = proj + (size_t)(t0 + s) * NPROJ + hd * 128 + ck;
          const uint4 vv = *(const uint4*)(src + 2560);
          const uint4 kv = *(const uint4*)(src + 2048);
          const float w = exp2f((dir == 0 ? (float)(127 - s) : (float)s) * lg);
          uint4 ko;
          ko.x = pack2(bflo(kv.x) * w, bfhi(kv.x) * w); ko.y = pack2(bflo(kv.y) * w, bfhi(kv.y) * w);
          ko.z = pack2(bflo(kv.z) * w, bfhi(kv.z) * w); ko.w = pack2(bflo(kv.w) * w, bfhi(kv.w) * w);
          *(uint4*)(Vs + r * 136 + ck) = vv;
          *(uint4*)(Ks + r * 136 + ck) = ko;
        }
        __syncthreads();
        static_for<2>([&](auto KS) {
          constexpr int ks = decltype(KS)::value;
          bf16x8 af[4], bfr[4];
          tr_frag4<ks * 32 * 272 + 0, ks * 32 * 272 + 32, ks * 32 * 272 + 64, ks * 32 * 272 + 96, 4 * 272>(va, af[0], af[1], af[2], af[3]);
          tr_frag4<ks * 32 * 272 + 0, ks * 32 * 272 + 32, ks * 32 * 272 + 64, ks * 32 * 272 + 96, 4 * 272>(ka, bfr[0], bfr[1], bfr[2], bfr[3]);
#pragma unroll
          for (int i = 0; i < 4; ++i)
#pragma unroll
            for (int j = 0; j < 4; ++j) acc[i][j] = __builtin_amdgcn_mfma_f32_16x16x32_bf16(af[i], bfr[j], acc[i][j], 0, 0, 0);
        });
      }
      float* dst = p.st + ((size_t)(dir * NCHUNK + c) * 4 + hd) * 16384;
#pragma unroll
      for (int i = 0; i < 4; ++i)
#pragma unroll
        for (int j = 0; j < 4; ++j)
#pragma unroll
          for (int r = 0; r < 4; ++r) {
            const int row = wm * 64 + i * 16 + (lane >> 4) * 4 + r;
            const int col = wn * 64 + j * 16 + (lane & 15);
            dst[row * 128 + col] = acc[i][j][r];
          }
    }
  }
}

__device__ __forceinline__ void ph_ret_scan(const Params& p, int bid, int nb) {
  const int TIX = opaque_tid(); bid = opaque_s(bid);
  const int gtid = bid * 256 + TIX, gn = nb * 256;
  for (int idx = gtid; idx < 2 * 4 * 4 * 16384; idx += gn) {
    const int e = idx & 16383, hd = (idx >> 14) & 3, b = (idx >> 16) & 3, dir = idx >> 18;
    const float dc = exp2f(128.f * p.lg2[dir][hd]);
    const size_t boff = (size_t)dir * NCHUNK * 4 * 16384 + (size_t)hd * 16384 + e;
    const float* src = p.st + boff;
    float* dst = p.ybuf + boff;
    float carry = 0.f;
    if (dir == 0) {
      for (int n = 0; n < 2; ++n) {
        const size_t o = (size_t)(256 + b * 2 + n) * 4 * 16384;
        const float u = src[o]; dst[o] = carry; carry = carry * dc + u;
      }
      for (int n = 0; n < 64; ++n) {
        const size_t o = (size_t)(b * 64 + n) * 4 * 16384;
        const float u = src[o]; dst[o] = carry; carry = carry * dc + u;
      }
    } else {
      for (int n = 1; n >= 0; --n) {
        const size_t o = (size_t)(256 + b * 2 + n) * 4 * 16384;
        const float u = src[o]; dst[o] = carry; carry = carry * dc + u;
      }
      for (int n = 63; n >= 0; --n) {
        const size_t o = (size_t)(b * 64 + n) * 4 * 16384;
        const float u = src[o]; dst[o] = carry; carry = carry * dc + u;
      }
    }
  }
}

__device__ __forceinline__ void ph_ret_out(const Params& p, int bid, int nb, char* smem) {
  const int TIX = opaque_tid(); bid = opaque_s(bid);
  const bf16_t* proj = (const bf16_t*)p.big;
  bf16_t* buf = (bf16_t*)smem;
  bf16_t* Pb = buf + 128 * 136;
  const int tid = TIX, lane = tid & 63, wave = tid >> 6;
  const unsigned ba = tr_lane_base((unsigned)(size_t)buf, 272u, lane);
  const int g = lane >> 4, l15 = lane & 15;
  bf16_t* Pw = Pb + wave * 16 * 136;
  for (int item = bid; item < NCHUNK * 8; item += nb) {
    const int c = item >> 3, hd = (item >> 1) & 3, rh = item & 1;
    const int t0 = c * 128;
    const int rw = rh * 64 + wave * 16;
    const float lgf = p.lg2[0][hd], lgb = p.lg2[1][hd];
    bf16x8 qf[4];
#pragma unroll
    for (int ks = 0; ks < 4; ++ks)
      qf[ks] = *(const bf16x8*)(proj + (size_t)(t0 + rw + l15) * NPROJ + 1536 + hd * 128 + ks * 32 + g * 8);
    f32x4 acc[8];
    if (!(DBG_RO & 4)) {
    __syncthreads();
#pragma unroll
    for (int i = 0; i < 8; ++i) {
      const int idx = tid + 256 * i; const int r = idx >> 4, ck = (idx & 15) * 8;
      *(uint4*)(buf + r * 136 + ck) = *(const uint4*)(proj + (size_t)(t0 + r) * NPROJ + 2048 + hd * 128 + ck);
    }
    __syncthreads();
#pragma unroll
    for (int nt = 0; nt < 8; ++nt) acc[nt] = zero4();
#pragma unroll
    for (int ks = 0; ks < 4; ++ks) {
#pragma unroll
      for (int nt = 0; nt < 8; ++nt) {
        const bf16x8 bfr = *(const bf16x8*)(buf + (nt * 16 + l15) * 136 + ks * 32 + g * 8);
        acc[nt] = __builtin_amdgcn_mfma_f32_16x16x32_bf16(qf[ks], bfr, acc[nt], 0, 0, 0);
      }
    }
#pragma unroll
    for (int nt = 0; nt < 8; ++nt)
#pragma unroll
      for (int r = 0; r < 4; ++r) {
        const int tl = g * 4 + r;
        const int t = rw + tl, s = nt * 16 + l15;
        const float d = (s <= t) ? exp2f((float)(t - s) * lgf) : exp2f((float)(s - t) * lgb);
        Pw[tl * 136 + s] = f2bf(acc[nt][r] * d);
      }
    __syncthreads();
#pragma unroll
    for (int i = 0; i < 8; ++i) {
      const int idx = tid + 256 * i; const int r = idx >> 4, ck = (idx & 15) * 8;
      *(uint4*)(buf + r * 136 + ck) = *(const uint4*)(proj + (size_t)(t0 + r) * NPROJ + 2560 + hd * 128 + ck);
    }
    __syncthreads();
    }
    f32x4 o[8];
#pragma unroll
    for (int nt = 0; nt < 8; ++nt) o[nt] = zero4();
    if (!(DBG_RO & 1)) static_for<4>([&](auto KS) {
      constexpr int ks = decltype(KS)::value;
      const bf16x8 pf = *(const bf16x8*)(Pw + l15 * 136 + ks * 32 + g * 8);
      static_for<2>([&](auto NH) {
        constexpr int nh = decltype(NH)::value;
        bf16x8 bfr[4];
        tr_frag4<ks * 32 * 272 + nh * 128 + 0, ks * 32 * 272 + nh * 128 + 32, ks * 32 * 272 + nh * 128 + 64, ks * 32 * 272 + nh * 128 + 96, 4 * 272>(
            ba, bfr[0], bfr[1], bfr[2], bfr[3]);
#pragma unroll
        for (int j = 0; j < 4; ++j) o[nh * 4 + j] = __builtin_amdgcn_mfma_f32_16x16x32_bf16(pf, bfr[j], o[nh * 4 + j], 0, 0, 0);
      });
    });
    if (!(DBG_RO & 2)) for (int dir = 0; dir < 2; ++dir) {
      __syncthreads();
      const float* ssrc = p.ybuf + ((size_t)(dir * NCHUNK + c) * 4 + hd) * 16384;
#pragma unroll
      for (int i = 0; i < 16; ++i) {
        const int idx = tid + 256 * i; const int r = idx >> 5, c4 = (idx & 31) * 4;
        const float4 v = *(const float4*)(ssrc + r * 128 + c4);
        uint2 w; w.x = pack2(v.x, v.y); w.y = pack2(v.z, v.w);
        *(uint2*)(buf + r * 136 + c4) = w;
      }
      __syncthreads();
      float fr[4];
#pragma unroll
      for (int r = 0; r < 4; ++r) {
        const int t = rw + g * 4 + r;
        fr[r] = (dir == 0) ? exp2f((float)(t + 1) * lgf) : exp2f((float)(128 - t) * lgb);
      }
#pragma unroll
      for (int nt = 0; nt < 8; ++nt) acc[nt] = zero4();
      __builtin_amdgcn_sched_barrier(0);
#pragma unroll
      for (int ks = 0; ks < 4; ++ks) {
#pragma unroll
        for (int nt = 0; nt < 8; ++nt) {
          const bf16x8 bfr = *(const bf16x8*)(buf + (nt * 16 + l15) * 136 + ks * 32 + g * 8);
          acc[nt] = __builtin_amdgcn_mfma_f32_16x16x32_bf16(qf[ks], bfr, acc[nt], 0, 0, 0);
        }
      }
      __builtin_amdgcn_sched_barrier(0);
      asm volatile("s_nop 15\n\ts_nop 15\n\ts_nop 15\n\ts_nop 15" ::: "memory");
      __builtin_amdgcn_sched_barrier(0);
#pragma unroll
      for (int r = 0; r < 4; ++r) {
#pragma unroll
        for (int nt = 0; nt < 8; ++nt) o[nt][r] += fr[r] * acc[nt][r];
      }
    }
#pragma unroll
    for (int r = 0; r < 4; ++r) {
      const int t = t0 + rw + g * 4 + r;
#pragma unroll
      for (int nt = 0; nt < 8; ++nt) p.cat[(size_t)t * DM + 512 + hd * 128 + nt * 16 + l15] = f2bf(o[nt][r]);
    }
  }
}

__device__ __forceinline__ void ph_gnorm(const Params& p, int bid, int nb) {
  const int TIX = opaque_tid(); bid = opaque_s(bid);
  const bf16_t* proj = (const bf16_t*)p.big;
  const int lane = TIX & 63;
  const int gw = bid * 4 + (TIX >> 6), nw = nb * 4;
  for (int t = gw; t < TT; t += nw) {
    bf16_t* op = p.cat + (size_t)t * DM + 512 + lane * 8;
    const uint4 ov = *(const uint4*)op;
    const uint4 gv = *(const uint4*)(proj + (size_t)t * NPROJ + 3072 + lane * 8);
    float o[8], gg[8];
    o[0] = bflo(ov.x); o[1] = bfhi(ov.x); o[2] = bflo(ov.y); o[3] = bfhi(ov.y);
    o[4] = bflo(ov.z); o[5] = bfhi(ov.z); o[6] = bflo(ov.w); o[7] = bfhi(ov.w);
    gg[0] = bflo(gv.x); gg[1] = bfhi(gv.x); gg[2] = bflo(gv.y); gg[3] = bfhi(gv.y);
    gg[4] = bflo(gv.z); gg[5] = bfhi(gv.z); gg[6] = bflo(gv.w); gg[7] = bfhi(gv.w);
    float s1 = 0.f;
#pragma unroll
    for (int i = 0; i < 8; ++i) s1 += o[i];
    s1 = row16_sum(s1);
    const float mu = s1 * (1.f / 128.f);
    float s2 = 0.f;
#pragma unroll
    for (int i = 0; i < 8; ++i) { const float d = o[i] - mu; s2 += d * d; }
    s2 = row16_sum(s2);
    const float rs = rsqrtf(s2 * (1.f / 128.f) + 1e-5f);
    float y[8];
#pragma unroll
    for (int i = 0; i < 8; ++i) y[i] = silu_f(gg[i]) * (o[i] - mu) * rs;
    *(uint4*)op = make_uint4(pack2(y[0], y[1]), pack2(y[2], y[3]), pack2(y[4], y[5]), pack2(y[6], y[7]));
  }
}

__device__ __forceinline__ void ph_ln(const Params& p, int l, int which, int bid, int nb) {
  const int TIX = opaque_tid(); bid = opaque_s(bid);
  const int lane = TIX & 63;
  const int gw = bid * 4 + (TIX >> 6), nw = nb * 4;
  const float* lg = (which == 1 ? p.ln1_g : p.ln2_g) + (size_t)l * DM;
  const float* lb = (which == 1 ? p.ln1_b : p.ln2_b) + (size_t)l * DM;
  const bool last = (l == NLAYER - 1);
  for (int t = gw; t < TT; t += nw) {
    const float* xr;
    if (l == 0 && which == 1) xr = t < TL ? p.x + (size_t)t * DM : p.ctx + (size_t)(t - TL) * DM;
    else xr = p.xres + (size_t)t * DM;
    const float* yr = p.ybuf + (size_t)t * DM;
    const float* m = p.mod + (size_t)(l * 5 + mod_row(t)) * 6144;
    const float* mg = m + (which == 1 ? 2048 : 5120);
    float v[16];
    float s1 = 0.f;
#pragma unroll
    for (int i = 0; i < 4; ++i) {
      const int col = lane * 4 + 256 * i;
      const float4 xv = *(const float4*)(xr + col);
      const float4 yv = *(const float4*)(yr + col);
      const float4 gv = *(const float4*)(mg + col);
      v[4 * i + 0] = ALPHA_F * xv.x + gv.x * yv.x; v[4 * i + 1] = ALPHA_F * xv.y + gv.y * yv.y;
      v[4 * i + 2] = ALPHA_F * xv.z + gv.z * yv.z; v[4 * i + 3] = ALPHA_F * xv.w + gv.w * yv.w;
      s1 += v[4 * i + 0] + v[4 * i + 1] + v[4 * i + 2] + v[4 * i + 3];
    }
    const float mu = wave_sum(s1) * (1.f / 1024.f);
    float s2 = 0.f;
#pragma unroll
    for (int i = 0; i < 16; ++i) { const float d = v[i] - mu; s2 += d * d; }
    const float rs = rsqrtf(wave_sum(s2) * (1.f / 1024.f) + 1e-5f);
    const float* msh; const float* msc;
    if (which == 1) { msh = m + 3072; msc = m + 4096; }
    else { const float* m2 = p.mod + (size_t)((last ? l : l + 1) * 5 + mod_row(t)) * 6144; msh = m2; msc = m2 + 1024; }
#pragma unroll
    for (int i = 0; i < 4; ++i) {
      const int col = lane * 4 + 256 * i;
      const float4 gg = *(const float4*)(lg + col);
      const float4 bb = *(const float4*)(lb + col);
      float4 o;
      o.x = (v[4 * i + 0] - mu) * rs * gg.x + bb.x; o.y = (v[4 * i + 1] - mu) * rs * gg.y + bb.y;
      o.z = (v[4 * i + 2] - mu) * rs * gg.z + bb.z; o.w = (v[4 * i + 3] - mu) * rs * gg.w + bb.w;
      *(float4*)(p.xres + (size_t)t * DM + col) = o;
      if (which == 2 && last && t < TL) *(float4*)(p.out + (size_t)t * DM + col) = o;
      const float4 sh = *(const float4*)(msh + col);
      const float4 sc = *(const float4*)(msc + col);
      uint2 h;
      h.x = pack2(o.x * (1.f + sc.x) + sh.x, o.y * (1.f + sc.y) + sh.y);
      h.y = pack2(o.z * (1.f + sc.z) + sh.z, o.w * (1.f + sc.w) + sh.w);
      *(uint2*)(p.hA + (size_t)t * DM + col) = h;
    }
  }
}

#define TK_INSERT(V, I, xv, xi)                                        \
  if ((xv) > V[15]) {                                                  \
    V[15] = (xv); I[15] = (xi);                                        \
    _Pragma("unroll") for (int q_ = 15; q_ > 0; --q_) {                \
      const bool sw_ = V[q_] > V[q_ - 1];                              \
      const float tv_ = V[q_]; const int ti_ = I[q_];                  \
      V[q_] = sw_ ? V[q_ - 1] : tv_; I[q_] = sw_ ? I[q_ - 1] : ti_;    \
      V[q_ - 1] = sw_ ? tv_ : V[q_ - 1]; I[q_ - 1] = sw_ ? ti_ : I[q_ - 1]; \
    }                                                                  \
  }

__device__ __forceinline__ void ph_topk1(const Params& p, int bid, int nb) {
  const int TIX = opaque_tid(); bid = opaque_s(bid);
  const float* scores = (const float*)p.big;
  const int gtid = bid * 256 + TIX, gn = nb * 256;
  for (int idx = gtid; idx < TT * 16; idx += gn) {
    const float* row = scores + (size_t)idx * 128;
    float V[16]; int I[16];
#pragma unroll
    for (int i = 0; i < 16; ++i) { V[i] = -3.0e38f; I[i] = 0; }
    for (int i4 = 0; i4 < 32; ++i4) {
      const float4 x = *(const float4*)(row + i4 * 4);
      TK_INSERT(V, I, x.x, i4 * 4 + 0)
      TK_INSERT(V, I, x.y, i4 * 4 + 1)
      TK_INSERT(V, I, x.z, i4 * 4 + 2)
      TK_INSERT(V, I, x.w, i4 * 4 + 3)
    }
    float4* dv = (float4*)(p.sv + (size_t)idx * 16);
    dv[0] = make_float4(V[0], V[1], V[2], V[3]); dv[1] = make_float4(V[4], V[5], V[6], V[7]);
    dv[2] = make_float4(V[8], V[9], V[10], V[11]); dv[3] = make_float4(V[12], V[13], V[14], V[15]);
    uint4 di;
    di.x = I[0] | (I[1] << 8) | (I[2] << 16) | (I[3] << 24);
    di.y = I[4] | (I[5] << 8) | (I[6] << 16) | (I[7] << 24);
    di.z = I[8] | (I[9] << 8) | (I[10] << 16) | (I[11] << 24);
    di.w = I[12] | (I[13] << 8) | (I[14] << 16) | (I[15] << 24);
    *(uint4*)(p.si + (size_t)idx * 16) = di;
  }
}

__device__ __forceinline__ void ph_topk2(const Params& p, int bid, int nb) {
  const int TIX = opaque_tid(); bid = opaque_s(bid);
  const int gtid = bid * 256 + TIX, gn = nb * 256;
  for (int idx = gtid; idx < TT * 8; idx += gn) {
    float a[16], b[16]; int ia[16], ib[16];
    {
      const float4* pa = (const float4*)(p.sv + (size_t)idx * 32);
#pragma unroll
      for (int i = 0; i < 4; ++i) { const float4 v = pa[i]; a[4 * i] = v.x; a[4 * i + 1] = v.y; a[4 * i + 2] = v.z; a[4 * i + 3] = v.w; }
#pragma unroll
      for (int i = 0; i < 4; ++i) { const float4 v = pa[4 + i]; b[4 * i] = v.x; b[4 * i + 1] = v.y; b[4 * i + 2] = v.z; b[4 * i + 3] = v.w; }
      const uint4 qa = *(const uint4*)(p.si + (size_t)idx * 32), qb = *(const uint4*)(p.si + (size_t)idx * 32 + 16);
      const uint32_t wa[4] = {qa.x, qa.y, qa.z, qa.w}, wb[4] = {qb.x, qb.y, qb.z, qb.w};
#pragma unroll
      for (int i = 0; i < 16; ++i) { ia[i] = (wa[i >> 2] >> (8 * (i & 3))) & 255; ib[i] = (wb[i >> 2] >> (8 * (i & 3))) & 255; }
    }
    float V[16]; int I[16];
#pragma unroll
    for (int i = 0; i < 16; ++i) { V[i] = -3.0e38f; I[i] = 0; }
#pragma unroll
    for (int i = 0; i < 16; ++i) {
#pragma unroll
      for (int j = 0; j < 16; ++j) {
        if ((i + 1) * (j + 1) <= 16) {
          const float cv = a[i] + b[j];
          const int ce = ia[i] * 128 + ib[j];
          TK_INSERT(V, I, cv, ce)
        }
      }
    }
    float e[16], sum = 0.f;
#pragma unroll
    for (int i = 0; i < 16; ++i) { e[i] = __expf(V[i] - V[0]); sum += e[i]; }
    const float inv = 1.f / sum;
    int4* de = (int4*)(p.pe + (size_t)idx * 16);
    float4* dg = (float4*)(p.pg + (size_t)idx * 16);
#pragma unroll
    for (int i = 0; i < 4; ++i) {
      de[i] = make_int4(I[4 * i], I[4 * i + 1], I[4 * i + 2], I[4 * i + 3]);
      dg[i] = make_float4(e[4 * i] * inv, e[4 * i + 1] * inv, e[4 * i + 2] * inv, e[4 * i + 3] * inv);
    }
  }
}

__device__ __forceinline__ void ph_wk_topk(const Params& p, int l, int bid, int nb, char* smem) {
  const int TIX = opaque_tid(); bid = opaque_s(bid);
  const int tid = TIX, lane = tid & 63, wave = tid >> 6;
  const int wm = wave >> 1, wn = wave & 1;
  float* sc = (float*)smem;
  const bf16_t* Bt = p.wkT + (size_t)l * 2048 * DM;
  for (int item = bid; item < (TT / 128) * 8; item += nb) {
    const int m0 = (item >> 3) << 7, hh = item & 7;
    float V0[16]; int I0[16];
#pragma unroll
    for (int i = 0; i < 16; ++i) { V0[i] = -3.0e38f; I0[i] = 0; }
    for (int ph = 0; ph < 2; ++ph) {
      f32x4 acc[4][4];
      gemm_tile_acc(p.hA, Bt, DM, m0, (hh * 2 + ph) * 128, smem, tid, acc);
#pragma unroll
      for (int i = 0; i < 4; ++i)
#pragma unroll
        for (int j = 0; j < 4; ++j)
#pragma unroll
          for (int r = 0; r < 4; ++r)
            sc[(wm * 64 + i * 16 + (lane >> 4) * 4 + r) * 129 + wn * 64 + j * 16 + (lane & 15)] = acc[i][j][r];
      __syncthreads();
      if (tid < 128) {
        const float* row = sc + tid * 129;
        float V[16]; int I[16];
#pragma unroll
        for (int i = 0; i < 16; ++i) { V[i] = -3.0e38f; I[i] = 0; }
        for (int c = 0; c < 128; c += 4) {
          const float x0 = row[c], x1 = row[c + 1], x2 = row[c + 2], x3 = row[c + 3];
          TK_INSERT(V, I, x0, c)
          TK_INSERT(V, I, x1, c + 1)
          TK_INSERT(V, I, x2, c + 2)
          TK_INSERT(V, I, x3, c + 3)
        }
        if (ph == 0) {
#pragma unroll
          for (int i = 0; i < 16; ++i) { V0[i] = V[i]; I0[i] = I[i]; }
        } else {
          float CV[16]; int CI[16];
#pragma unroll
          for (int i = 0; i < 16; ++i) { CV[i] = -3.0e38f; CI[i] = 0; }
#pragma unroll
          for (int i = 0; i < 16; ++i) {
#pragma unroll
            for (int j = 0; j < 16; ++j) {
              if ((i + 1) * (j + 1) <= 16) {
                const float cv = V0[i] + V[j];
                const int ce = I0[i] * 128 + I[j];
                TK_INSERT(CV, CI, cv, ce)
              }
            }
          }
          float e[16], sum = 0.f;
#pragma unroll
          for (int i = 0; i < 16; ++i) { e[i] = __expf(CV[i] - CV[0]); sum += e[i]; }
          const float inv = 1.f / sum;
          const size_t o = ((size_t)(m0 + tid) * 8 + hh) * 16;
          int4* de = (int4*)(p.pe + o);
          float4* dg = (float4*)(p.pg + o);
#pragma unroll
          for (int i = 0; i < 4; ++i) {
            de[i] = make_int4(CI[4 * i], CI[4 * i + 1], CI[4 * i + 2], CI[4 * i + 3]);
            dg[i] = make_float4(e[4 * i] * inv, e[4 * i + 1] * inv, e[4 * i + 2] * inv, e[4 * i + 3] * inv);
          }
        }
      }
    }
  }
}

typedef float f32x2 __attribute__((ext_vector_type(2)));
__device__ __forceinline__ float wave_sum_fast(float v) {
  v = row16_sum(v);
  v += __shfl_xor(v, 16);
  v += __shfl_xor(v, 32);
  return v;
}
#define FP8_DOT(W, H0, H1, H2, H3, D)                                                            \
  { const f32x2 t0_ = __builtin_amdgcn_cvt_pk_f32_fp8((int)(W), false);                          \
    const f32x2 t1_ = __builtin_amdgcn_cvt_pk_f32_fp8((int)(W), true);                           \
    D += t0_.x * (H0) + t0_.y * (H1) + t1_.x * (H2) + t1_.y * (H3); }
#define FP8_AXPY(W, A, C0, C1, C2, C3)                                                           \
  { const f32x2 t0_ = __builtin_amdgcn_cvt_pk_f32_fp8((int)(W), false);                          \
    const f32x2 t1_ = __builtin_amdgcn_cvt_pk_f32_fp8((int)(W), true);                           \
    C0 += (A) * t0_.x; C1 += (A) * t0_.y; C2 += (A) * t1_.x; C3 += (A) * t1_.y; }

__device__ __forceinline__ void ph_gather_ln2(const Params& p, int l, int bid, int nb) {
  const int TIX = opaque_tid(); bid = opaque_s(bid);
  const int lane = TIX & 63;
  const int gw = bid * 4 + (TIX >> 6), nw = nb * 4;
  const unsigned char* ut = (const unsigned char*)p.ubf;
  const unsigned char* vt = (const unsigned char*)p.vbf;
  const bool last = (l == NLAYER - 1);
  const float* lg = p.ln2_g + (size_t)l * DM + lane * 16;
  const float* lb = p.ln2_b + (size_t)l * DM + lane * 16;
  for (int t = gw; t < TT; t += nw) {
    const bf16_t* hrow = p.hA + (size_t)t * DM + lane * 16;
    const uint4 h0 = *(const uint4*)hrow, h1 = *(const uint4*)(hrow + 8);
    float hf[16];
    hf[0] = bflo(h0.x); hf[1] = bfhi(h0.x); hf[2] = bflo(h0.y); hf[3] = bfhi(h0.y);
    hf[4] = bflo(h0.z); hf[5] = bfhi(h0.z); hf[6] = bflo(h0.w); hf[7] = bfhi(h0.w);
    hf[8] = bflo(h1.x); hf[9] = bfhi(h1.x); hf[10] = bflo(h1.y); hf[11] = bfhi(h1.y);
    hf[12] = bflo(h1.z); hf[13] = bfhi(h1.z); hf[14] = bflo(h1.w); hf[15] = bfhi(h1.w);
    float acc[16];
#pragma unroll
    for (int i = 0; i < 16; ++i) acc[i] = 0.f;
    const int e_lo = p.pe[(size_t)t * 128 + lane], e_hi = p.pe[(size_t)t * 128 + 64 + lane];
    const float g_lo = p.pg[(size_t)t * 128 + lane], g_hi = p.pg[(size_t)t * 128 + 64 + lane];
    for (int kb = 0; kb < 128; kb += 8) {
      float gt[8];
      uint4 uw[8], vw[8];
#pragma unroll
      for (int u = 0; u < 8; ++u) {
        const int k = kb + u;
        const int e = __shfl(k < 64 ? e_lo : e_hi, k & 63);
        gt[u] = __shfl(k < 64 ? g_lo : g_hi, k & 63);
        uw[u] = *(const uint4*)(ut + (size_t)e * DM + lane * 16);
        vw[u] = *(const uint4*)(vt + (size_t)e * DM + lane * 16);
      }
      float d[8];
#pragma unroll
      for (int u = 0; u < 8; ++u) {
        float dd = 0.f;
        FP8_DOT(uw[u].x, hf[0], hf[1], hf[2], hf[3], dd)
        FP8_DOT(uw[u].y, hf[4], hf[5], hf[6], hf[7], dd)
        FP8_DOT(uw[u].z, hf[8], hf[9], hf[10], hf[11], dd)
        FP8_DOT(uw[u].w, hf[12], hf[13], hf[14], hf[15], dd)
        d[u] = dd;
      }
#pragma unroll
      for (int u = 0; u < 8; ++u) d[u] = wave_sum_fast(d[u]) * (1.f / SCALE_U);
#pragma unroll
      for (int u = 0; u < 8; ++u) {
        const float a = gt[u] * 0.5f * d[u] * (1.f + erff(d[u] * 0.7071067811865476f)) * (1.f / SCALE_V);
        FP8_AXPY(vw[u].x, a, acc[0], acc[1], acc[2], acc[3])
        FP8_AXPY(vw[u].y, a, acc[4], acc[5], acc[6], acc[7])
        FP8_AXPY(vw[u].z, a, acc[8], acc[9], acc[10], acc[11])
        FP8_AXPY(vw[u].w, a, acc[12], acc[13], acc[14], acc[15])
      }
    }
    const float* xr = p.xres + (size_t)t * DM + lane * 16;
    const float* m = p.mod + (size_t)(l * 5 + mod_row(t)) * 6144 + lane * 16;
    float v[16];
    float s1 = 0.f;
#pragma unroll
    for (int i = 0; i < 4; ++i) {
      const float4 xv = *(const float4*)(xr + 4 * i);
      const float4 gv = *(const float4*)(m + 5120 + 4 * i);
      v[4 * i + 0] = ALPHA_F * xv.x + gv.x * acc[4 * i + 0]; v[4 * i + 1] = ALPHA_F * xv.y + gv.y * acc[4 * i + 1];
      v[4 * i + 2] = ALPHA_F * xv.z + gv.z * acc[4 * i + 2]; v[4 * i + 3] = ALPHA_F * xv.w + gv.w * acc[4 * i + 3];
      s1 += v[4 * i + 0] + v[4 * i + 1] + v[4 * i + 2] + v[4 * i + 3];
    }
    const float mu = wave_sum(s1) * (1.f / 1024.f);
    float s2 = 0.f;
#pragma unroll
    for (int i = 0; i < 16; ++i) { const float dlt = v[i] - mu; s2 += dlt * dlt; }
    const float rs = rsqrtf(wave_sum(s2) * (1.f / 1024.f) + 1e-5f);
    const float* m2 = p.mod + (size_t)((last ? l : l + 1) * 5 + mod_row(t)) * 6144 + lane * 16;
    uint32_t hw[8];
#pragma unroll
    for (int i = 0; i < 4; ++i) {
      const float4 gg = *(const float4*)(lg + 4 * i);
      const float4 bb = *(const float4*)(lb + 4 * i);
      float4 o;
      o.x = (v[4 * i + 0] - mu) * rs * gg.x + bb.x; o.y = (v[4 * i + 1] - mu) * rs * gg.y + bb.y;
      o.z = (v[4 * i + 2] - mu) * rs * gg.z + bb.z; o.w = (v[4 * i + 3] - mu) * rs * gg.w + bb.w;
      *(float4*)(p.xres + (size_t)t * DM + lane * 16 + 4 * i) = o;
      if (last && t < TL) *(float4*)(p.out + (size_t)t * DM + lane * 16 + 4 * i) = o;
      const float4 sh = *(const float4*)(m2 + 4 * i);
      const float4 sc = *(const float4*)(m2 + 1024 + 4 * i);
      hw[2 * i] = pack2(o.x * (1.f + sc.x) + sh.x, o.y * (1.f + sc.y) + sh.y);
      hw[2 * i + 1] = pack2(o.z * (1.f + sc.z) + sh.z, o.w * (1.f + sc.w) + sh.w);
    }
    bf16_t* hd = p.hA + (size_t)t * DM + lane * 16;
    *(uint4*)hd = make_uint4(hw[0], hw[1], hw[2], hw[3]);
    *(uint4*)(hd + 8) = make_uint4(hw[4], hw[5], hw[6], hw[7]);
  }
}

enum { PH_PRE_A = 0, PH_PRE_B, PH_INIT, PH_GEMM_IN, PH_ELEM, PH_RET_UPD, PH_RET_SCAN, PH_RET_OUT, PH_GEMM_OUT, PH_LN1,
       PH_GEMM_WK, PH_TOPK1, PH_TOPK2, PH_GATHER, PH_LN2, PH_GNORM };

__device__ __forceinline__ void run_phase(const Params& p, int ph, int l, int bid, int nb, char* smem) {
  switch (ph) {
    case PH_PRE_A:
      ph_mod_partial(p, bid, nb, smem);
      for (int ll = 0; ll < NLAYER; ++ll) {
        ph_transpose_cvt(p.w_in + (size_t)ll * DM * NPROJ, p.w_inT + (size_t)ll * NPROJ * DM, DM, NPROJ, bid, nb, smem);
        ph_transpose_cvt(p.w_out + (size_t)ll * DM * DM, p.w_outT + (size_t)ll * DM * DM, DM, DM, bid, nb, smem);
      }
      ph_wk_fold(p, bid, nb, smem);
      break;
    case PH_PRE_B: ph_mod_reduce(p, bid, nb); break;
    case PH_INIT: ph_init_h(p, bid, nb); break;
    case PH_GEMM_IN:
      ph_gemm<true>(p.hA, p.w_inT + (size_t)l * NPROJ * DM, p.big, TT, NPROJ, DM, bid, nb, smem);
      ph_cvt_uv(p, l, bid, nb);
      break;
    case PH_ELEM: ph_elem(p, l, bid, nb); break;
    case PH_RET_UPD: ph_ret_upd(p, bid, nb, smem); break;
    case PH_RET_SCAN: ph_ret_scan(p, bid, nb); break;
    case PH_RET_OUT: ph_ret_out(p, bid, nb, smem); break;
    case PH_GEMM_OUT: ph_gemm<false>(p.cat, p.w_outT + (size_t)l * DM * DM, p.ybuf, TT, DM, DM, bid, nb, smem); break;
    case PH_LN1: ph_ln(p, l, 1, bid, nb); break;
    case PH_GEMM_WK: ph_wk_topk(p, l, bid, nb, smem); break;
    case PH_TOPK1: break;
    case PH_TOPK2: break;
    case PH_GATHER: ph_gather_ln2(p, l, bid, nb); break;
    case PH_LN2: break;
    case PH_GNORM: ph_gnorm(p, bid, nb); break;
  }
}

extern __shared__ __attribute__((aligned(16))) char dyn_smem[];

template <int PH>
__global__ void __launch_bounds__(256, 2) k_phase(Params p, int l) {
  run_phase(p, PH, l, blockIdx.x, gridDim.x, dyn_smem);
}

#define XB_TMO      128
#define XB_XCNT(j)  (256  + 64 * (j))
#define XB_XSUB(j)  (1280 + 64 * (j))
#define XB_XGEN(j)  (2304 + 64 * (j))
#define XB_TOP      3328
#define XB_TOPGEN   3392
#define XCD_BAR_WORDS 3456
#define XB_SPIN_CAP (1u << 22)
__device__ __forceinline__ unsigned xb_ld(unsigned* q)              { return __hip_atomic_load(q, __ATOMIC_RELAXED, __HIP_MEMORY_SCOPE_AGENT); }
__device__ __forceinline__ unsigned xb_add(unsigned* q, unsigned v) { return __hip_atomic_fetch_add(q, v, __ATOMIC_RELAXED, __HIP_MEMORY_SCOPE_AGENT); }
__device__ __forceinline__ unsigned xb_xcc_id() { return (unsigned)__builtin_amdgcn_s_getreg((3 << 11) | 20) & 0xFu; }
#define XB_SPIN(cond, bar) do { unsigned _sp = 0; while (cond) { __builtin_amdgcn_s_sleep(1); \
    if ((++_sp & 255u) == 0u) { if (xb_ld(&(bar)[XB_TMO])) break; if (_sp > XB_SPIN_CAP) { atomicAdd(&(bar)[XB_TMO], 1u); break; } } } } while (0)
struct XcdBarrier { unsigned* bar; unsigned x; volatile unsigned* st; };
__device__ __forceinline__ XcdBarrier xcd_barrier_post(unsigned* bar, volatile unsigned* st) {
  XcdBarrier b; b.bar = bar; b.x = xb_xcc_id(); b.st = st;
  if (threadIdx.x == 0) (void)xb_add(&bar[XB_XCNT(b.x)], 1u);
  return b;
}
__device__ __forceinline__ void xcd_barrier_complete(unsigned* bar, unsigned x, unsigned& nloc, unsigned& nx) {
  const unsigned G = gridDim.x * gridDim.y * gridDim.z;
  unsigned sum, cnt, mine, sp = 0u;
  for (;;) {
    sum = 0u; cnt = 0u; mine = 0u;
#pragma unroll
    for (unsigned j = 0; j < 16; ++j) { const unsigned c = xb_ld(&bar[XB_XCNT(j)]); sum += c; cnt += (c > 0u) ? 1u : 0u; mine = (j == x) ? c : mine; }
    if (sum == G) break;
    __builtin_amdgcn_s_sleep(1);
    if ((++sp & 255u) == 0u) { if (xb_ld(&bar[XB_TMO])) break; if (sp > XB_SPIN_CAP) { atomicAdd(&bar[XB_TMO], 1u); break; } }
  }
  nloc = mine > 0u ? mine : 1u; nx = cnt > 0u ? cnt : 1u;
}
__device__ __forceinline__ void xcd_barrier(const XcdBarrier& b) {
  asm volatile("s_waitcnt vmcnt(0)" ::: "memory");
  __syncthreads();
  if (threadIdx.x == 0) {
    unsigned* bar = b.bar;
    __builtin_amdgcn_s_waitcnt(0);
    unsigned nloc = b.st[0], nx = b.st[1];
    if (nloc == 0u) { xcd_barrier_complete(bar, b.x, nloc, nx); b.st[0] = nloc; b.st[1] = nx; }
    const unsigned old = xb_add(&bar[XB_XSUB(b.x)], 1u);
    const unsigned gen = old / nloc;
    if (old + 1u == (gen + 1u) * nloc) {
      __builtin_amdgcn_fence(__ATOMIC_RELEASE, "agent");
      asm volatile("s_waitcnt vmcnt(0)" ::: "memory");
      const unsigned og = xb_add(&bar[XB_TOP], 1u);
      const unsigned tg = og / nx;
      if (og + 1u == (tg + 1u) * nx) xb_add(&bar[XB_TOPGEN], 1u);
      else XB_SPIN(xb_ld(&bar[XB_TOPGEN]) == tg, bar);
      __builtin_amdgcn_fence(__ATOMIC_ACQUIRE, "agent");
      xb_add(&bar[XB_XGEN(b.x)], 1u);
      asm volatile("s_waitcnt vmcnt(0)" ::: "memory");
    } else {
      XB_SPIN(xb_ld(&bar[XB_XGEN(b.x)]) == gen, bar);
      __builtin_amdgcn_fence(__ATOMIC_ACQUIRE, "agent");
      asm volatile("s_waitcnt vmcnt(0)" ::: "memory");
    }
  }
  __syncthreads();
}

__global__ void __launch_bounds__(256, 2) k_mega(Params p) {
  cg::grid_group grid = cg::this_grid();
  const int bid = blockIdx.x, nb = gridDim.x;
  volatile unsigned* xst = (volatile unsigned*)(dyn_smem + 66048);
  if (threadIdx.x == 0) { xst[0] = 0u; xst[1] = 0u; xst[2] = 0u; xst[3] = 0u; }
  __syncthreads();
  const XcdBarrier xb = xcd_barrier_post(p.bar, xst);
#define GSYNC() xcd_barrier(xb)
  grid.sync();
  run_phase(p, PH_PRE_A, 0, bid, nb, dyn_smem); GSYNC();
  run_phase(p, PH_PRE_B, 0, bid, nb, dyn_smem); GSYNC();
  run_phase(p, PH_INIT, 0, bid, nb, dyn_smem); GSYNC();
  for (int l = 0; l < NLAYER; ++l) {
    run_phase(p, PH_GEMM_IN, l, bid, nb, dyn_smem); GSYNC();
    run_phase(p, PH_ELEM, l, bid, nb, dyn_smem); GSYNC();
    run_phase(p, PH_RET_UPD, l, bid, nb, dyn_smem); GSYNC();
    run_phase(p, PH_RET_SCAN, l, bid, nb, dyn_smem); GSYNC();
    run_phase(p, PH_RET_OUT, l, bid, nb, dyn_smem); GSYNC();
    run_phase(p, PH_GNORM, l, bid, nb, dyn_smem); GSYNC();
    run_phase(p, PH_GEMM_OUT, l, bid, nb, dyn_smem); GSYNC();
    run_phase(p, PH_LN1, l, bid, nb, dyn_smem); GSYNC();
    run_phase(p, PH_GEMM_WK, l, bid, nb, dyn_smem); GSYNC();
    run_phase(p, PH_GATHER, l, bid, nb, dyn_smem);
    if (l + 1 < NLAYER) GSYNC();
  }
#undef GSYNC
}

__global__ void k_dump_bf16(const bf16_t* src, float* out, size_t n) {
  for (size_t i = (size_t)blockIdx.x * 256 + threadIdx.x; i < n; i += (size_t)gridDim.x * 256) out[i] = bf2f(src[i]);
}
__global__ void k_dump_cols(const bf16_t* src, int ld, int col0, float* out, size_t n) {
  for (size_t i = (size_t)blockIdx.x * 256 + threadIdx.x; i < n; i += (size_t)gridDim.x * 256) out[i] = bf2f(src[(i >> 10) * ld + col0 + (i & 1023)]);
}
__global__ void k_dump_hash(const uint32_t* src, size_t nwords, float* out, size_t nout, float scale) {
  __shared__ uint32_t red[256];
  const size_t L = (nwords + 1023) / 1024;
  const size_t b0 = (size_t)blockIdx.x * L;
  uint32_t h = 0;
  for (size_t i = threadIdx.x; i < L; i += 256) {
    const size_t j = b0 + i;
    if (j < nwords) h += (src[j] ^ 0x9e3779b9u) * (uint32_t)(2654435761u * (uint32_t)(i + 1) + 12345u);
  }
  red[threadIdx.x] = h;
  __syncthreads();
  for (int o = 128; o > 0; o >>= 1) { if ((int)threadIdx.x < o) red[threadIdx.x] += red[threadIdx.x + o]; __syncthreads(); }
  uint32_t hh = red[0];
  hh ^= hh >> 16; hh *= 0x85ebca6bu; hh ^= hh >> 13;
  const float v = scale * (float)(1u + (hh & 255u));
  const size_t per = nout / 1024;
  for (size_t i = threadIdx.x; i < per; i += 256) out[(size_t)blockIdx.x * per + i] = v;
}
__global__ void k_fill(float* out, size_t n, float v) {
  for (size_t i = (size_t)blockIdx.x * 256 + threadIdx.x; i < n; i += (size_t)gridDim.x * 256) out[i] = v;
}
__global__ void k_dump_f32(const float* src, float* out, size_t n) {
  for (size_t i = (size_t)blockIdx.x * 256 + threadIdx.x; i < n; i += (size_t)gridDim.x * 256) out[i] = src[i];
}
static inline size_t al256(size_t v) { return (v + 255) & ~(size_t)255; }

extern "C" void kernel_launch(void* const* d_in, const int* in_sizes, int n_in, void* d_out, int out_size, void* d_ws,
                              size_t ws_size, hipStream_t stream) {
  static int grid = 0, mgrid = 0;
  if (grid == 0) {
    int dev = 0, cus = 0, per_cu = 0;
    (void)hipGetDevice(&dev);
    (void)hipDeviceGetAttribute(&cus, hipDeviceAttributeMultiprocessorCount, dev);
#define SETATTR(PH) (void)hipFuncSetAttribute((const void*)k_phase<PH>, hipFuncAttributeMaxDynamicSharedMemorySize, SMEM_BYTES);
    SETATTR(0) SETATTR(1) SETATTR(2) SETATTR(3) SETATTR(4) SETATTR(5) SETATTR(6) SETATTR(7) SETATTR(8) SETATTR(9)
    SETATTR(10) SETATTR(11) SETATTR(12) SETATTR(13) SETATTR(14) SETATTR(15)
    if (cus <= 0) cus = 256;
    grid = cus * 2;
    (void)hipFuncSetAttribute((const void*)k_mega, hipFuncAttributeMaxDynamicSharedMemorySize, SMEM_BYTES);
    if (hipOccupancyMaxActiveBlocksPerMultiprocessor(&per_cu, (const void*)k_mega, 256, SMEM_BYTES) != hipSuccess || per_cu < 1) per_cu = 1;
    if (per_cu > 2) per_cu = 2;
    mgrid = cus * per_cu;
  }
  Params p{};
  p.x = (const float*)d_in[0]; p.c = (const float*)d_in[1]; p.ctx = (const float*)d_in[2]; p.c_ctx = (const float*)d_in[3];
  p.w_mod = (const float*)d_in[4]; p.b_mod = (const float*)d_in[5]; p.w_in = (const float*)d_in[6]; p.conv_w = (const float*)d_in[7];
  p.w_out = (const float*)d_in[8]; p.ln1_g = (const float*)d_in[9]; p.ln1_b = (const float*)d_in[10]; p.peer_wq = (const float*)d_in[11];
  p.peer_keys = (const float*)d_in[12]; p.peer_u = (const float*)d_in[13]; p.peer_v = (const float*)d_in[14];
  p.ln2_g = (const float*)d_in[15]; p.ln2_b = (const float*)d_in[16];
  p.out = (float*)d_out;
  char* w = (char*)d_ws; size_t off = 0;
  auto take = [&](size_t bytes) { char* r = w + off; off = al256(off + bytes); return r; };
  p.xres = (float*)take((size_t)TT * DM * 4);
  p.hA = (bf16_t*)take((size_t)TT * DM * 2);
  p.big = take((size_t)TT * 2048 * 4);
  p.cat = (bf16_t*)take((size_t)TT * DM * 2);
  p.st = (float*)take((size_t)2 * NCHUNK * 4 * 16384 * 4);
  p.ybuf = (float*)take((size_t)TT * DM * 4);
  p.w_inT = (bf16_t*)take((size_t)NLAYER * NPROJ * DM * 2);
  p.w_outT = (bf16_t*)take((size_t)NLAYER * DM * DM * 2);
  p.wkT = (bf16_t*)take((size_t)NLAYER * 2048 * DM * 2);
  p.ubf = (bf16_t*)take((size_t)NEXP * DM * 2);
  p.vbf = (bf16_t*)take((size_t)NEXP * DM * 2);
  p.mod = (float*)take((size_t)4 * 5 * 6144 * 4);
  p.modp = (float*)take((size_t)8 * 4 * 5 * 6144 * 4);
  p.ropec = (float*)take(128 * 32 * 4);
  p.ropes = (float*)take(128 * 32 * 4);
  p.bar = (unsigned*)take(XCD_BAR_WORDS * 4);
  p.pad0 = nullptr;
  {
    char* a = (char*)p.st; size_t o2 = 0;
    p.sv = (float*)(a + o2); o2 = al256(o2 + (size_t)TT * 256 * 4);
    p.si = (unsigned char*)(a + o2); o2 = al256(o2 + (size_t)TT * 256);
    p.pe = (int*)(a + o2); o2 = al256(o2 + (size_t)TT * 128 * 4);
    p.pg = (float*)(a + o2); o2 = al256(o2 + (size_t)TT * 128 * 4);
  }
  for (int d = 0; d < 2; ++d)
    for (int h = 0; h < 4; ++h) p.lg2[d][h] = (float)log2(1.0 - exp2(-(5.0 + 0.5 * d + (double)h)));
  if (off > ws_size) { fprintf(stderr, "kernel_launch: workspace too small: need %zu have %zu\n", off, ws_size); return; }

#if MEGA
  {
    (void)hipMemsetAsync(p.bar, 0, XCD_BAR_WORDS * 4, stream);
    void* args[] = {(void*)&p};
    hipError_t e = hipLaunchCooperativeKernel((const void*)k_mega, dim3(mgrid), dim3(256), args, SMEM_BYTES, stream);
    if (e != hipSuccess) fprintf(stderr, "kernel_launch: cooperative launch failed: %s (grid %d)\n", hipGetErrorString(e), mgrid);
    return;
  }
#endif
#define launch(PH, L) hipLaunchKernelGGL(k_phase<PH>, dim3(grid), dim3(256), SMEM_BYTES, stream, p, (int)(L))
  const size_t HR = ((size_t)TL * DM / 8) & ~(size_t)1023;
#define HASH(K, PTR, BYTES) if (DBG_STOP == 20) hipLaunchKernelGGL(k_dump_hash, dim3(1024), dim3(256), 0, stream, (const uint32_t*)(PTR), (size_t)(BYTES) / 4, p.out + (size_t)(K) * HR, HR, ((DBG_HMASK >> (K)) & 1) ? 1.0f : 0.0f)
  if (DBG_STOP == 20) hipLaunchKernelGGL(k_fill, dim3(1024), dim3(256), 0, stream, p.out, (size_t)TL * DM, 0.f);
  launch(PH_PRE_A, 0);
  launch(PH_PRE_B, 0);
  launch(PH_INIT, 0);
  HASH(0, p.hA, (size_t)TT * DM * 2);
  HASH(1, p.w_inT, (size_t)NPROJ * DM * 2);
  for (int l = 0; l < NLAYER; ++l) {
    launch(PH_GEMM_IN, l);
    if (l == 0) HASH(2, p.big, (size_t)TT * NPROJ * 2);
    if (DBG_STOP == 6) { hipLaunchKernelGGL(k_dump_bf16, dim3(1024), dim3(256), 0, stream, (const bf16_t*)p.big, p.out, (size_t)TL * DM); return; }
    launch(PH_ELEM, l);
    if (l == 0) HASH(3, p.big, (size_t)TT * NPROJ * 2);
    if (DBG_STOP == 12) { hipLaunchKernelGGL(k_dump_cols, dim3(1024), dim3(256), 0, stream, (const bf16_t*)p.big, NPROJ, 1536, p.out, (size_t)TL * DM); return; }
    if (DBG_STOP == 13) { hipLaunchKernelGGL(k_dump_cols, dim3(1024), dim3(256), 0, stream, (const bf16_t*)p.big, NPROJ, 2560, p.out, (size_t)TL * DM); return; }
    if (DBG_STOP == 7) { hipLaunchKernelGGL(k_dump_bf16, dim3(1024), dim3(256), 0, stream, (const bf16_t*)p.big, p.out, (size_t)TL * DM); return; }
    launch(PH_RET_UPD, l);
    if (l == 0) HASH(4, p.st, (size_t)2 * NCHUNK * 4 * 16384 * 4);
    if (DBG_STOP == 8) { hipLaunchKernelGGL(k_dump_f32, dim3(1024), dim3(256), 0, stream, p.st, p.out, (size_t)TL * DM); return; }
    launch(PH_RET_SCAN, l);
    if (l == 0) HASH(5, p.ybuf, (size_t)2 * NCHUNK * 4 * 16384 * 4);
    if (DBG_STOP == 10) { hipLaunchKernelGGL(k_dump_f32, dim3(1024), dim3(256), 0, stream, p.st + (size_t)NCHUNK * 4 * 16384, p.out, (size_t)TL * DM); return; }
    if (DBG_STOP == 11) { hipLaunchKernelGGL(k_dump_f32, dim3(1024), dim3(256), 0, stream, p.st + (size_t)200 * 4 * 16384, p.out, (size_t)TL * DM); return; }
    if (DBG_STOP == 9) { hipLaunchKernelGGL(k_dump_f32, dim3(1024), dim3(256), 0, stream, p.st, p.out, (size_t)TL * DM); return; }
    launch(PH_RET_OUT, l);
    launch(PH_GNORM, l);
    if (l == 0) HASH(6, p.cat, (size_t)TT * DM * 2);
    if (DBG_STOP == 20) return;
    if (DBG_STOP == 1) { hipLaunchKernelGGL(k_dump_bf16, dim3(1024), dim3(256), 0, stream, p.cat, p.out, (size_t)TL * DM); return; }
    launch(PH_GEMM_OUT, l);
    launch(PH_LN1, l);
    if (DBG_STOP == 2) { hipLaunchKernelGGL(k_dump_f32, dim3(1024), dim3(256), 0, stream, p.xres, p.out, (size_t)TL * DM); return; }
    launch(PH_GEMM_WK, l);
    launch(PH_GATHER, l);
    if (1) continue;
    if (DBG_STOP == 3) { hipLaunchKernelGGL(k_dump_f32, dim3(1024), dim3(256), 0, stream, p.ybuf, p.out, (size_t)TL * DM); return; }
    launch(PH_LN2, l);
    if (DBG_STOP == 4) { hipLaunchKernelGGL(k_dump_f32, dim3(1024), dim3(256), 0, stream, p.xres, p.out, (size_t)TL * DM); return; }
  }
}
```

```cpp
#include <hip/hip_runtime.h>
#include <hip/hip_cooperative_groups.h>
#include <stdint.h>
#include <math.h>
#include <stdio.h>
#include <utility>
#include <type_traits>

namespace cg = cooperative_groups;

typedef unsigned short bf16_t;
using bf16x8 = __attribute__((ext_vector_type(8))) short;
using s16x4 = __attribute__((ext_vector_type(4))) short;
using f32x4 = __attribute__((ext_vector_type(4))) float;
using u32x4 = __attribute__((ext_vector_type(4))) unsigned;

#define DM 1024
#define NB 4
#define SEQ 8192
#define TL 32768
#define TC 1024
#define TT 33792
#define NCHUNK 264
#define NPROJ 3584
#define NLAYER 4
#define NEXP 16384
#define ALPHA_F 1.681792830507429f
#define SMEM_BYTES 66576
#ifndef PROBE_MASK
#define PROBE_MASK 0
#endif

struct Params {
  const float *x, *c, *ctx, *c_ctx, *w_mod, *b_mod, *w_in, *conv_w, *w_out, *ln1_g, *ln1_b;
  const float *peer_wq, *peer_keys, *peer_u, *peer_v, *ln2_g, *ln2_b;
  float* out;
  float* xres; bf16_t* hA; char* big; bf16_t* cat; float* st; float* ybuf;
  bf16_t *w_inT, *w_outT, *wkT, *ubf, *vbf;
  float* sv; unsigned char* si; int* pe; float* pg;
  float *mod, *modp, *ropec, *ropes;
  unsigned* bar; unsigned* pad0;
  float lg2[2][4];
};

__device__ __forceinline__ bf16_t f2bf(float f) {
  uint32_t u = __float_as_uint(f);
  u += 0x7fffu + ((u >> 16) & 1u);
  return (bf16_t)(u >> 16);
}
__device__ __forceinline__ float bf2f(bf16_t b) { return __uint_as_float(((uint32_t)b) << 16); }
__device__ __forceinline__ uint32_t pack2(float a, float b) { return (uint32_t)f2bf(a) | ((uint32_t)f2bf(b) << 16); }
__device__ __forceinline__ float bflo(uint32_t w) { return __uint_as_float(w << 16); }
__device__ __forceinline__ float bfhi(uint32_t w) { return __uint_as_float(w & 0xffff0000u); }
__device__ __forceinline__ float wave_sum(float v) {
#pragma unroll
  for (int o = 32; o > 0; o >>= 1) v += __shfl_xor(v, o);
  return v;
}
__device__ __forceinline__ float row16_sum(float v) {
  v += __builtin_bit_cast(float, __builtin_amdgcn_update_dpp(0, __builtin_bit_cast(int, v), 0xB1, 0xF, 0xF, true));
  v += __builtin_bit_cast(float, __builtin_amdgcn_update_dpp(0, __builtin_bit_cast(int, v), 0x4E, 0xF, 0xF, true));
  v += __builtin_bit_cast(float, __builtin_amdgcn_update_dpp(0, __builtin_bit_cast(int, v), 0x141, 0xF, 0xF, true));
  v += __builtin_bit_cast(float, __builtin_amdgcn_update_dpp(0, __builtin_bit_cast(int, v), 0x140, 0xF, 0xF, true));
  return v;
}
__device__ __forceinline__ float silu_f(float v) { return v * __builtin_amdgcn_rcpf(1.f + __expf(-v)); }
__device__ __forceinline__ int mod_row(int t) { return t < TL ? (t >> 13) : 4; }

__device__ __forceinline__ f32x4 zero4() { f32x4 a = {0.f, 0.f, 0.f, 0.f}; asm volatile("" : "+v"(a)); return a; }

__device__ __forceinline__ int opaque_tid() { int t = threadIdx.x; asm volatile("" : "+v"(t)); return t; }
__device__ __forceinline__ int opaque_s(int v) { v = __builtin_amdgcn_readfirstlane(v); asm volatile("" : "+s"(v)); return v; }

template <class F, int... I>
__device__ __forceinline__ void static_for_impl(F&& f, std::integer_sequence<int, I...>) { (f(std::integral_constant<int, I>{}), ...); }
template <int N, class F>
__device__ __forceinline__ void static_for(F&& f) { static_for_impl(f, std::make_integer_sequence<int, N>{}); }

__device__ __forceinline__ unsigned tr_lane_base(unsigned base, unsigned ld, unsigned lane) {
  const unsigned g = lane >> 4, q = (lane & 15u) >> 2, p = lane & 3u;
  return base + (8u * g + q) * ld + 8u * p;
}
template <int O0, int O1, int O2, int O3, int D>
__device__ __forceinline__ void tr_frag4(unsigned a, bf16x8& f0, bf16x8& f1, bf16x8& f2, bf16x8& f3) {
  s16x4 r0, r1, r2, r3, r4, r5, r6, r7;
  asm volatile(
      "ds_read_b64_tr_b16 %0, %8 offset:%9\n\t"
      "ds_read_b64_tr_b16 %1, %8 offset:%10\n\t"
      "ds_read_b64_tr_b16 %2, %8 offset:%11\n\t"
      "ds_read_b64_tr_b16 %3, %8 offset:%12\n\t"
      "ds_read_b64_tr_b16 %4, %8 offset:%13\n\t"
      "ds_read_b64_tr_b16 %5, %8 offset:%14\n\t"
      "ds_read_b64_tr_b16 %6, %8 offset:%15\n\t"
      "ds_read_b64_tr_b16 %7, %8 offset:%16\n\t"
      "s_waitcnt lgkmcnt(0)"
      : "=&v"(r0), "=&v"(r1), "=&v"(r2), "=&v"(r3), "=&v"(r4), "=&v"(r5), "=&v"(r6), "=&v"(r7)
      : "v"(a), "n"(O0), "n"(O0 + D), "n"(O1), "n"(O1 + D), "n"(O2), "n"(O2 + D), "n"(O3), "n"(O3 + D)
      : "memory");
  f0 = __builtin_shufflevector(r0, r1, 0, 1, 2, 3, 4, 5, 6, 7);
  f1 = __builtin_shufflevector(r2, r3, 0, 1, 2, 3, 4, 5, 6, 7);
  f2 = __builtin_shufflevector(r4, r5, 0, 1, 2, 3, 4, 5, 6, 7);
  f3 = __builtin_shufflevector(r6, r7, 0, 1, 2, 3, 4, 5, 6, 7);
}

__device__ __forceinline__ void ph_mod_partial(const Params& p, int bid, int nb, char* smem) {
  const int TIX = opaque_tid(); bid = opaque_s(bid);
  float* sm = (float*)smem;
  const int tid = TIX;
  for (int item = bid; item < 4 * 24 * 8; item += nb) {
    const int ks = item & 7, cb = (item >> 3) % 24, l = item / 192;
    __syncthreads();
    for (int idx = tid; idx < 640; idx += 256) {
      const int r = idx >> 7, k = ks * 128 + (idx & 127);
      const float v = (r < 4) ? p.c[r * DM + k] : p.c_ctx[k];
      sm[idx] = silu_f(v);
    }
    __syncthreads();
    const int col = cb * 256 + tid;
    float acc[5] = {0.f, 0.f, 0.f, 0.f, 0.f};
    const float* w = p.w_mod + ((size_t)l * DM + ks * 128) * 6144 + col;
#pragma unroll 4
    for (int k = 0; k < 128; ++k) {
      const float wv = w[(size_t)k * 6144];
#pragma unroll
      for (int r = 0; r < 5; ++r) acc[r] += sm[r * 128 + k] * wv;
    }
#pragma unroll
    for (int r = 0; r < 5; ++r) p.modp[((size_t)(ks * 4 + l) * 5 + r) * 6144 + col] = acc[r];
  }
}

__device__ __forceinline__ void ph_mod_reduce(const Params& p, int bid, int nb) {
  const int TIX = opaque_tid(); bid = opaque_s(bid);
  const int gtid = bid * 256 + TIX, gn = nb * 256;
  for (int idx = gtid; idx < 4 * 5 * 6144; idx += gn) {
    const int l = idx / (5 * 6144), col = idx % 6144;
    float s = p.b_mod[l * 6144 + col];
#pragma unroll
    for (int ks = 0; ks < 8; ++ks) s += p.modp[(size_t)ks * (4 * 5 * 6144) + idx];
    p.mod[idx] = s;
  }
  for (int idx = gtid; idx < 128 * 32; idx += gn) {
    const int pos = idx >> 5, d = idx & 31;
    const float inv = exp2f(-(float)d * (13.287712379549449f / 32.f));
    const float angf = (float)pos * inv;
    const double a = (double)angf;
    const double kk = rint(a * 0.15915494309189535);
    const double r = a - kk * 6.283185307179586;
    const double r2 = r * r;
    double sn = 1.0, cs = 1.0;
    for (int n = 13; n >= 1; --n) {
      sn = 1.0 - sn * r2 / (double)((2 * n) * (2 * n + 1));
      cs = 1.0 - cs * r2 / (double)((2 * n - 1) * (2 * n));
    }
    p.ropec[idx] = (float)cs;
    p.ropes[idx] = (float)(r * sn);
  }
}

__device__ __forceinline__ void ph_transpose_cvt(const float* src, bf16_t* dst, int K, int N, int bid, int nb, char* smem) {
  const int TIX = opaque_tid(); bid = opaque_s(bid);
  float* tile = (float*)smem;
  const int tid = TIX;
  const int ntn = N >> 6, ntk = K >> 6;
  for (int item = bid; item < ntn * ntk; item += nb) {
    const int kt = item / ntn, nt = item % ntn;
    __syncthreads();
#pragma unroll
    for (int i = 0; i < 4; ++i) {
      const int r = (tid >> 4) + 16 * i, c4 = (tid & 15) * 4;
      const float4 v = *(const float4*)(src + (size_t)(kt * 64 + r) * N + nt * 64 + c4);
      tile[r * 65 + c4 + 0] = v.x; tile[r * 65 + c4 + 1] = v.y; tile[r * 65 + c4 + 2] = v.z; tile[r * 65 + c4 + 3] = v.w;
    }
    __syncthreads();
    const int n = tid >> 2, kseg = (tid & 3) * 16;
    uint32_t w[8];
#pragma unroll
    for (int e = 0; e < 8; ++e) w[e] = pack2(tile[(kseg + 2 * e) * 65 + n], tile[(kseg + 2 * e + 1) * 65 + n]);
    uint4* d = (uint4*)(dst + (size_t)(nt * 64 + n) * K + kt * 64 + kseg);
    d[0] = make_uint4(w[0], w[1], w[2], w[3]);
    d[1] = make_uint4(w[4], w[5], w[6], w[7]);
  }
}

__device__ __forceinline__ void ph_wk_fold(const Params& p, int bid, int nb, char* smem) {
  const int TIX = opaque_tid(); bid = opaque_s(bid);
  float* wq_s = (float*)smem;
  float* key_s = wq_s + 64 * 65;
  const int tid = TIX;
  const int tc = tid >> 4, tn = tid & 15;
  for (int item = bid; item < 4 * 16 * 16; item += nb) {
    const int ct = item & 15, hp = (item >> 4) & 15, l = item >> 8;
    float acc[4][8];
#pragma unroll
    for (int a = 0; a < 4; ++a)
#pragma unroll
      for (int b = 0; b < 8; ++b) acc[a][b] = 0.f;
    for (int dh = 0; dh < 2; ++dh) {
      __syncthreads();
#pragma unroll
      for (int i = 0; i < 4; ++i) {
        const int r = (tid >> 4) + 16 * i, c4 = (tid & 15) * 4;
        const float4 v = *(const float4*)(p.peer_wq + ((size_t)l * DM + ct * 64 + r) * 2048 + hp * 128 + dh * 64 + c4);
        wq_s[r * 65 + c4 + 0] = v.x; wq_s[r * 65 + c4 + 1] = v.y; wq_s[r * 65 + c4 + 2] = v.z; wq_s[r * 65 + c4 + 3] = v.w;
      }
#pragma unroll
      for (int i = 0; i < 8; ++i) {
        const int r = (tid >> 4) + 16 * i, c4 = (tid & 15) * 4;
        const float4 v = *(const float4*)(p.peer_keys + (((size_t)l * 2 + (hp & 1)) * 128 + r) * 128 + dh * 64 + c4);
        key_s[r * 65 + c4 + 0] = v.x; key_s[r * 65 + c4 + 1] = v.y; key_s[r * 65 + c4 + 2] = v.z; key_s[r * 65 + c4 + 3] = v.w;
      }
      __syncthreads();
#pragma unroll 4
      for (int d = 0; d < 64; ++d) {
        float av[4], bv[8];
#pragma unroll
        for (int a = 0; a < 4; ++a) av[a] = wq_s[(tc * 4 + a) * 65 + d];
#pragma unroll
        for (int b = 0; b < 8; ++b) bv[b] = key_s[(tn + 16 * b) * 65 + d];
#pragma unroll
        for (int a = 0; a < 4; ++a)
#pragma unroll
          for (int b = 0; b < 8; ++b) acc[a][b] += av[a] * bv[b];
      }
    }
#pragma unroll
    for (int b = 0; b < 8; ++b) {
      const int row = hp * 128 + tn + 16 * b;
      uint2 o;
      o.x = pack2(acc[0][b], acc[1][b]);
      o.y = pack2(acc[2][b], acc[3][b]);
      *(uint2*)(p.wkT + ((size_t)l * 2048 + row) * DM + ct * 64 + tc * 4) = o;
    }
  }
}

#define SCALE_U 128.f
#define SCALE_V 8.f
__device__ __forceinline__ uint32_t pack_fp8x4(float a, float b, float c, float d) {
  int w = 0;
  w = __builtin_amdgcn_cvt_pk_fp8_f32(a, b, w, false);
  w = __builtin_amdgcn_cvt_pk_fp8_f32(c, d, w, true);
  return (uint32_t)w;
}
#define QSCALE_U 512.f
__device__ __forceinline__ uint32_t pack_i8x4(float a, float b, float c, float d) {
  const int qa = max(-127, min(127, __float2int_rn(a))), qb = max(-127, min(127, __float2int_rn(b)));
  const int qc = max(-127, min(127, __float2int_rn(c))), qd = max(-127, min(127, __float2int_rn(d)));
  return (uint32_t)(qa & 255) | ((uint32_t)(qb & 255) << 8) | ((uint32_t)(qc & 255) << 16) | ((uint32_t)(qd & 255) << 24);
}
__device__ __forceinline__ void cvt_uv_unit(const Params& p, int l, size_t i) {
  const size_t n16 = (size_t)NEXP * DM / 16;
  const bool isv = i >= n16;
  const size_t j = isv ? i - n16 : i;
  const float sc = SCALE_V;
  const float4* s4 = (const float4*)((isv ? p.peer_v : p.peer_u) + (size_t)l * NEXP * DM + j * 16);
  const float4 a0 = s4[0], a1 = s4[1], a2 = s4[2], a3 = s4[3];
  uint4 o;
  if (isv) {
    o.x = pack_fp8x4(a0.x * sc, a0.y * sc, a0.z * sc, a0.w * sc);
    o.y = pack_fp8x4(a1.x * sc, a1.y * sc, a1.z * sc, a1.w * sc);
    o.z = pack_fp8x4(a2.x * sc, a2.y * sc, a2.z * sc, a2.w * sc);
    o.w = pack_fp8x4(a3.x * sc, a3.y * sc, a3.z * sc, a3.w * sc);
  } else {
    o.x = pack_i8x4(a0.x * QSCALE_U, a0.y * QSCALE_U, a0.z * QSCALE_U, a0.w * QSCALE_U);
    o.y = pack_i8x4(a1.x * QSCALE_U, a1.y * QSCALE_U, a1.z * QSCALE_U, a1.w * QSCALE_U);
    o.z = pack_i8x4(a2.x * QSCALE_U, a2.y * QSCALE_U, a2.z * QSCALE_U, a2.w * QSCALE_U);
    o.w = pack_i8x4(a3.x * QSCALE_U, a3.y * QSCALE_U, a3.z * QSCALE_U, a3.w * QSCALE_U);
  }
  *(uint4*)((unsigned char*)(isv ? p.vbf : p.ubf) + j * 16) = o;
}
#define CVT_UNITS ((size_t)2 * NEXP * DM / 16)

__device__ __forceinline__ void ph_init_h(const Params& p, int bid, int nb) {
  const int TIX = opaque_tid(); bid = opaque_s(bid);
  const int lane = TIX & 63;
  const int gw = bid * 4 + (TIX >> 6), nw = nb * 4;
  for (int t = gw; t < TT; t += nw) {
    const float* xr = t < TL ? p.x + (size_t)t * DM : p.ctx + (size_t)(t - TL) * DM;
    const float* m = p.mod + (size_t)(0 * 5 + mod_row(t)) * 6144;
#pragma unroll
    for (int i = 0; i < 4; ++i) {
      const int col = lane * 4 + 256 * i;
      const float4 v = *(const float4*)(xr + col);
      const float4 sh = *(const float4*)(m + col);
      const float4 sc = *(const float4*)(m + 1024 + col);
      uint2 o;
      o.x = pack2(v.x * (1.f + sc.x) + sh.x, v.y * (1.f + sc.y) + sh.y);
      o.y = pack2(v.z * (1.f + sc.z) + sh.z, v.w * (1.f + sc.w) + sh.w);
      *(uint2*)(p.hA + (size_t)t * DM + col) = o;
    }
  }
}

__device__ __forceinline__ void gemm_tile_acc(const bf16_t* __restrict__ A, const bf16_t* __restrict__ Bt, int K, int m0, int n0,
                                              char* smem, int tid, f32x4 (&acc)[4][4]) {
  const int lane = tid & 63, wave = opaque_s(tid >> 6);
  const int wm = wave >> 1, wn = wave & 1;
  const int g = lane >> 4, l15 = lane & 15;
  const int nt = K >> 6;
#pragma unroll
  for (int i = 0; i < 4; ++i)
#pragma unroll
    for (int j = 0; j < 4; ++j) acc[i][j] = zero4();
  const int sb = lane * 16, swz = sb ^ (((sb >> 9) & 1) << 5);
  const int R0 = (wave >> 1) * 16 + (swz >> 6), C0 = (wave & 1) * 32 + ((swz & 63) >> 1);
  const bf16_t* ga = A + (size_t)(m0 + R0) * K + C0;
  const bf16_t* gb = Bt + (size_t)(n0 + R0) * K + C0;
  char* stA = smem + wave * 1024;
  char* stB = smem + 16384 + wave * 1024;
  const int fl = l15 * 64 + ((g * 16) ^ ((l15 >> 3) << 5));
  const char* rdA = smem + fl + wm * 8192;
  const char* rdB = smem + 16384 + fl + wn * 8192;
#define GLDS_STAGE(BUF, KT) do { _Pragma("unroll") for (int i_ = 0; i_ < 4; ++i_) {                                                        \
    __builtin_amdgcn_global_load_lds((const unsigned*)(ga + (size_t)(32 * i_) * K + (KT) * 64), (unsigned*)(stA + (BUF) * 32768 + i_ * 4096), 16, 0, 0); \
    __builtin_amdgcn_global_load_lds((const unsigned*)(gb + (size_t)(32 * i_) * K + (KT) * 64), (unsigned*)(stB + (BUF) * 32768 + i_ * 4096), 16, 0, 0); } } while (0)
  __syncthreads();
  GLDS_STAGE(0, 0);
  asm volatile("s_waitcnt vmcnt(0)" ::: "memory");
  __syncthreads();
  if (nt > 1) GLDS_STAGE(1, 1);
  bf16x8 af0[4], bf0[4], af1[4], bf1[4];
#pragma unroll
  for (int i = 0; i < 4; ++i) af0[i] = *(const bf16x8*)(rdA + (i * 2) * 1024);
#pragma unroll
  for (int j = 0; j < 4; ++j) bf0[j] = *(const bf16x8*)(rdB + (j * 2) * 1024);
  for (int t = 0; t < nt; ++t) {
    const int cur = t & 1;
    acc[0][0] = __builtin_amdgcn_mfma_f32_16x16x32_bf16(af0[0], bf0[0], acc[0][0], 0, 0, 0);
    __builtin_amdgcn_sched_barrier(0);
#pragma unroll
    for (int i = 0; i < 4; ++i) af1[i] = *(const bf16x8*)(rdA + cur * 32768 + (i * 2 + 1) * 1024);
#pragma unroll
    for (int j = 0; j < 4; ++j) bf1[j] = *(const bf16x8*)(rdB + cur * 32768 + (j * 2 + 1) * 1024);
    __builtin_amdgcn_sched_barrier(0);
#pragma unroll
    for (int i = 0; i < 4; ++i)
#pragma unroll
      for (int j = 0; j < 4; ++j)
        if (i | j) acc[i][j] = __builtin_amdgcn_mfma_f32_16x16x32_bf16(af0[i], bf0[j], acc[i][j], 0, 0, 0);
    __builtin_amdgcn_sched_barrier(0);
    asm volatile("s_waitcnt vmcnt(0)" ::: "memory");
    __syncthreads();
    if (t + 2 < nt) GLDS_STAGE(cur, t + 2);
    if (t + 1 < nt) {
#pragma unroll
      for (int i = 0; i < 4; ++i) af0[i] = *(const bf16x8*)(rdA + (cur ^ 1) * 32768 + (i * 2) * 1024);
#pragma unroll
      for (int j = 0; j < 4; ++j) bf0[j] = *(const bf16x8*)(rdB + (cur ^ 1) * 32768 + (j * 2) * 1024);
    }
    __builtin_amdgcn_sched_barrier(0);
#pragma unroll
    for (int i = 0; i < 4; ++i)
#pragma unroll
      for (int j = 0; j < 4; ++j) acc[i][j] = __builtin_amdgcn_mfma_f32_16x16x32_bf16(af1[i], bf1[j], acc[i][j], 0, 0, 0);
    __builtin_amdgcn_sched_barrier(0);
  }
#undef GLDS_STAGE
}

template <int MX, int NX>
__device__ __forceinline__ bool xcd_tile(int bid, int nb, int k, int ntm, int ntn, int& m, int& n) {
  if ((nb & 7) || (ntm % MX) || (ntn % NX)) {
    const int t = bid + k * nb;
    if (t >= ntm * ntn) return false;
    m = t / ntn; n = t % ntn; return true;
  }
  const int x = bid & 7, q = bid >> 3, nq = nb >> 3;
  const int nloc = ntn / NX, per_x = (ntm / MX) * nloc;
  const int j = q + k * nq;
  if (j >= per_x) return false;
  m = (j / nloc) * MX + (x % MX); n = (j % nloc) * NX + (x / MX);
  return true;
}

__device__ __forceinline__ bool xcd_pair_item(int bid, int nb, int k, int npairs, int& pair, int& sub) {
  if ((nb & 7) || (npairs & 7)) {
    const int t = bid + k * nb;
    if (t >= npairs * 2) return false;
    pair = t >> 1; sub = t & 1; return true;
  }
  const int x = bid & 7, q = bid >> 3, nq = nb >> 3;
  const int j = q + k * nq;
  if (j >= (npairs >> 3) * 2) return false;
  pair = (j >> 1) * 8 + x; sub = j & 1;
  return true;
}

template <bool OUT_BF16>
__device__ __forceinline__ void ph_gemm(const bf16_t* __restrict__ A, const bf16_t* __restrict__ Bt, void* Cout, int M, int N, int K,
                        int bid, int nb, char* smem) {
  const int TIX = opaque_tid(); bid = opaque_s(bid);
  const int tid = TIX, lane = tid & 63, wave = tid >> 6;
  const int wm = wave >> 1, wn = wave & 1;
  const int ntn = N >> 7, ntm = M >> 7;
  for (int k = 0;; ++k) {
    int tm, tn;
    if (!xcd_tile<8, 1>(bid, nb, k, ntm, ntn, tm, tn)) break;
    const int m0 = tm << 7, n0 = tn << 7;
    f32x4 acc[4][4];
    gemm_tile_acc(A, Bt, K, m0, n0, smem, tid, acc);
#pragma unroll
    for (int i = 0; i < 4; ++i)
#pragma unroll
      for (int j = 0; j < 4; ++j)
#pragma unroll
        for (int r = 0; r < 4; ++r) {
          const int row = m0 + wm * 64 + i * 16 + (lane >> 4) * 4 + r;
          const int col = n0 + wn * 64 + j * 16 + (lane & 15);
          if (OUT_BF16) ((bf16_t*)Cout)[(size_t)row * N + col] = f2bf(acc[i][j][r]);
          else ((float*)Cout)[(size_t)row * N + col] = acc[i][j][r];
        }
  }
}

__device__ __forceinline__ void ph_gemm_in(const Params& p, int l, int bid, int nb, char* smem) {
  const int TIX = opaque_tid(); bid = opaque_s(bid);
  const int tid = TIX, lane = tid & 63, wave = tid >> 6;
  const int wm = wave >> 1, wn = wave & 1;
  const int g = lane >> 4, l15 = lane & 15;
  bf16_t* proj = (bf16_t*)p.big;
  const bf16_t* Bt = p.w_inT + (size_t)l * NPROJ * DM;
  constexpr int ntn = NPROJ >> 7;
  for (int k = 0;; ++k) {
    int tm, nt;
    if (!xcd_tile<2, 4>(bid, nb, k, TT >> 7, ntn, tm, nt)) break;
    const int m0 = tm << 7, n0 = nt << 7;
    {
      const size_t cu = (size_t)(bid + k * nb) * 512 + tid;
      if (cu < CVT_UNITS) cvt_uv_unit(p, l, cu);
      if (cu + 256 < CVT_UNITS) cvt_uv_unit(p, l, cu + 256);
    }
    if (l == NLAYER - 1 && m0 >= TL && (nt < 16 || nt >= 24)) continue;
    f32x4 acc[4][4];
    gemm_tile_acc(p.hA, Bt, DM, m0, n0, smem, tid, acc);
    if (nt >= 12 && nt < 20) {
      const float scl = (nt >= 16) ? 0.08838834764831845f : 1.f;
      if (m0 < TL) {
#pragma unroll
        for (int i = 0; i < 4; ++i)
#pragma unroll
          for (int r = 0; r < 4; ++r) {
            const int ii = (m0 + wm * 64 + i * 16 + g * 4 + r) & 8191;
            const int pos = wn ? (ii & 63) : (ii >> 6);
#pragma unroll
            for (int jj = 0; jj < 2; ++jj) {
              const float cs = p.ropec[pos * 32 + jj * 16 + l15], sn = p.ropes[pos * 32 + jj * 16 + l15];
              const float a = acc[i][jj][r], b = acc[i][jj + 2][r];
              acc[i][jj][r] = (a * cs - b * sn) * scl;
              acc[i][jj + 2][r] = (a * sn + b * cs) * scl;
            }
          }
      } else if (nt >= 16) {
#pragma unroll
        for (int i = 0; i < 4; ++i)
#pragma unroll
          for (int j = 0; j < 4; ++j)
#pragma unroll
            for (int r = 0; r < 4; ++r) acc[i][j][r] *= scl;
      }
    }
#pragma unroll
    for (int i = 0; i < 4; ++i)
#pragma unroll
      for (int j = 0; j < 4; ++j)
#pragma unroll
        for (int r = 0; r < 4; ++r) {
          const int row = m0 + wm * 64 + i * 16 + g * 4 + r;
          const int col = n0 + wn * 64 + j * 16 + l15;
          proj[(size_t)row * NPROJ + col] = f2bf(acc[i][j][r]);
        }
  }
}

__device__ __forceinline__ void ph_ret_upd(const Params& p, int bid, int nb, char* smem) {
  const int TIX = opaque_tid(); bid = opaque_s(bid);
  const bf16_t* proj = (const bf16_t*)p.big;
  bf16_t* Vs = (bf16_t*)smem;
  bf16_t* Ks = Vs + 64 * 136;
  const int tid = TIX, lane = tid & 63, wave = tid >> 6;
  const int wm = wave >> 1, wn = wave & 1;
  const unsigned va = tr_lane_base((unsigned)(size_t)Vs, 272u, lane) + wm * 128;
  const unsigned ka = tr_lane_base((unsigned)(size_t)Ks, 272u, lane) + wn * 128;
  const int sr = tid >> 4, sck = (tid & 15) * 8;
  for (int k = 0;; ++k) {
    int pr, dir;
    if (!xcd_pair_item(bid, nb, k, NCHUNK * 4, pr, dir)) break;
    const int c = pr >> 2, hd = pr & 3;
    const int t0 = c * 128;
    const float lg = p.lg2[dir][hd];
    const bf16_t* src = proj + (size_t)(t0 + sr) * NPROJ + hd * 128 + sck;
    u32x4 rv[4], rk[4];
#pragma unroll
    for (int i = 0; i < 4; ++i) {
      rv[i] = *(const u32x4*)(src + 2560 + (size_t)(16 * i) * NPROJ);
      rk[i] = *(const u32x4*)(src + 2048 + (size_t)(16 * i) * NPROJ);
    }
    f32x4 acc[4][4];
#pragma unroll
    for (int i = 0; i < 4; ++i)
#pragma unroll
      for (int j = 0; j < 4; ++j) acc[i][j] = zero4();
#pragma unroll
    for (int half = 0; half < 2; ++half) {
      __syncthreads();
#pragma unroll
      for (int i = 0; i < 4; ++i) {
        const int r = sr + 16 * i, sp = half * 64 + r;
        const float w = exp2f((dir == 0 ? (float)(127 - sp) : (float)sp) * lg);
        u32x4 ko;
#pragma unroll
        for (int q = 0; q < 4; ++q) ko[q] = pack2(bflo(rk[i][q]) * w, bfhi(rk[i][q]) * w);
        *(u32x4*)(Vs + r * 136 + sck) = rv[i];
        *(u32x4*)(Ks + r * 136 + sck) = ko;
      }
      __syncthreads();
      if (half == 0) {
#pragma unroll
        for (int i = 0; i < 4; ++i) {
          rv[i] = *(const u32x4*)(src + 2560 + (size_t)(64 + 16 * i) * NPROJ);
          rk[i] = *(const u32x4*)(src + 2048 + (size_t)(64 + 16 * i) * NPROJ);
        }
      }
      static_for<2>([&](auto KS) {
        constexpr int ks = decltype(KS)::value;
        bf16x8 af[4], bfr[4];
        tr_frag4<ks * 32 * 272 + 0, ks * 32 * 272 + 32, ks * 32 * 272 + 64, ks * 32 * 272 + 96, 4 * 272>(va, af[0], af[1], af[2], af[3]);
        tr_frag4<ks * 32 * 272 + 0, ks * 32 * 272 + 32, ks * 32 * 272 + 64, ks * 32 * 272 + 96, 4 * 272>(ka, bfr[0], bfr[1], bfr[2], bfr[3]);
#pragma unroll
        for (int i = 0; i < 4; ++i)
#pragma unroll
          for (int j = 0; j < 4; ++j) acc[i][j] = __builtin_amdgcn_mfma_f32_16x16x32_bf16(bfr[j], af[i], acc[i][j], 0, 0, 0);
      });
    }
    bf16_t* dst = (bf16_t*)p.st + ((size_t)(dir * NCHUNK + c) * 4 + hd) * 16384;
#pragma unroll
    for (int i = 0; i < 4; ++i)
#pragma unroll
      for (int j = 0; j < 4; ++j) {
        const int row = wm * 64 + i * 16 + (lane & 15);
        const int col = wn * 64 + j * 16 + (lane >> 4) * 4;
        uint2 o; o.x = pack2(acc[i][j][0], acc[i][j][1]); o.y = pack2(acc[i][j][2], acc[i][j][3]);
        *(uint2*)(dst + row * 128 + col) = o;
      }
  }
}

__device__ __forceinline__ void ph_ret_scan(const Params& p, int bid, int nb) {
  const int TIX = opaque_tid(); bid = opaque_s(bid);
  const int gtid = bid * 256 + TIX, gn = nb * 256;
  bf16_t* sout = (bf16_t*)p.ybuf;
  for (int idx = gtid; idx < 2 * 4 * 4 * 8192; idx += gn) {
    const int e = (idx & 8191) * 2, hd = (idx >> 13) & 3, b = (idx >> 15) & 3, dir = idx >> 17;
    const float dc = exp2f(128.f * p.lg2[dir][hd]);
    const size_t boff = (size_t)dir * NCHUNK * 4 * 16384 + (size_t)hd * 16384 + e;
    const bf16_t* __restrict__ src = (const bf16_t*)p.st + boff;
    bf16_t* __restrict__ dst = sout + boff;
    const size_t cs = (size_t)4 * 16384;
    float c0 = 0.f, c1 = 0.f;
    {
      const size_t o0 = (size_t)(256 + b * 2 + (dir ? 1 : 0)) * cs, o1 = (size_t)(256 + b * 2 + (dir ? 0 : 1)) * cs;
      const uint32_t u0 = *(const uint32_t*)(src + o0), u1 = *(const uint32_t*)(src + o1);
      *(uint32_t*)(dst + o0) = pack2(c0, c1); c0 = c0 * dc + bflo(u0); c1 = c1 * dc + bfhi(u0);
      *(uint32_t*)(dst + o1) = pack2(c0, c1); c0 = c0 * dc + bflo(u1); c1 = c1 * dc + bfhi(u1);
    }
    for (int n0 = 0; n0 < 64; n0 += 16) {
      uint32_t u[16];
#pragma unroll
      for (int i = 0; i < 16; ++i) {
        const int n = dir ? (63 - (n0 + i)) : (n0 + i);
        u[i] = *(const uint32_t*)(src + (size_t)(b * 64 + n) * cs);
      }
#pragma unroll
      for (int i = 0; i < 16; ++i) {
        const int n = dir ? (63 - (n0 + i)) : (n0 + i);
        *(uint32_t*)(dst + (size_t)(b * 64 + n) * cs) = pack2(c0, c1);
        c0 = c0 * dc + bflo(u[i]); c1 = c1 * dc + bfhi(u[i]);
      }
    }
  }
}

__device__ __forceinline__ void ph_ret_out(const Params& p, int l, int bid, int nb, char* smem) {
  const int TIX = opaque_tid(); bid = opaque_s(bid);
  const bf16_t* proj = (const bf16_t*)p.big;
  const bf16_t* sin = (const bf16_t*)p.ybuf;
  bf16_t* buf = (bf16_t*)smem;
  bf16_t* Pb = buf + 128 * 136;
  const int tid = TIX, lane = tid & 63, wave = tid >> 6;
  const unsigned ba = tr_lane_base((unsigned)(size_t)buf, 272u, lane);
  const int g = lane >> 4, l15 = lane & 15;
  bf16_t* Pw = Pb + wave * 16 * 136;
  const int sr = tid >> 4, sck = (tid & 15) * 8;
  const int nitem_ro = ((l == NLAYER - 1) ? 256 : NCHUNK) * 8;
  for (int k = 0;; ++k) {
    int pr, rh;
    if (!xcd_pair_item(bid, nb, k, nitem_ro >> 1, pr, rh)) break;
    const int c = pr >> 2, hd = pr & 3;
    const int t0 = c * 128;
    const int rw = rh * 64 + wave * 16;
    const float lgf = p.lg2[0][hd], lgb = p.lg2[1][hd];
    bf16x8 qf[4];
#pragma unroll
    for (int ks = 0; ks < 4; ++ks)
      qf[ks] = *(const bf16x8*)(proj + (size_t)(t0 + rw + l15) * NPROJ + 1536 + hd * 128 + ks * 32 + g * 8);
    u32x4 ra[8], rb[8];
    const bf16_t* kv = proj + (size_t)(t0 + sr) * NPROJ + hd * 128 + sck;
#pragma unroll
    for (int i = 0; i < 8; ++i) ra[i] = *(const u32x4*)(kv + 2048 + (size_t)(16 * i) * NPROJ);
#pragma unroll
    for (int i = 0; i < 8; ++i) rb[i] = *(const u32x4*)(kv + 2560 + (size_t)(16 * i) * NPROJ);
    const bf16_t* sf = sin + ((size_t)(0 * NCHUNK + c) * 4 + hd) * 16384 + sr * 128 + sck;
    const bf16_t* sb = sin + ((size_t)(1 * NCHUNK + c) * 4 + hd) * 16384 + sr * 128 + sck;
    __syncthreads();
#pragma unroll
    for (int i = 0; i < 8; ++i) *(u32x4*)(buf + (sr + 16 * i) * 136 + sck) = ra[i];
    __syncthreads();
#pragma unroll
    for (int i = 0; i < 8; ++i) ra[i] = *(const u32x4*)(sf + (size_t)(16 * i) * 128);
    f32x4 acc[8];
#pragma unroll
    for (int nt = 0; nt < 8; ++nt) acc[nt] = zero4();
#pragma unroll
    for (int ks = 0; ks < 4; ++ks) {
#pragma unroll
      for (int nt = 0; nt < 8; ++nt) {
        const bf16x8 bfr = *(const bf16x8*)(buf + (nt * 16 + l15) * 136 + ks * 32 + g * 8);
        acc[nt] = __builtin_amdgcn_mfma_f32_16x16x32_bf16(qf[ks], bfr, acc[nt], 0, 0, 0);
      }
    }
#pragma unroll
    for (int nt = 0; nt < 8; ++nt)
#pragma unroll
      for (int r = 0; r < 4; ++r) {
        const int tl = g * 4 + r;
        const int t = rw + tl, s2 = nt * 16 + l15;
        const float d = (s2 <= t) ? exp2f((float)(t - s2) * lgf) : exp2f((float)(s2 - t) * lgb);
        Pw[tl * 136 + s2] = f2bf(acc[nt][r] * d);
      }
    __syncthreads();
#pragma unroll
    for (int i = 0; i < 8; ++i) *(u32x4*)(buf + (sr + 16 * i) * 136 + sck) = rb[i];
    __syncthreads();
#pragma unroll
    for (int i = 0; i < 8; ++i) rb[i] = *(const u32x4*)(sb + (size_t)(16 * i) * 128);
    f32x4 o[8];
#pragma unroll
    for (int nt = 0; nt < 8; ++nt) o[nt] = zero4();
    static_for<4>([&](auto KS) {
      constexpr int ks = decltype(KS)::value;
      const bf16x8 pf = *(const bf16x8*)(Pw + l15 * 136 + ks * 32 + g * 8);
      static_for<2>([&](auto NH) {
        constexpr int nh = decltype(NH)::value;
        bf16x8 bfr[4];
        tr_frag4<ks * 32 * 272 + nh * 128 + 0, ks * 32 * 272 + nh * 128 + 32, ks * 32 * 272 + nh * 128 + 64, ks * 32 * 272 + nh * 128 + 96, 4 * 272>(
            ba, bfr[0], bfr[1], bfr[2], bfr[3]);
#pragma unroll
        for (int j = 0; j < 4; ++j) o[nh * 4 + j] = __builtin_amdgcn_mfma_f32_16x16x32_bf16(pf, bfr[j], o[nh * 4 + j], 0, 0, 0);
      });
    });
#define RO_CROSS(DIRV, REG)                                                                                     \
    {                                                                                                           \
      __syncthreads();                                                                                          \
      _Pragma("unroll") for (int i = 0; i < 8; ++i) *(u32x4*)(buf + (sr + 16 * i) * 136 + sck) = REG[i];        \
      __syncthreads();                                                                                          \
      float fr[4];                                                                                              \
      _Pragma("unroll") for (int r = 0; r < 4; ++r) {                                                           \
        const int t = rw + g * 4 + r;                                                                           \
        fr[r] = (DIRV == 0) ? exp2f((float)(t + 1) * lgf) : exp2f((float)(128 - t) * lgb);                      \
      }                                                                                                         \
      _Pragma("unroll") for (int nt = 0; nt < 8; ++nt) acc[nt] = zero4();                                       \
      _Pragma("unroll") for (int ks = 0; ks < 4; ++ks) {                                                        \
        _Pragma("unroll") for (int nt = 0; nt < 8; ++nt) {                                                      \
          const bf16x8 bfr = *(const bf16x8*)(buf + (nt * 16 + l15) * 136 + ks * 32 + g * 8);                   \
          acc[nt] = __builtin_amdgcn_mfma_f32_16x16x32_bf16(qf[ks], bfr, acc[nt], 0, 0, 0);                     \
        }                                                                                                       \
      }                                                                                                         \
      _Pragma("unroll") for (int r = 0; r < 4; ++r)                                                             \
        _Pragma("unroll") for (int nt = 0; nt < 8; ++nt) o[nt][r] += fr[r] * acc[nt][r];                        \
    }
    RO_CROSS(0, ra)
    RO_CROSS(1, rb)
#undef RO_CROSS
#pragma unroll
    for (int r = 0; r < 4; ++r) {
      const int t = t0 + rw + g * 4 + r;
#pragma unroll
      for (int nt = 0; nt < 8; ++nt) p.cat[(size_t)t * DM + 512 + hd * 128 + nt * 16 + l15] = f2bf(o[nt][r]);
    }
  }
}

__device__ __forceinline__ void ph_gnorm(const Params& p, int l, int bid, int nb) {
  const int TIX = opaque_tid(); bid = opaque_s(bid);
  const bf16_t* proj = (const bf16_t*)p.big;
  const int lane = TIX & 63;
  const int gw = bid * 4 + (TIX >> 6), nw = nb * 4;
  const float* cw = p.conv_w + ((size_t)l * 512 + lane * 8) * 3;
  float cwv[24];
#pragma unroll
  for (int i = 0; i < 24; ++i) cwv[i] = cw[i];
  const int tend = (l == NLAYER - 1) ? TL : TT;
  struct GnRaw { uint4 bg, c0, c1, c2, h0, h1, h2, ov, gv; };
  auto fetch = [&](int t, GnRaw& r) {
    const bf16_t* row = proj + (size_t)t * NPROJ;
    const int ch = lane * 8;
    bool hasl, hasr;
    if (t < TL) { const int i = t & 63; hasl = i != 0; hasr = i != 63; }
    else { const int i = (t - TL) & 255; hasl = i != 0; hasr = i != 255; }
    r.bg = *(const uint4*)(row + ch);
    r.c1 = *(const uint4*)(row + 512 + ch); r.h1 = *(const uint4*)(row + 1024 + ch);
    r.c0 = make_uint4(0, 0, 0, 0); r.h0 = r.c0; r.c2 = r.c0; r.h2 = r.c0;
    if (hasl) { r.c0 = *(const uint4*)(row - NPROJ + 512 + ch); r.h0 = *(const uint4*)(row - NPROJ + 1024 + ch); }
    if (hasr) { r.c2 = *(const uint4*)(row + NPROJ + 512 + ch); r.h2 = *(const uint4*)(row + NPROJ + 1024 + ch); }
    r.ov = *(const uint4*)(p.cat + (size_t)t * DM + 512 + lane * 8);
    r.gv = *(const uint4*)(row + 3072 + lane * 8);
  };
  GnRaw cur;
  if (gw < tend) fetch(gw, cur);
  for (int t = gw; t < tend; t += nw) {
    GnRaw nxt = cur;
    if (t + nw < tend) fetch(t + nw, nxt);
    {
      const int ch = lane * 8;
      const uint4 bg = cur.bg, c0 = cur.c0, c1 = cur.c1, c2 = cur.c2, h0 = cur.h0, h1 = cur.h1, h2 = cur.h2;
      const uint32_t bgw[4] = {bg.x, bg.y, bg.z, bg.w};
      const uint32_t c0w[4] = {c0.x, c0.y, c0.z, c0.w}, c1w[4] = {c1.x, c1.y, c1.z, c1.w}, c2w[4] = {c2.x, c2.y, c2.z, c2.w};
      const uint32_t h0w[4] = {h0.x, h0.y, h0.z, h0.w}, h1w[4] = {h1.x, h1.y, h1.z, h1.w}, h2w[4] = {h2.x, h2.y, h2.z, h2.w};
      uint32_t ow[4];
#pragma unroll
      for (int e = 0; e < 4; ++e) {
        const float z0a = bflo(c0w[e]) * bflo(h0w[e]), z1a = bflo(c1w[e]) * bflo(h1w[e]), z2a = bflo(c2w[e]) * bflo(h2w[e]);
        const float z0b = bfhi(c0w[e]) * bfhi(h0w[e]), z1b = bfhi(c1w[e]) * bfhi(h1w[e]), z2b = bfhi(c2w[e]) * bfhi(h2w[e]);
        const float ya = z0a * cwv[6 * e + 0] + z1a * cwv[6 * e + 1] + z2a * cwv[6 * e + 2];
        const float yb = z0b * cwv[6 * e + 3] + z1b * cwv[6 * e + 4] + z2b * cwv[6 * e + 5];
        ow[e] = pack2(bflo(bgw[e]) * ya, bfhi(bgw[e]) * yb);
      }
      *(uint4*)(p.cat + (size_t)t * DM + ch) = make_uint4(ow[0], ow[1], ow[2], ow[3]);
    }
    bf16_t* op = p.cat + (size_t)t * DM + 512 + lane * 8;
    const uint4 ov = cur.ov;
    const uint4 gv = cur.gv;
    float o[8], gg[8];
    o[0] = bflo(ov.x); o[1] = bfhi(ov.x); o[2] = bflo(ov.y); o[3] = bfhi(ov.y);
    o[4] = bflo(ov.z); o[5] = bfhi(ov.z); o[6] = bflo(ov.w); o[7] = bfhi(ov.w);
    gg[0] = bflo(gv.x); gg[1] = bfhi(gv.x); gg[2] = bflo(gv.y); gg[3] = bfhi(gv.y);
    gg[4] = bflo(gv.z); gg[5] = bfhi(gv.z); gg[6] = bflo(gv.w); gg[7] = bfhi(gv.w);
    float s1 = 0.f;
#pragma unroll
    for (int i = 0; i < 8; ++i) s1 += o[i];
    s1 = row16_sum(s1);
    const float mu = s1 * (1.f / 128.f);
    float s2 = 0.f;
#pragma unroll
    for (int i = 0; i < 8; ++i) { const float d = o[i] - mu; s2 += d * d; }
    s2 = row16_sum(s2);
    const float rs = rsqrtf(s2 * (1.f / 128.f) + 1e-5f);
    float y[8];
#pragma unroll
    for (int i = 0; i < 8; ++i) y[i] = silu_f(gg[i]) * (o[i] - mu) * rs;
    *(uint4*)op = make_uint4(pack2(y[0], y[1]), pack2(y[2], y[3]), pack2(y[4], y[5]), pack2(y[6], y[7]));
    cur = nxt;
  }
}

__device__ __forceinline__ void ph_ln(const Params& p, int l, int which, int bid, int nb) {
  const int TIX = opaque_tid(); bid = opaque_s(bid);
  const int lane = TIX & 63;
  const int gw = bid * 4 + (TIX >> 6), nw = nb * 4;
  const bool last = (l == NLAYER - 1);
  const int tend = last ? TL : TT;
  bf16_t* xres = (bf16_t*)p.xres;
  const bf16_t* ybf = (const bf16_t*)p.ybuf;
  (void)which;
  float4 pgg[4], pbb[4], pgv[4], psh[4], psc[4];
#pragma unroll
  for (int i = 0; i < 4; ++i) {
    pgg[i] = *(const float4*)(p.ln1_g + (size_t)l * DM + lane * 16 + 4 * i);
    pbb[i] = *(const float4*)(p.ln1_b + (size_t)l * DM + lane * 16 + 4 * i);
    pgv[i] = pgg[i]; psh[i] = pgg[i]; psc[i] = pgg[i];
  }
  int cur_row = -1;
  uint4 xa, xb, ya, yb;
  float4 xf[4];
#define LN_FETCH(T, XA, XB, YA, YB, XF) {                                                                                       \
    if (l == 0) { const float* xs_ = ((T) < TL ? p.x + (size_t)(T) * DM : p.ctx + (size_t)((T) - TL) * DM) + lane * 16;        \
      _Pragma("unroll") for (int i = 0; i < 4; ++i) XF[i] = *(const float4*)(xs_ + 4 * i); }                                     \
    else { const bf16_t* xs_ = xres + (size_t)(T) * DM + lane * 16; XA = *(const uint4*)xs_; XB = *(const uint4*)(xs_ + 8); }    \
    const bf16_t* ys_ = ybf + (size_t)(T) * DM + lane * 16; YA = *(const uint4*)ys_; YB = *(const uint4*)(ys_ + 8); }
  if (gw < tend) LN_FETCH(gw, xa, xb, ya, yb, xf)
  for (int t = gw; t < tend; t += nw) {
    uint4 nxa = xa, nxb = xb, nya = ya, nyb = yb; float4 nxf[4] = {xf[0], xf[1], xf[2], xf[3]};
    if (t + nw < tend) LN_FETCH(t + nw, nxa, nxb, nya, nyb, nxf)
    const int mr = mod_row(t);
    if (mr != cur_row) {
      cur_row = mr;
      const float* m = p.mod + (size_t)(l * 5 + mr) * 6144 + lane * 16;
#pragma unroll
      for (int i = 0; i < 4; ++i) { pgv[i] = *(const float4*)(m + 2048 + 4 * i); psh[i] = *(const float4*)(m + 3072 + 4 * i); psc[i] = *(const float4*)(m + 4096 + 4 * i); }
    }
    const uint32_t xw[8] = {xa.x, xa.y, xa.z, xa.w, xb.x, xb.y, xb.z, xb.w};
    const uint32_t yw[8] = {ya.x, ya.y, ya.z, ya.w, yb.x, yb.y, yb.z, yb.w};
    float v[16];
    float s1 = 0.f;
#pragma unroll
    for (int i = 0; i < 4; ++i) {
      const float4 xv = (l == 0) ? xf[i] : make_float4(bflo(xw[2 * i]), bfhi(xw[2 * i]), bflo(xw[2 * i + 1]), bfhi(xw[2 * i + 1]));
      const float4 gv = pgv[i];
      v[4 * i + 0] = ALPHA_F * xv.x + gv.x * bflo(yw[2 * i]); v[4 * i + 1] = ALPHA_F * xv.y + gv.y * bfhi(yw[2 * i]);
      v[4 * i + 2] = ALPHA_F * xv.z + gv.z * bflo(yw[2 * i + 1]); v[4 * i + 3] = ALPHA_F * xv.w + gv.w * bfhi(yw[2 * i + 1]);
      s1 += v[4 * i + 0] + v[4 * i + 1] + v[4 * i + 2] + v[4 * i + 3];
    }
    const float mu = wave_sum(s1) * (1.f / 1024.f);
    float s2 = 0.f;
#pragma unroll
    for (int i = 0; i < 16; ++i) { const float d = v[i] - mu; s2 += d * d; }
    const float rs = rsqrtf(wave_sum(s2) * (1.f / 1024.f) + 1e-5f);
    uint32_t xo[8], hw[8];
#pragma unroll
    for (int i = 0; i < 4; ++i) {
      const float4 gg = pgg[i], bb = pbb[i], sh = psh[i], sc = psc[i];
      float4 o;
      o.x = (v[4 * i + 0] - mu) * rs * gg.x + bb.x; o.y = (v[4 * i + 1] - mu) * rs * gg.y + bb.y;
      o.z = (v[4 * i + 2] - mu) * rs * gg.z + bb.z; o.w = (v[4 * i + 3] - mu) * rs * gg.w + bb.w;
      xo[2 * i] = pack2(o.x, o.y); xo[2 * i + 1] = pack2(o.z, o.w);
      hw[2 * i] = pack2(o.x * (1.f + sc.x) + sh.x, o.y * (1.f + sc.y) + sh.y);
      hw[2 * i + 1] = pack2(o.z * (1.f + sc.z) + sh.z, o.w * (1.f + sc.w) + sh.w);
    }
    bf16_t* xd = xres + (size_t)t * DM + lane * 16;
    *(uint4*)xd = make_uint4(xo[0], xo[1], xo[2], xo[3]);
    *(uint4*)(xd + 8) = make_uint4(xo[4], xo[5], xo[6], xo[7]);
    bf16_t* hd = p.hA + (size_t)t * DM + lane * 16;
    *(uint4*)hd = make_uint4(hw[0], hw[1], hw[2], hw[3]);
    *(uint4*)(hd + 8) = make_uint4(hw[4], hw[5], hw[6], hw[7]);
    xa = nxa; xb = nxb; ya = nya; yb = nyb;
#pragma unroll
    for (int i = 0; i < 4; ++i) xf[i] = nxf[i];
  }
#undef LN_FETCH
}

#define CE_DESC(A, B) { const unsigned hi_ = max(A, B), lo_ = min(A, B); A = hi_; B = lo_; }
__device__ __forceinline__ unsigned key_enc(float x, unsigned lowmask, unsigned tag) {
  const unsigned b = __float_as_uint(x);
  const unsigned sgn = (unsigned)((int)b >> 31) | 0x80000000u;
  return ((b ^ sgn) & ~lowmask) | tag;
}
__device__ __forceinline__ float key_val(unsigned key, unsigned lowmask) {
  const unsigned sv = key & ~lowmask;
  return __uint_as_float((sv & 0x80000000u) ? (sv ^ 0x80000000u) : ~sv);
}
__device__ __forceinline__ void sort16_desc(unsigned (&k)[16]) {
#pragma unroll
  for (int size = 2; size <= 16; size <<= 1) {
#pragma unroll
    for (int stride = size >> 1; stride >= 1; stride >>= 1) {
#pragma unroll
      for (int i = 0; i < 16; ++i) {
        if ((i & stride) == 0) {
          const int j = i | stride;
          if ((i & size) == 0 || size == 16) { CE_DESC(k[i], k[j]) } else { CE_DESC(k[j], k[i]) }
        }
      }
    }
  }
}
__device__ __forceinline__ void merge16_desc(unsigned (&r)[16], const unsigned (&c)[16]) {
#pragma unroll
  for (int i = 0; i < 16; ++i) r[i] = max(r[i], c[15 - i]);
#pragma unroll
  for (int stride = 8; stride >= 1; stride >>= 1) {
#pragma unroll
    for (int i = 0; i < 16; ++i) {
      if ((i & stride) == 0) { CE_DESC(r[i], r[i | stride]) }
    }
  }
}

__device__ __forceinline__ void pair_merge16(unsigned (&r)[16]) {
  unsigned c[16];
#pragma unroll
  for (int i = 0; i < 16; ++i) c[i] = (unsigned)__builtin_amdgcn_update_dpp(0, (int)r[i], 0xB1, 0xF, 0xF, true);
  merge16_desc(r, c);
}

__device__ __forceinline__ void ph_wk_topk(const Params& p, int l, int bid, int nb, char* smem) {
  const int TIX = opaque_tid(); bid = opaque_s(bid);
  const int tid = TIX, lane = tid & 63, wave = tid >> 6;
  const int wm = wave >> 1, wn = wave & 1;
  float* sc = (float*)smem;
  const bf16_t* Bt = p.wkT + (size_t)l * 2048 * DM;
  const int trow = tid >> 1, thalf = tid & 1;
  const int nitem_wk = (((l == NLAYER - 1) ? TL : TT) / 128) * 8;
  for (int k = 0;; ++k) {
    int tm, hh;
    if (!xcd_tile<4, 2>(bid, nb, k, nitem_wk >> 3, 8, tm, hh)) break;
    const int m0 = tm << 7;
    unsigned K0[16];
#pragma unroll
    for (int i = 0; i < 16; ++i) K0[i] = 0u;
    for (int ph = 0; ph < 2; ++ph) {
      f32x4 acc[4][4];
      gemm_tile_acc(p.hA, Bt, DM, m0, (hh * 2 + ph) * 128, smem, tid, acc);
#pragma unroll
      for (int i = 0; i < 4; ++i)
#pragma unroll
        for (int j = 0; j < 4; ++j)
#pragma unroll
          for (int r = 0; r < 4; ++r)
            sc[(wm * 64 + i * 16 + (lane >> 4) * 4 + r) * 130 + wn * 65 + j * 16 + (lane & 15)] = acc[i][j][r];
      __syncthreads();
      {
        float* row = sc + trow * 130 + thalf * 65;
        unsigned R[16];
#pragma unroll
        for (int i = 0; i < 16; ++i) R[i] = key_enc(row[i], 127u, 127u - (unsigned)(thalf * 64 + i));
        sort16_desc(R);
#pragma unroll 1
        for (int c = 1; c < 4; ++c) {
          unsigned C[16];
#pragma unroll
          for (int i = 0; i < 16; ++i) C[i] = key_enc(row[c * 16 + i], 127u, 127u - (unsigned)(thalf * 64 + c * 16 + i));
          sort16_desc(C);
          merge16_desc(R, C);
        }
        pair_merge16(R);
        if (ph == 0) {
#pragma unroll
          for (int i = 0; i < 16; ++i) K0[i] = R[i];
        } else {
          float av[16], bv[16];
          int* tab = (int*)(sc + trow * 130);
#pragma unroll
          for (int i = 0; i < 16; ++i) {
            av[i] = key_val(K0[i], 127u); bv[i] = key_val(R[i], 127u);
            tab[i] = 127 - (int)(K0[i] & 127u); tab[16 + i] = 127 - (int)(R[i] & 127u);
          }
          unsigned QA[16], QB[16];
#pragma unroll
          for (int i = 0; i < 16; ++i) { QA[i] = 0u; QB[i] = 0u; }
          {
            int n = 0;
#pragma unroll
            for (int i = 0; i < 16; ++i) {
#pragma unroll
              for (int j = 0; j < 16; ++j) {
                if ((i + 1) * (j + 1) <= 16) {
                  const unsigned key = key_enc(av[i] + bv[j], 255u, 255u - (unsigned)(i * 16 + j));
                  const int ch = n >> 4, sl = n & 15;
                  if (ch == 0) QA[sl] = thalf ? QA[sl] : key;
                  if (ch == 1) QB[sl] = thalf ? QB[sl] : key;
                  if (ch == 2) QA[sl] = thalf ? key : QA[sl];
                  if (ch == 3) QB[sl] = thalf ? key : QB[sl];
                  ++n;
                }
              }
            }
          }
          sort16_desc(QA); sort16_desc(QB);
          merge16_desc(QA, QB);
          pair_merge16(QA);
          float e[16], sum = 0.f;
          const float cv0 = key_val(QA[0], 255u);
#pragma unroll
          for (int i = 0; i < 16; ++i) { e[i] = __expf(key_val(QA[i], 255u) - cv0); sum += e[i]; }
          const float inv = 1.f / sum;
          const unsigned hm = thalf ? 0xFFFFFFFFu : 0u;
          int ce[8]; float ge[8];
#pragma unroll
          for (int i = 0; i < 8; ++i) {
            const unsigned key = (QA[8 + i] & hm) | (QA[i] & ~hm);
            const unsigned flat = 255u - (key & 255u);
            ce[i] = tab[flat >> 4] * 128 + tab[16 + (flat & 15u)];
            ge[i] = __uint_as_float((__float_as_uint(e[8 + i]) & hm) | (__float_as_uint(e[i]) & ~hm)) * inv;
          }
          const size_t o = ((size_t)(m0 + trow) * 8 + hh) * 16 + thalf * 8;
          int4* de = (int4*)(p.pe + o);
          float4* dg = (float4*)(p.pg + o);
          de[0] = make_int4(ce[0], ce[1], ce[2], ce[3]); de[1] = make_int4(ce[4], ce[5], ce[6], ce[7]);
          dg[0] = make_float4(ge[0], ge[1], ge[2], ge[3]); dg[1] = make_float4(ge[4], ge[5], ge[6], ge[7]);
        }
      }
    }
  }
}

typedef float f32x2 __attribute__((ext_vector_type(2)));

#define DPPI(V, CTRL) __builtin_amdgcn_update_dpp(0, (V), (CTRL), 0xF, 0xF, true)
__device__ __forceinline__ int reduce16_transpose_i(const int (&v)[16], int lane) {
  const bool b0 = lane & 1, b1 = lane & 2, b2 = lane & 4, b3 = lane & 8;
  int w[8], x[4], y[2];
#pragma unroll
  for (int i = 0; i < 8; ++i) {
    const int mine = b0 ? v[2 * i + 1] : v[2 * i], other = b0 ? v[2 * i] : v[2 * i + 1];
    w[i] = mine + DPPI(other, 0xB1);
  }
#pragma unroll
  for (int i = 0; i < 4; ++i) {
    const int mine = b1 ? w[2 * i + 1] : w[2 * i], other = b1 ? w[2 * i] : w[2 * i + 1];
    x[i] = mine + DPPI(other, 0x4E);
  }
#pragma unroll
  for (int i = 0; i < 2; ++i) {
    const int mine = b2 ? x[2 * i + 1] : x[2 * i], other = b2 ? x[2 * i] : x[2 * i + 1];
    const int up = DPPI(other, 0x104), dn = DPPI(other, 0x114);
    y[i] = mine + (b2 ? dn : up);
  }
  const int mine = b3 ? y[1] : y[0], other = b3 ? y[0] : y[1];
  int z = mine + DPPI(other, 0x128);
  z += __shfl_xor(z, 16);
  z += __shfl_xor(z, 32);
  return z;
}

#define GBS 16
#define GBV 8
#define GGT 8
__device__ __forceinline__ void wave_sort128(int& a, int& b, int lane) {
#pragma unroll
  for (int size = 2; size <= 128; size <<= 1) {
#pragma unroll
    for (int stride = size >> 1; stride >= 1; stride >>= 1) {
      if (stride == 64) {
        const int lo = min(a, b), hi = max(a, b); a = lo; b = hi;
      } else {
        const int pa = __shfl_xor(a, stride), pb = __shfl_xor(b, stride);
        const bool lower = (lane & stride) == 0;
        const bool asc_a = (lane & size) == 0, asc_b = ((lane + 64) & size) == 0;
        a = (lower == asc_a) ? min(a, pa) : max(a, pa);
        b = (lower == asc_b) ? min(b, pb) : max(b, pb);
      }
    }
  }
}

template <int GT>
__device__ __forceinline__ void gather_group(const Params& p, const int l, const int tb, const int lane, const unsigned char* ut,
                                             const unsigned char* vt, const bool last, const float* lg, const float* lb,
                                             int* es, float* gs, uint4* hqs) {
    float hsc[GT];
#pragma unroll
    for (int j = 0; j < GT; ++j) {
      const size_t t = (size_t)(tb + j);
      int ka = (p.pe[t * 128 + lane] << 7) | lane, kb2 = (p.pe[t * 128 + 64 + lane] << 7) | (64 + lane);
      const float ga = p.pg[t * 128 + lane], gb = p.pg[t * 128 + 64 + lane];
      wave_sort128(ka, kb2, lane);
      const int ia = ka & 127, ib = kb2 & 127;
      const float xa = __shfl(ga, ia & 63), ya = __shfl(gb, ia & 63);
      const float xb = __shfl(ga, ib & 63), yb = __shfl(gb, ib & 63);
      es[j * 128 + lane] = ka >> 7; es[j * 128 + 64 + lane] = kb2 >> 7;
      gs[j * 128 + lane] = ia < 64 ? xa : ya; gs[j * 128 + 64 + lane] = ib < 64 ? xb : yb;
      const bf16_t* hrow = p.hA + t * DM + lane * 16;
      const uint4 h0 = *(const uint4*)hrow, h1 = *(const uint4*)(hrow + 8);
      float hf[16];
      hf[0] = bflo(h0.x); hf[1] = bfhi(h0.x); hf[2] = bflo(h0.y); hf[3] = bfhi(h0.y);
      hf[4] = bflo(h0.z); hf[5] = bfhi(h0.z); hf[6] = bflo(h0.w); hf[7] = bfhi(h0.w);
      hf[8] = bflo(h1.x); hf[9] = bfhi(h1.x); hf[10] = bflo(h1.y); hf[11] = bfhi(h1.y);
      hf[12] = bflo(h1.z); hf[13] = bfhi(h1.z); hf[14] = bflo(h1.w); hf[15] = bfhi(h1.w);
      float mx = 0.f;
#pragma unroll
      for (int i = 0; i < 16; ++i) mx = fmaxf(mx, fabsf(hf[i]));
#pragma unroll
      for (int o = 32; o > 0; o >>= 1) mx = fmaxf(mx, __shfl_xor(mx, o));
      mx = fmaxf(mx, 1e-20f);
      const float qs = 127.f / mx;
      hsc[j] = mx * (1.f / 127.f) * (1.f / QSCALE_U);
      hqs[j * 64 + lane] = make_uint4(pack_i8x4(hf[0] * qs, hf[1] * qs, hf[2] * qs, hf[3] * qs), pack_i8x4(hf[4] * qs, hf[5] * qs, hf[6] * qs, hf[7] * qs),
                                      pack_i8x4(hf[8] * qs, hf[9] * qs, hf[10] * qs, hf[11] * qs), pack_i8x4(hf[12] * qs, hf[13] * qs, hf[14] * qs, hf[15] * qs));
    }
#pragma unroll 1
    for (int bi = 0; bi < 128 / GBS; ++bi) {
#pragma unroll
      for (int j = 0; j < GT; ++j) {
        uint4 uw[GBS];
        const int esrc = es[j * 128 + bi * GBS + (lane & (GBS - 1))];
#pragma unroll
        for (int u = 0; u < GBS; ++u) {
          const int e = __builtin_amdgcn_readlane(esrc, u);
          uw[u] = *(const uint4*)(ut + (size_t)e * DM);
        }
        int d[GBS];
        const uint4 hqj = hqs[j * 64 + lane];
#pragma unroll
        for (int u = 0; u < GBS; ++u) {
          int dd = __builtin_amdgcn_sdot4((int)uw[u].x, (int)hqj.x, 0, false);
          dd = __builtin_amdgcn_sdot4((int)uw[u].y, (int)hqj.y, dd, false);
          dd = __builtin_amdgcn_sdot4((int)uw[u].z, (int)hqj.z, dd, false);
          dd = __builtin_amdgcn_sdot4((int)uw[u].w, (int)hqj.w, dd, false);
          d[u] = dd;
        }
        static_assert(GBS == 16, "reduce16_transpose handles 16 pairs per batch");
        const float dsel = (float)reduce16_transpose_i(d, lane) * hsc[j];
        const float gsel = gs[j * 128 + bi * GBS + (lane & (GBS - 1))];
        const float a = gsel * 0.5f * dsel * (1.f + erff(dsel * 0.7071067811865476f)) * (1.f / SCALE_V);
        if (lane < GBS) gs[j * 128 + bi * GBS + lane] = a;
        asm volatile("" ::: "memory");
        __builtin_amdgcn_sched_barrier(0);
      }
    }
    constexpr int GV = (GT > 4) ? 4 : GT;
#pragma unroll 1
    for (int j0 = 0; j0 < GT; j0 += GV) {
    f32x2 acc2[GV][8];
#pragma unroll
    for (int j = 0; j < GV; ++j)
#pragma unroll
      for (int i = 0; i < 8; ++i) acc2[j][i] = f32x2{0.f, 0.f};
#pragma unroll 1
    for (int bi = 0; bi < 128 / GBV; ++bi) {
#pragma unroll
      for (int j = 0; j < GV; ++j) {
        uint4 vw[GBV]; float aa[GBV];
        const int esrc = es[(j0 + j) * 128 + bi * GBV + (lane & (GBV - 1))];
        const int gsrc = __builtin_bit_cast(int, gs[(j0 + j) * 128 + bi * GBV + (lane & (GBV - 1))]);
#pragma unroll
        for (int u = 0; u < GBV; ++u) {
          const int e = __builtin_amdgcn_readlane(esrc, u);
          aa[u] = __builtin_bit_cast(float, __builtin_amdgcn_readlane(gsrc, u));
          vw[u] = *(const uint4*)(vt + (size_t)e * DM);
        }
#pragma unroll
        for (int u = 0; u < GBV; ++u) {
          uint32_t w0 = vw[u].x, w1 = vw[u].y, w2 = vw[u].z, w3 = vw[u].w;
          asm volatile("" : "+v"(w0), "+v"(w1), "+v"(w2), "+v"(w3) : "v"(acc2[j][0]), "v"(acc2[j][7]));
          const f32x2 a2 = f32x2{aa[u], aa[u]};
          acc2[j][0] += __builtin_amdgcn_cvt_pk_f32_fp8((int)w0, false) * a2;
          acc2[j][1] += __builtin_amdgcn_cvt_pk_f32_fp8((int)w0, true) * a2;
          acc2[j][2] += __builtin_amdgcn_cvt_pk_f32_fp8((int)w1, false) * a2;
          acc2[j][3] += __builtin_amdgcn_cvt_pk_f32_fp8((int)w1, true) * a2;
          acc2[j][4] += __builtin_amdgcn_cvt_pk_f32_fp8((int)w2, false) * a2;
          acc2[j][5] += __builtin_amdgcn_cvt_pk_f32_fp8((int)w2, true) * a2;
          acc2[j][6] += __builtin_amdgcn_cvt_pk_f32_fp8((int)w3, false) * a2;
          acc2[j][7] += __builtin_amdgcn_cvt_pk_f32_fp8((int)w3, true) * a2;
        }
        asm volatile("" ::: "memory");
        __builtin_amdgcn_sched_barrier(0);
      }
    }
    float acc[GV][16];
#pragma unroll
    for (int j = 0; j < GV; ++j)
#pragma unroll
      for (int i = 0; i < 8; ++i) { acc[j][2 * i] = acc2[j][i].x; acc[j][2 * i + 1] = acc2[j][i].y; }
    float4 pgv[4], pgg[4], pbb[4], psh[4], psc[4];
    {
      const int t0 = tb + j0;
      const float* m = p.mod + (size_t)(l * 5 + mod_row(t0)) * 6144 + lane * 16;
      const float* m2 = p.mod + (size_t)((last ? l : l + 1) * 5 + mod_row(t0)) * 6144 + lane * 16;
#pragma unroll
      for (int i = 0; i < 4; ++i) {
        pgv[i] = *(const float4*)(m + 5120 + 4 * i);
        pgg[i] = *(const float4*)(lg + 4 * i); pbb[i] = *(const float4*)(lb + 4 * i);
        psh[i] = *(const float4*)(m2 + 4 * i); psc[i] = *(const float4*)(m2 + 1024 + 4 * i);
      }
    }
#pragma unroll
    for (int j = 0; j < GV; ++j) {
      __builtin_amdgcn_sched_barrier(0);
      const int t = tb + j0 + j;
      bf16_t* xr = (bf16_t*)p.xres + (size_t)t * DM + lane * 16;
      const uint4 xb0 = *(const uint4*)xr, xb1 = *(const uint4*)(xr + 8);
      const uint32_t xw[8] = {xb0.x, xb0.y, xb0.z, xb0.w, xb1.x, xb1.y, xb1.z, xb1.w};
      float v[16];
      float s1 = 0.f;
#pragma unroll
      for (int i = 0; i < 4; ++i) {
        const float4 xv = make_float4(bflo(xw[2 * i]), bfhi(xw[2 * i]), bflo(xw[2 * i + 1]), bfhi(xw[2 * i + 1]));
        const float4 gv = pgv[i];
        v[4 * i + 0] = ALPHA_F * xv.x + gv.x * acc[j][4 * i + 0]; v[4 * i + 1] = ALPHA_F * xv.y + gv.y * acc[j][4 * i + 1];
        v[4 * i + 2] = ALPHA_F * xv.z + gv.z * acc[j][4 * i + 2]; v[4 * i + 3] = ALPHA_F * xv.w + gv.w * acc[j][4 * i + 3];
        s1 += v[4 * i + 0] + v[4 * i + 1] + v[4 * i + 2] + v[4 * i + 3];
      }
      const float mu = wave_sum(s1) * (1.f / 1024.f);
      float s2 = 0.f;
#pragma unroll
      for (int i = 0; i < 16; ++i) { const float dlt = v[i] - mu; s2 += dlt * dlt; }
      const float rs = rsqrtf(wave_sum(s2) * (1.f / 1024.f) + 1e-5f);
      uint32_t hw[8], xo[8];
#pragma unroll
      for (int i = 0; i < 4; ++i) {
        const float4 gg = pgg[i];
        const float4 bb = pbb[i];
        float4 o;
        o.x = (v[4 * i + 0] - mu) * rs * gg.x + bb.x; o.y = (v[4 * i + 1] - mu) * rs * gg.y + bb.y;
        o.z = (v[4 * i + 2] - mu) * rs * gg.z + bb.z; o.w = (v[4 * i + 3] - mu) * rs * gg.w + bb.w;
        xo[2 * i] = pack2(o.x, o.y); xo[2 * i + 1] = pack2(o.z, o.w);
        if (last && t < TL) *(float4*)(p.out + (size_t)t * DM + lane * 16 + 4 * i) = o;
        const float4 sh = psh[i];
        const float4 sc = psc[i];
        hw[2 * i] = pack2(o.x * (1.f + sc.x) + sh.x, o.y * (1.f + sc.y) + sh.y);
        hw[2 * i + 1] = pack2(o.z * (1.f + sc.z) + sh.z, o.w * (1.f + sc.w) + sh.w);
      }
      *(uint4*)xr = make_uint4(xo[0], xo[1], xo[2], xo[3]);
      *(uint4*)(xr + 8) = make_uint4(xo[4], xo[5], xo[6], xo[7]);
      bf16_t* hd = p.hA + (size_t)t * DM + lane * 16;
      *(uint4*)hd = make_uint4(hw[0], hw[1], hw[2], hw[3]);
      *(uint4*)(hd + 8) = make_uint4(hw[4], hw[5], hw[6], hw[7]);
    }
    }
}

__device__ __forceinline__ void ph_gather_sorted(const Params& p, int l, int bid, int nb, char* smem) {
  const int TIX = opaque_tid(); bid = opaque_s(bid);
  const int lane = TIX & 63;
  const int gw = bid * 4 + (TIX >> 6), nw = nb * 4;
  const unsigned char* ut = (const unsigned char*)p.ubf + lane * 16;
  const unsigned char* vt = (const unsigned char*)p.vbf + lane * 16;
  const bool last = (l == NLAYER - 1);
  const float* lg = p.ln2_g + (size_t)l * DM + lane * 16;
  const float* lb = p.ln2_b + (size_t)l * DM + lane * 16;
  int* es = (int*)(smem + (TIX >> 6) * (GGT * 2048));
  float* gs = (float*)(es + GGT * 128);
  uint4* hqs = (uint4*)(gs + GGT * 128);
  for (int grp = gw; grp < TL / GGT; grp += nw) gather_group<GGT>(p, l, grp * GGT, lane, ut, vt, last, lg, lb, es, gs, hqs);
  if (!last) for (int t = TL + gw; t < TT; t += nw) gather_group<1>(p, l, t, lane, ut, vt, last, lg, lb, es, gs, hqs);
}

enum { PH_PRE_A = 0, PH_PRE_B, PH_INIT, PH_GEMM_IN, PH_ELEM, PH_RET_UPD, PH_RET_SCAN, PH_RET_OUT, PH_GEMM_OUT, PH_LN1,
       PH_GEMM_WK, PH_TOPK1, PH_TOPK2, PH_GATHER, PH_LN2, PH_GNORM };

__device__ __forceinline__ void run_phase(const Params& p, int ph, int l, int bid, int nb, char* smem) {
  switch (ph) {
    case PH_PRE_A:
      ph_mod_partial(p, bid, nb, smem);
      for (int ll = 0; ll < NLAYER; ++ll) {
        ph_transpose_cvt(p.w_in + (size_t)ll * DM * NPROJ, p.w_inT + (size_t)ll * NPROJ * DM, DM, NPROJ, bid, nb, smem);
        ph_transpose_cvt(p.w_out + (size_t)ll * DM * DM, p.w_outT + (size_t)ll * DM * DM, DM, DM, bid, nb, smem);
      }
      ph_wk_fold(p, bid, nb, smem);
      break;
    case PH_PRE_B: ph_mod_reduce(p, bid, nb); break;
    case PH_INIT: ph_init_h(p, bid, nb); break;
    case PH_GEMM_IN:
      ph_gemm_in(p, l, bid, nb, smem);
      break;
    case PH_RET_UPD: ph_ret_upd(p, bid, nb, smem); break;
    case PH_RET_SCAN: ph_ret_scan(p, bid, nb); break;
    case PH_RET_OUT: ph_ret_out(p, l, bid, nb, smem); break;
    case PH_GEMM_OUT: ph_gemm<true>(p.cat, p.w_outT + (size_t)l * DM * DM, p.ybuf, (l == NLAYER - 1) ? TL : TT, DM, DM, bid, nb, smem); break;
    case PH_LN1: ph_ln(p, l, 1, bid, nb); break;
    case PH_GEMM_WK: ph_wk_topk(p, l, bid, nb, smem); break;
    case PH_GATHER: ph_gather_sorted(p, l, bid, nb, smem); break;
    case PH_GNORM: ph_gnorm(p, l, bid, nb); break;
  }
}

extern __shared__ __attribute__((aligned(16))) char dyn_smem[];

#define XB_TMO      128
#define XB_XCNT(j)  (256  + 64 * (j))
#define XB_XSUB(j)  (1280 + 64 * (j))
#define XB_XGEN(j)  (2304 + 64 * (j))
#define XB_TOP      3328
#define XB_TOPGEN   3392
#define XCD_BAR_WORDS 3456
#define XB_SPIN_CAP (1u << 22)
__device__ __forceinline__ unsigned xb_ld(unsigned* q)              { return __hip_atomic_load(q, __ATOMIC_RELAXED, __HIP_MEMORY_SCOPE_AGENT); }
__device__ __forceinline__ unsigned xb_add(unsigned* q, unsigned v) { return __hip_atomic_fetch_add(q, v, __ATOMIC_RELAXED, __HIP_MEMORY_SCOPE_AGENT); }
__device__ __forceinline__ unsigned xb_xcc_id() { return (unsigned)__builtin_amdgcn_s_getreg((3 << 11) | 20) & 0xFu; }
#define XB_SPIN(cond, bar) do { unsigned _sp = 0; while (cond) { __builtin_amdgcn_s_sleep(1); \
    if ((++_sp & 255u) == 0u) { if (xb_ld(&(bar)[XB_TMO])) break; if (_sp > XB_SPIN_CAP) { atomicAdd(&(bar)[XB_TMO], 1u); break; } } } } while (0)
struct XcdBarrier { unsigned* bar; unsigned x; volatile unsigned* st; };
__device__ __forceinline__ XcdBarrier xcd_barrier_post(unsigned* bar, volatile unsigned* st) {
  XcdBarrier b; b.bar = bar; b.x = xb_xcc_id(); b.st = st;
  if (threadIdx.x == 0) (void)xb_add(&bar[XB_XCNT(b.x)], 1u);
  return b;
}
__device__ __forceinline__ void xcd_barrier_complete(unsigned* bar, unsigned x, unsigned& nloc, unsigned& nx) {
  const unsigned G = gridDim.x * gridDim.y * gridDim.z;
  unsigned sum, cnt, mine, sp = 0u;
  for (;;) {
    sum = 0u; cnt = 0u; mine = 0u;
#pragma unroll
    for (unsigned j = 0; j < 16; ++j) { const unsigned c = xb_ld(&bar[XB_XCNT(j)]); sum += c; cnt += (c > 0u) ? 1u : 0u; mine = (j == x) ? c : mine; }
    if (sum == G) break;
    __builtin_amdgcn_s_sleep(1);
    if ((++sp & 255u) == 0u) { if (xb_ld(&bar[XB_TMO])) break; if (sp > XB_SPIN_CAP) { atomicAdd(&bar[XB_TMO], 1u); break; } }
  }
  nloc = mine > 0u ? mine : 1u; nx = cnt > 0u ? cnt : 1u;
}
__device__ __forceinline__ void xcd_barrier(const XcdBarrier& b) {
  asm volatile("s_waitcnt vmcnt(0)" ::: "memory");
  __syncthreads();
  if (threadIdx.x == 0) {
    unsigned* bar = b.bar;
    __builtin_amdgcn_s_waitcnt(0);
    unsigned nloc = b.st[0], nx = b.st[1];
    if (nloc == 0u) { xcd_barrier_complete(bar, b.x, nloc, nx); b.st[0] = nloc; b.st[1] = nx; }
    const unsigned old = xb_add(&bar[XB_XSUB(b.x)], 1u);
    const unsigned gen = old / nloc;
    if (old + 1u == (gen + 1u) * nloc) {
      __builtin_amdgcn_fence(__ATOMIC_RELEASE, "agent");
      asm volatile("s_waitcnt vmcnt(0)" ::: "memory");
      const unsigned og = xb_add(&bar[XB_TOP], 1u);
      const unsigned tg = og / nx;
      if (og + 1u == (tg + 1u) * nx) xb_add(&bar[XB_TOPGEN], 1u);
      else XB_SPIN(xb_ld(&bar[XB_TOPGEN]) == tg, bar);
      __builtin_amdgcn_fence(__ATOMIC_ACQUIRE, "agent");
      xb_add(&bar[XB_XGEN(b.x)], 1u);
      asm volatile("s_waitcnt vmcnt(0)" ::: "memory");
    } else {
      XB_SPIN(xb_ld(&bar[XB_XGEN(b.x)]) == gen, bar);
      __builtin_amdgcn_fence(__ATOMIC_ACQUIRE, "agent");
      asm volatile("s_waitcnt vmcnt(0)" ::: "memory");
    }
  }
  __syncthreads();
}

__global__ void __launch_bounds__(256, 2) k_mega(Params p) {
  cg::grid_group grid = cg::this_grid();
  const int bid = blockIdx.x, nb = gridDim.x;
  volatile unsigned* xst = (volatile unsigned*)(dyn_smem + 66560);
  if (threadIdx.x == 0) { xst[0] = 0u; xst[1] = 0u; xst[2] = 0u; xst[3] = 0u; }
  __syncthreads();
  const XcdBarrier xb = xcd_barrier_post(p.bar, xst);
#define GSYNC() xcd_barrier(xb)
  grid.sync();
#define RUNP(PH, L, SYNC) do { unsigned long long t0_ = 0; if ((PROBE_MASK >> (PH)) & 1) t0_ = wall_clock64(); \
    run_phase(p, PH, L, bid, nb, dyn_smem); if (SYNC) GSYNC(); \
    if ((PROBE_MASK >> (PH)) & 1) { if (!(SYNC)) GSYNC(); const unsigned long long t1_ = wall_clock64(); \
      while (wall_clock64() - t1_ < t1_ - t0_) __builtin_amdgcn_s_sleep(8); GSYNC(); } } while (0)
  RUNP(PH_PRE_A, 0, 1);
  RUNP(PH_PRE_B, 0, 1);
  RUNP(PH_INIT, 0, 1);
  for (int l = 0; l < NLAYER; ++l) {
    RUNP(PH_GEMM_IN, l, 1);
    RUNP(PH_RET_UPD, l, 1);
    RUNP(PH_RET_SCAN, l, 1);
    RUNP(PH_RET_OUT, l, 1);
    RUNP(PH_GNORM, l, 1);
    RUNP(PH_GEMM_OUT, l, 1);
    RUNP(PH_LN1, l, 1);
    RUNP(PH_GEMM_WK, l, 1);
    RUNP(PH_GATHER, l, (l + 1 < NLAYER));
  }
#undef GSYNC
}

static inline size_t al256(size_t v) { return (v + 255) & ~(size_t)255; }

extern "C" void kernel_launch(void* const* d_in, const int* in_sizes, int n_in, void* d_out, int out_size, void* d_ws,
                              size_t ws_size, hipStream_t stream) {
  static int mgrid = 0;
  if (mgrid == 0) {
    int dev = 0, cus = 0, per_cu = 0;
    (void)hipGetDevice(&dev);
    (void)hipDeviceGetAttribute(&cus, hipDeviceAttributeMultiprocessorCount, dev);
    if (cus <= 0) cus = 256;
    (void)hipFuncSetAttribute((const void*)k_mega, hipFuncAttributeMaxDynamicSharedMemorySize, SMEM_BYTES);
    if (hipOccupancyMaxActiveBlocksPerMultiprocessor(&per_cu, (const void*)k_mega, 256, SMEM_BYTES) != hipSuccess || per_cu < 1) per_cu = 1;
    if (per_cu > 2) per_cu = 2;
    mgrid = cus * per_cu;
  }
  Params p{};
  p.x = (const float*)d_in[0]; p.c = (const float*)d_in[1]; p.ctx = (const float*)d_in[2]; p.c_ctx = (const float*)d_in[3];
  p.w_mod = (const float*)d_in[4]; p.b_mod = (const float*)d_in[5]; p.w_in = (const float*)d_in[6]; p.conv_w = (const float*)d_in[7];
  p.w_out = (const float*)d_in[8]; p.ln1_g = (const float*)d_in[9]; p.ln1_b = (const float*)d_in[10]; p.peer_wq = (const float*)d_in[11];
  p.peer_keys = (const float*)d_in[12]; p.peer_u = (const float*)d_in[13]; p.peer_v = (const float*)d_in[14];
  p.ln2_g = (const float*)d_in[15]; p.ln2_b = (const float*)d_in[16];
  p.out = (float*)d_out;
  char* w = (char*)d_ws; size_t off = 0;
  auto take = [&](size_t bytes) { char* r = w + off; off = al256(off + bytes); return r; };
  p.xres = (float*)take((size_t)TT * DM * 4);
  p.hA = (bf16_t*)take((size_t)TT * DM * 2);
  p.big = take((size_t)TT * 2048 * 4);
  p.cat = (bf16_t*)take((size_t)TT * DM * 2);
  p.st = (float*)take((size_t)2 * NCHUNK * 4 * 16384 * 4);
  p.ybuf = (float*)take((size_t)TT * DM * 4);
  p.w_inT = (bf16_t*)take((size_t)NLAYER * NPROJ * DM * 2);
  p.w_outT = (bf16_t*)take((size_t)NLAYER * DM * DM * 2);
  p.wkT = (bf16_t*)take((size_t)NLAYER * 2048 * DM * 2);
  p.ubf = (bf16_t*)take((size_t)NEXP * DM * 2);
  p.vbf = (bf16_t*)take((size_t)NEXP * DM * 2);
  p.mod = (float*)take((size_t)4 * 5 * 6144 * 4);
  p.modp = (float*)take((size_t)8 * 4 * 5 * 6144 * 4);
  p.ropec = (float*)take(128 * 32 * 4);
  p.ropes = (float*)take(128 * 32 * 4);
  p.bar = (unsigned*)take(XCD_BAR_WORDS * 4);
  p.pad0 = nullptr;
  {
    char* a = (char*)p.st; size_t o2 = 0;
    p.sv = (float*)(a + o2); o2 = al256(o2 + (size_t)TT * 256 * 4);
    p.si = (unsigned char*)(a + o2); o2 = al256(o2 + (size_t)TT * 256);
    p.pe = (int*)(a + o2); o2 = al256(o2 + (size_t)TT * 128 * 4);
    p.pg = (float*)(a + o2); o2 = al256(o2 + (size_t)TT * 128 * 4);
  }
  for (int d = 0; d < 2; ++d)
    for (int h = 0; h < 4; ++h) p.lg2[d][h] = (float)log2(1.0 - exp2(-(5.0 + 0.5 * d + (double)h)));
  if (off > ws_size) { fprintf(stderr, "kernel_launch: workspace too small: need %zu have %zu\n", off, ws_size); return; }

  (void)hipMemsetAsync(p.bar, 0, XCD_BAR_WORDS * 4, stream);
  void* args[] = {(void*)&p};
  hipError_t e = hipLaunchCooperativeKernel((const void*)k_mega, dim3(mgrid), dim3(256), args, SMEM_BYTES, stream);
  if (e != hipSuccess) fprintf(stderr, "kernel_launch: cooperative launch failed: %s (grid %d)\n", hipGetErrorString(e), mgrid);
}
```

```cpp
#include <hip/hip_runtime.h>
#include <hip/hip_cooperative_groups.h>
#include <stdint.h>
#include <math.h>
#include <stdio.h>
#include <utility>
#include <type_traits>

namespace cg = cooperative_groups;

typedef unsigned short bf16_t;
using bf16x8 = __attribute__((ext_vector_type(8))) short;
using s16x4 = __attribute__((ext_vector_type(4))) short;
using f32x4 = __attribute__((ext_vector_type(4))) float;
using u32x4 = __attribute__((ext_vector_type(4))) unsigned;

#define DM 1024
#define NB 4
#define SEQ 8192
#define TL 32768
#define TC 1024
#define TT 33792
#define NCHUNK 264
#define NPROJ 3584
#define NLAYER 4
#define NEXP 16384
#define ALPHA_F 1.681792830507429f
#define SMEM_BYTES 66576
#ifndef PROBE_MASK
#define PROBE_MASK 0
#endif

struct Params {
  const float *x, *c, *ctx, *c_ctx, *w_mod, *b_mod, *w_in, *conv_w, *w_out, *ln1_g, *ln1_b;
  const float *peer_wq, *peer_keys, *peer_u, *peer_v, *ln2_g, *ln2_b;
  float* out;
  float* xres; bf16_t* hA; char* big; bf16_t* cat; float* st; float* ybuf;
  bf16_t *w_inT, *w_outT, *wkT, *ubf, *vbf;
  float* sv; unsigned char* si; int* pe; float* pg;
  float *mod, *modp, *ropec, *ropes;
  unsigned* bar; unsigned* pad0;
  float lg2[2][4];
};

__device__ __forceinline__ bf16_t f2bf(float f) {
  uint32_t u = __float_as_uint(f);
  u += 0x7fffu + ((u >> 16) & 1u);
  return (bf16_t)(u >> 16);
}
__device__ __forceinline__ float bf2f(bf16_t b) { return __uint_as_float(((uint32_t)b) << 16); }
__device__ __forceinline__ uint32_t pack2(float a, float b) { return (uint32_t)f2bf(a) | ((uint32_t)f2bf(b) << 16); }
__device__ __forceinline__ float bflo(uint32_t w) { return __uint_as_float(w << 16); }
__device__ __forceinline__ float bfhi(uint32_t w) { return __uint_as_float(w & 0xffff0000u); }
__device__ __forceinline__ float wave_sum(float v) {
#pragma unroll
  for (int o = 32; o > 0; o >>= 1) v += __shfl_xor(v, o);
  return v;
}
__device__ __forceinline__ float row16_sum(float v) {
  v += __builtin_bit_cast(float, __builtin_amdgcn_update_dpp(0, __builtin_bit_cast(int, v), 0xB1, 0xF, 0xF, true));
  v += __builtin_bit_cast(float, __builtin_amdgcn_update_dpp(0, __builtin_bit_cast(int, v), 0x4E, 0xF, 0xF, true));
  v += __builtin_bit_cast(float, __builtin_amdgcn_update_dpp(0, __builtin_bit_cast(int, v), 0x141, 0xF, 0xF, true));
  v += __builtin_bit_cast(float, __builtin_amdgcn_update_dpp(0, __builtin_bit_cast(int, v), 0x140, 0xF, 0xF, true));
  return v;
}
__device__ __forceinline__ float silu_f(float v) { return v * __builtin_amdgcn_rcpf(1.f + __expf(-v)); }
__device__ __forceinline__ int mod_row(int t) { return t < TL ? (t >> 13) : 4; }

__device__ __forceinline__ f32x4 zero4() { f32x4 a = {0.f, 0.f, 0.f, 0.f}; asm volatile("" : "+v"(a)); return a; }

__device__ __forceinline__ int opaque_tid() { int t = threadIdx.x; asm volatile("" : "+v"(t)); return t; }
__device__ __forceinline__ int opaque_s(int v) { v = __builtin_amdgcn_readfirstlane(v); asm volatile("" : "+s"(v)); return v; }

template <class F, int... I>
__device__ __forceinline__ void static_for_impl(F&& f, std::integer_sequence<int, I...>) { (f(std::integral_constant<int, I>{}), ...); }
template <int N, class F>
__device__ __forceinline__ void static_for(F&& f) { static_for_impl(f, std::make_integer_sequence<int, N>{}); }

__device__ __forceinline__ unsigned tr_lane_base(unsigned base, unsigned ld, unsigned lane) {
  const unsigned g = lane >> 4, q = (lane & 15u) >> 2, p = lane & 3u;
  return base + (8u * g + q) * ld + 8u * p;
}
template <int O0, int O1, int O2, int O3, int D>
__device__ __forceinline__ void tr_frag4(unsigned a, bf16x8& f0, bf16x8& f1, bf16x8& f2, bf16x8& f3) {
  s16x4 r0, r1, r2, r3, r4, r5, r6, r7;
  asm volatile(
      "ds_read_b64_tr_b16 %0, %8 offset:%9\n\t"
      "ds_read_b64_tr_b16 %1, %8 offset:%10\n\t"
      "ds_read_b64_tr_b16 %2, %8 offset:%11\n\t"
      "ds_read_b64_tr_b16 %3, %8 offset:%12\n\t"
      "ds_read_b64_tr_b16 %4, %8 offset:%13\n\t"
      "ds_read_b64_tr_b16 %5, %8 offset:%14\n\t"
      "ds_read_b64_tr_b16 %6, %8 offset:%15\n\t"
      "ds_read_b64_tr_b16 %7, %8 offset:%16\n\t"
      "s_waitcnt lgkmcnt(0)"
      : "=&v"(r0), "=&v"(r1), "=&v"(r2), "=&v"(r3), "=&v"(r4), "=&v"(r5), "=&v"(r6), "=&v"(r7)
      : "v"(a), "n"(O0), "n"(O0 + D), "n"(O1), "n"(O1 + D), "n"(O2), "n"(O2 + D), "n"(O3), "n"(O3 + D)
      : "memory");
  f0 = __builtin_shufflevector(r0, r1, 0, 1, 2, 3, 4, 5, 6, 7);
  f1 = __builtin_shufflevector(r2, r3, 0, 1, 2, 3, 4, 5, 6, 7);
  f2 = __builtin_shufflevector(r4, r5, 0, 1, 2, 3, 4, 5, 6, 7);
  f3 = __builtin_shufflevector(r6, r7, 0, 1, 2, 3, 4, 5, 6, 7);
}

__device__ __forceinline__ void ph_mod_partial(const Params& p, int bid, int nb, char* smem) {
  const int TIX = opaque_tid(); bid = opaque_s(bid);
  float* sm = (float*)smem;
  const int tid = TIX;
  for (int item = bid; item < 4 * 24 * 8; item += nb) {
    const int ks = item & 7, cb = (item >> 3) % 24, l = item / 192;
    __syncthreads();
    for (int idx = tid; idx < 640; idx += 256) {
      const int r = idx >> 7, k = ks * 128 + (idx & 127);
      const float v = (r < 4) ? p.c[r * DM + k] : p.c_ctx[k];
      sm[idx] = silu_f(v);
    }
    __syncthreads();
    const int col = cb * 256 + tid;
    float acc[5] = {0.f, 0.f, 0.f, 0.f, 0.f};
    const float* w = p.w_mod + ((size_t)l * DM + ks * 128) * 6144 + col;
#pragma unroll 4
    for (int k = 0; k < 128; ++k) {
      const float wv = w[(size_t)k * 6144];
#pragma unroll
      for (int r = 0; r < 5; ++r) acc[r] += sm[r * 128 + k] * wv;
    }
#pragma unroll
    for (int r = 0; r < 5; ++r) p.modp[((size_t)(ks * 4 + l) * 5 + r) * 6144 + col] = acc[r];
  }
}

__device__ __forceinline__ void ph_mod_reduce(const Params& p, int bid, int nb) {
  const int TIX = opaque_tid(); bid = opaque_s(bid);
  const int gtid = bid * 256 + TIX, gn = nb * 256;
  for (int idx = gtid; idx < 4 * 5 * 6144; idx += gn) {
    const int l = idx / (5 * 6144), col = idx % 6144;
    float s = p.b_mod[l * 6144 + col];
#pragma unroll
    for (int ks = 0; ks < 8; ++ks) s += p.modp[(size_t)ks * (4 * 5 * 6144) + idx];
    p.mod[idx] = s;
  }
  for (int idx = gtid; idx < 128 * 32; idx += gn) {
    const int pos = idx >> 5, d = idx & 31;
    const float inv = exp2f(-(float)d * (13.287712379549449f / 32.f));
    const float angf = (float)pos * inv;
    const double a = (double)angf;
    const double kk = rint(a * 0.15915494309189535);
    const double r = a - kk * 6.283185307179586;
    const double r2 = r * r;
    double sn = 1.0, cs = 1.0;
    for (int n = 13; n >= 1; --n) {
      sn = 1.0 - sn * r2 / (double)((2 * n) * (2 * n + 1));
      cs = 1.0 - cs * r2 / (double)((2 * n - 1) * (2 * n));
    }
    p.ropec[idx] = (float)cs;
    p.ropes[idx] = (float)(r * sn);
  }
}

__device__ __forceinline__ void ph_transpose_cvt(const float* src, bf16_t* dst, int K, int N, int bid, int nb, char* smem) {
  const int TIX = opaque_tid(); bid = opaque_s(bid);
  float* tile = (float*)smem;
  const int tid = TIX;
  const int ntn = N >> 6, ntk = K >> 6;
  for (int item = bid; item < ntn * ntk; item += nb) {
    const int kt = item / ntn, nt = item % ntn;
    __syncthreads();
#pragma unroll
    for (int i = 0; i < 4; ++i) {
      const int r = (tid >> 4) + 16 * i, c4 = (tid & 15) * 4;
      const float4 v = *(const float4*)(src + (size_t)(kt * 64 + r) * N + nt * 64 + c4);
      tile[r * 65 + c4 + 0] = v.x; tile[r * 65 + c4 + 1] = v.y; tile[r * 65 + c4 + 2] = v.z; tile[r * 65 + c4 + 3] = v.w;
    }
    __syncthreads();
    const int n = tid >> 2, kseg = (tid & 3) * 16;
    uint32_t w[8];
#pragma unroll
    for (int e = 0; e < 8; ++e) w[e] = pack2(tile[(kseg + 2 * e) * 65 + n], tile[(kseg + 2 * e + 1) * 65 + n]);
    uint4* d = (uint4*)(dst + (size_t)(nt * 64 + n) * K + kt * 64 + kseg);
    d[0] = make_uint4(w[0], w[1], w[2], w[3]);
    d[1] = make_uint4(w[4], w[5], w[6], w[7]);
  }
}

__device__ __forceinline__ void ph_wk_fold(const Params& p, int bid, int nb, char* smem) {
  const int TIX = opaque_tid(); bid = opaque_s(bid);
  float* wq_s = (float*)smem;
  float* key_s = wq_s + 64 * 65;
  const int tid = TIX;
  const int tc = tid >> 4, tn = tid & 15;
  for (int item = bid; item < 4 * 16 * 16; item += nb) {
    const int ct = item & 15, hp = (item >> 4) & 15, l = item >> 8;
    float acc[4][8];
#pragma unroll
    for (int a = 0; a < 4; ++a)
#pragma unroll
      for (int b = 0; b < 8; ++b) acc[a][b] = 0.f;
    for (int dh = 0; dh < 2; ++dh) {
      __syncthreads();
#pragma unroll
      for (int i = 0; i < 4; ++i) {
        const int r = (tid >> 4) + 16 * i, c4 = (tid & 15) * 4;
        const float4 v = *(const float4*)(p.peer_wq + ((size_t)l * DM + ct * 64 + r) * 2048 + hp * 128 + dh * 64 + c4);
        wq_s[r * 65 + c4 + 0] = v.x; wq_s[r * 65 + c4 + 1] = v.y; wq_s[r * 65 + c4 + 2] = v.z; wq_s[r * 65 + c4 + 3] = v.w;
      }
#pragma unroll
      for (int i = 0; i < 8; ++i) {
        const int r = (tid >> 4) + 16 * i, c4 = (tid & 15) * 4;
        const float4 v = *(const float4*)(p.peer_keys + (((size_t)l * 2 + (hp & 1)) * 128 + r) * 128 + dh * 64 + c4);
        key_s[r * 65 + c4 + 0] = v.x; key_s[r * 65 + c4 + 1] = v.y; key_s[r * 65 + c4 + 2] = v.z; key_s[r * 65 + c4 + 3] = v.w;
      }
      __syncthreads();
#pragma unroll 4
      for (int d = 0; d < 64; ++d) {
        float av[4], bv[8];
#pragma unroll
        for (int a = 0; a < 4; ++a) av[a] = wq_s[(tc * 4 + a) * 65 + d];
#pragma unroll
        for (int b = 0; b < 8; ++b) bv[b] = key_s[(tn + 16 * b) * 65 + d];
#pragma unroll
        for (int a = 0; a < 4; ++a)
#pragma unroll
          for (int b = 0; b < 8; ++b) acc[a][b] += av[a] * bv[b];
      }
    }
#pragma unroll
    for (int b = 0; b < 8; ++b) {
      const int row = hp * 128 + tn + 16 * b;
      uint2 o;
      o.x = pack2(acc[0][b], acc[1][b]);
      o.y = pack2(acc[2][b], acc[3][b]);
      *(uint2*)(p.wkT + ((size_t)l * 2048 + row) * DM + ct * 64 + tc * 4) = o;
    }
  }
}

#define SCALE_U 128.f
#define SCALE_V 8.f
__device__ __forceinline__ uint32_t pack_fp8x4(float a, float b, float c, float d) {
  int w = 0;
  w = __builtin_amdgcn_cvt_pk_fp8_f32(a, b, w, false);
  w = __builtin_amdgcn_cvt_pk_fp8_f32(c, d, w, true);
  return (uint32_t)w;
}
#define QSCALE_U 512.f
__device__ __forceinline__ uint32_t pack_i8x4(float a, float b, float c, float d) {
  const int qa = max(-127, min(127, __float2int_rn(a))), qb = max(-127, min(127, __float2int_rn(b)));
  const int qc = max(-127, min(127, __float2int_rn(c))), qd = max(-127, min(127, __float2int_rn(d)));
  return (uint32_t)(qa & 255) | ((uint32_t)(qb & 255) << 8) | ((uint32_t)(qc & 255) << 16) | ((uint32_t)(qd & 255) << 24);
}
__device__ __forceinline__ void cvt_uv_unit(const Params& p, int l, size_t i) {
  const size_t n16 = (size_t)NEXP * DM / 16;
  const bool isv = i >= n16;
  const size_t j = isv ? i - n16 : i;
  const float sc = SCALE_V;
  const float4* s4 = (const float4*)((isv ? p.peer_v : p.peer_u) + (size_t)l * NEXP * DM + j * 16);
  const float4 a0 = s4[0], a1 = s4[1], a2 = s4[2], a3 = s4[3];
  uint4 o;
  if (isv) {
    o.x = pack_fp8x4(a0.x * sc, a0.y * sc, a0.z * sc, a0.w * sc);
    o.y = pack_fp8x4(a1.x * sc, a1.y * sc, a1.z * sc, a1.w * sc);
    o.z = pack_fp8x4(a2.x * sc, a2.y * sc, a2.z * sc, a2.w * sc);
    o.w = pack_fp8x4(a3.x * sc, a3.y * sc, a3.z * sc, a3.w * sc);
  } else {
    o.x = pack_i8x4(a0.x * QSCALE_U, a0.y * QSCALE_U, a0.z * QSCALE_U, a0.w * QSCALE_U);
    o.y = pack_i8x4(a1.x * QSCALE_U, a1.y * QSCALE_U, a1.z * QSCALE_U, a1.w * QSCALE_U);
    o.z = pack_i8x4(a2.x * QSCALE_U, a2.y * QSCALE_U, a2.z * QSCALE_U, a2.w * QSCALE_U);
    o.w = pack_i8x4(a3.x * QSCALE_U, a3.y * QSCALE_U, a3.z * QSCALE_U, a3.w * QSCALE_U);
  }
  *(uint4*)((unsigned char*)(isv ? p.vbf : p.ubf) + j * 16) = o;
}
#define CVT_UNITS ((size_t)2 * NEXP * DM / 16)

__device__ __forceinline__ void ph_init_h(const Params& p, int bid, int nb) {
  const int TIX = opaque_tid(); bid = opaque_s(bid);
  const int lane = TIX & 63;
  const int gw = bid * 4 + (TIX >> 6), nw = nb * 4;
  float4 psh[4], psc[4], xc[4];
  int cur_row = -1;
#define IH_FETCH(T, X) { const float* xr_ = ((T) < TL ? p.x + (size_t)(T) * DM : p.ctx + (size_t)((T) - TL) * DM) + lane * 16; \
    _Pragma("unroll") for (int i = 0; i < 4; ++i) X[i] = *(const float4*)(xr_ + 4 * i); }
  if (gw < TT) IH_FETCH(gw, xc)
  for (int t = gw; t < TT; t += nw) {
    float4 xn[4] = {xc[0], xc[1], xc[2], xc[3]};
    if (t + nw < TT) IH_FETCH(t + nw, xn)
    const int mr = mod_row(t);
    if (mr != cur_row) {
      cur_row = mr;
      const float* m = p.mod + (size_t)(0 * 5 + mr) * 6144 + lane * 16;
#pragma unroll
      for (int i = 0; i < 4; ++i) { psh[i] = *(const float4*)(m + 4 * i); psc[i] = *(const float4*)(m + 1024 + 4 * i); }
    }
    uint32_t o[8];
#pragma unroll
    for (int i = 0; i < 4; ++i) {
      const float4 v = xc[i], sh = psh[i], sc = psc[i];
      o[2 * i] = pack2(v.x * (1.f + sc.x) + sh.x, v.y * (1.f + sc.y) + sh.y);
      o[2 * i + 1] = pack2(v.z * (1.f + sc.z) + sh.z, v.w * (1.f + sc.w) + sh.w);
    }
    bf16_t* hd = p.hA + (size_t)t * DM + lane * 16;
    *(uint4*)hd = make_uint4(o[0], o[1], o[2], o[3]);
    *(uint4*)(hd + 8) = make_uint4(o[4], o[5], o[6], o[7]);
#pragma unroll
    for (int i = 0; i < 4; ++i) xc[i] = xn[i];
  }
#undef IH_FETCH
}

__device__ __forceinline__ void gemm_tile_acc(const bf16_t* __restrict__ A, const bf16_t* __restrict__ Bt, int K, int m0, int n0,
                                              char* smem, int tid, f32x4 (&acc)[4][4]) {
  const int lane = tid & 63, wave = opaque_s(tid >> 6);
  const int wm = wave >> 1, wn = wave & 1;
  const int g = lane >> 4, l15 = lane & 15;
  const int nt = K >> 6;
#pragma unroll
  for (int i = 0; i < 4; ++i)
#pragma unroll
    for (int j = 0; j < 4; ++j) acc[i][j] = zero4();
  const int sb = lane * 16, swz = sb ^ (((sb >> 9) & 1) << 5);
  const int R0 = (wave >> 1) * 16 + (swz >> 6), C0 = (wave & 1) * 32 + ((swz & 63) >> 1);
  const bf16_t* ga = A + (size_t)(m0 + R0) * K + C0;
  const bf16_t* gb = Bt + (size_t)(n0 + R0) * K + C0;
  char* stA = smem + wave * 1024;
  char* stB = smem + 16384 + wave * 1024;
  const int fl = l15 * 64 + ((g * 16) ^ ((l15 >> 3) << 5));
  const char* rdA = smem + fl + wm * 8192;
  const char* rdB = smem + 16384 + fl + wn * 8192;
#define GLDS_STAGE(BUF, KT) do { _Pragma("unroll") for (int i_ = 0; i_ < 4; ++i_) {                                                        \
    __builtin_amdgcn_global_load_lds((const unsigned*)(ga + (size_t)(32 * i_) * K + (KT) * 64), (unsigned*)(stA + (BUF) * 32768 + i_ * 4096), 16, 0, 0); \
    __builtin_amdgcn_global_load_lds((const unsigned*)(gb + (size_t)(32 * i_) * K + (KT) * 64), (unsigned*)(stB + (BUF) * 32768 + i_ * 4096), 16, 0, 0); } } while (0)
  __syncthreads();
  GLDS_STAGE(0, 0);
  asm volatile("s_waitcnt vmcnt(0)" ::: "memory");
  __syncthreads();
  if (nt > 1) GLDS_STAGE(1, 1);
  bf16x8 af0[4], bf0[4], af1[4], bf1[4];
#pragma unroll
  for (int i = 0; i < 4; ++i) af0[i] = *(const bf16x8*)(rdA + (i * 2) * 1024);
#pragma unroll
  for (int j = 0; j < 4; ++j) bf0[j] = *(const bf16x8*)(rdB + (j * 2) * 1024);
  for (int t = 0; t < nt; ++t) {
    const int cur = t & 1;
    acc[0][0] = __builtin_amdgcn_mfma_f32_16x16x32_bf16(af0[0], bf0[0], acc[0][0], 0, 0, 0);
    __builtin_amdgcn_sched_barrier(0);
#pragma unroll
    for (int i = 0; i < 4; ++i) af1[i] = *(const bf16x8*)(rdA + cur * 32768 + (i * 2 + 1) * 1024);
#pragma unroll
    for (int j = 0; j < 4; ++j) bf1[j] = *(const bf16x8*)(rdB + cur * 32768 + (j * 2 + 1) * 1024);
    __builtin_amdgcn_sched_barrier(0);
#pragma unroll
    for (int i = 0; i < 4; ++i)
#pragma unroll
      for (int j = 0; j < 4; ++j)
        if (i | j) acc[i][j] = __builtin_amdgcn_mfma_f32_16x16x32_bf16(af0[i], bf0[j], acc[i][j], 0, 0, 0);
    __builtin_amdgcn_sched_barrier(0);
    asm volatile("s_waitcnt vmcnt(0)" ::: "memory");
    __syncthreads();
    if (t + 2 < nt) GLDS_STAGE(cur, t + 2);
    if (t + 1 < nt) {
#pragma unroll
      for (int i = 0; i < 4; ++i) af0[i] = *(const bf16x8*)(rdA + (cur ^ 1) * 32768 + (i * 2) * 1024);
#pragma unroll
      for (int j = 0; j < 4; ++j) bf0[j] = *(const bf16x8*)(rdB + (cur ^ 1) * 32768 + (j * 2) * 1024);
    }
    __builtin_amdgcn_sched_barrier(0);
#pragma unroll
    for (int i = 0; i < 4; ++i)
#pragma unroll
      for (int j = 0; j < 4; ++j) acc[i][j] = __builtin_amdgcn_mfma_f32_16x16x32_bf16(af1[i], bf1[j], acc[i][j], 0, 0, 0);
    __builtin_amdgcn_sched_barrier(0);
  }
#undef GLDS_STAGE
}

template <int MX, int NX>
__device__ __forceinline__ bool xcd_tile(int bid, int nb, int k, int ntm, int ntn, int& m, int& n) {
  if ((nb & 7) || (ntm % MX) || (ntn % NX)) {
    const int t = bid + k * nb;
    if (t >= ntm * ntn) return false;
    m = t / ntn; n = t % ntn; return true;
  }
  const int x = bid & 7, q = bid >> 3, nq = nb >> 3;
  const int nloc = ntn / NX, per_x = (ntm / MX) * nloc;
  const int j = q + k * nq;
  if (j >= per_x) return false;
  m = (j / nloc) * MX + (x % MX); n = (j % nloc) * NX + (x / MX);
  return true;
}

__device__ __forceinline__ bool xcd_pair_item(int bid, int nb, int k, int npairs, int& pair, int& sub) {
  if ((nb & 7) || (npairs & 7)) {
    const int t = bid + k * nb;
    if (t >= npairs * 2) return false;
    pair = t >> 1; sub = t & 1; return true;
  }
  const int x = bid & 7, q = bid >> 3, nq = nb >> 3;
  const int j = q + k * nq;
  if (j >= (npairs >> 3) * 2) return false;
  pair = (j >> 1) * 8 + x; sub = j & 1;
  return true;
}

template <bool OUT_BF16>
__device__ __forceinline__ void ph_gemm(const bf16_t* __restrict__ A, const bf16_t* __restrict__ Bt, void* Cout, int M, int N, int K,
                        int bid, int nb, char* smem) {
  const int TIX = opaque_tid(); bid = opaque_s(bid);
  const int tid = TIX, lane = tid & 63, wave = tid >> 6;
  const int wm = wave >> 1, wn = wave & 1;
  const int ntn = N >> 7, ntm = M >> 7;
  for (int k = 0;; ++k) {
    int tm, tn;
    if (!xcd_tile<8, 1>(bid, nb, k, ntm, ntn, tm, tn)) break;
    const int m0 = tm << 7, n0 = tn << 7;
    f32x4 acc[4][4];
    gemm_tile_acc(A, Bt, K, m0, n0, smem, tid, acc);
#pragma unroll
    for (int i = 0; i < 4; ++i)
#pragma unroll
      for (int j = 0; j < 4; ++j)
#pragma unroll
        for (int r = 0; r < 4; ++r) {
          const int row = m0 + wm * 64 + i * 16 + (lane >> 4) * 4 + r;
          const int col = n0 + wn * 64 + j * 16 + (lane & 15);
          if (OUT_BF16) ((bf16_t*)Cout)[(size_t)row * N + col] = f2bf(acc[i][j][r]);
          else ((float*)Cout)[(size_t)row * N + col] = acc[i][j][r];
        }
  }
}

__device__ __forceinline__ void ph_gemm_in(const Params& p, int l, int bid, int nb, char* smem) {
  const int TIX = opaque_tid(); bid = opaque_s(bid);
  const int tid = TIX, lane = tid & 63, wave = tid >> 6;
  const int wm = wave >> 1, wn = wave & 1;
  const int g = lane >> 4, l15 = lane & 15;
  bf16_t* proj = (bf16_t*)p.big;
  const bf16_t* Bt = p.w_inT + (size_t)l * NPROJ * DM;
  constexpr int ntn = NPROJ >> 7;
  for (int k = 0;; ++k) {
    int tm, nt;
    if (!xcd_tile<2, 4>(bid, nb, k, TT >> 7, ntn, tm, nt)) break;
    const int m0 = tm << 7, n0 = nt << 7;
    {
      const size_t cu = (size_t)(bid + k * nb) * 512 + tid;
      if (cu < CVT_UNITS) cvt_uv_unit(p, l, cu);
      if (cu + 256 < CVT_UNITS) cvt_uv_unit(p, l, cu + 256);
    }
    if (l == NLAYER - 1 && m0 >= TL && (nt < 16 || nt >= 24)) continue;
    f32x4 acc[4][4];
    gemm_tile_acc(p.hA, Bt, DM, m0, n0, smem, tid, acc);
    if (nt >= 12 && nt < 20) {
      const float scl = (nt >= 16) ? 0.08838834764831845f : 1.f;
      if (m0 < TL) {
#pragma unroll
        for (int i = 0; i < 4; ++i)
#pragma unroll
          for (int r = 0; r < 4; ++r) {
            const int ii = (m0 + wm * 64 + i * 16 + g * 4 + r) & 8191;
            const int pos = wn ? (ii & 63) : (ii >> 6);
#pragma unroll
            for (int jj = 0; jj < 2; ++jj) {
              const float cs = p.ropec[pos * 32 + jj * 16 + l15], sn = p.ropes[pos * 32 + jj * 16 + l15];
              const float a = acc[i][jj][r], b = acc[i][jj + 2][r];
              acc[i][jj][r] = (a * cs - b * sn) * scl;
              acc[i][jj + 2][r] = (a * sn + b * cs) * scl;
            }
          }
      } else if (nt >= 16) {
#pragma unroll
        for (int i = 0; i < 4; ++i)
#pragma unroll
          for (int j = 0; j < 4; ++j)
#pragma unroll
            for (int r = 0; r < 4; ++r) acc[i][j][r] *= scl;
      }
    }
#pragma unroll
    for (int i = 0; i < 4; ++i)
#pragma unroll
      for (int j = 0; j < 4; ++j)
#pragma unroll
        for (int r = 0; r < 4; ++r) {
          const int row = m0 + wm * 64 + i * 16 + g * 4 + r;
          const int col = n0 + wn * 64 + j * 16 + l15;
          proj[(size_t)row * NPROJ + col] = f2bf(acc[i][j][r]);
        }
  }
}

__device__ __forceinline__ void ph_ret_upd(const Params& p, int bid, int nb, char* smem) {
  const int TIX = opaque_tid(); bid = opaque_s(bid);
  const bf16_t* proj = (const bf16_t*)p.big;
  bf16_t* Vs = (bf16_t*)smem;
  bf16_t* Ks = Vs + 64 * 136;
  const int tid = TIX, lane = tid & 63, wave = tid >> 6;
  const int wm = wave >> 1, wn = wave & 1;
  const unsigned va = tr_lane_base((unsigned)(size_t)Vs, 272u, lane) + wm * 128;
  const unsigned ka = tr_lane_base((unsigned)(size_t)Ks, 272u, lane) + wn * 128;
  const int sr = tid >> 4, sck = (tid & 15) * 8;
  for (int k = 0;; ++k) {
    int pr, dir;
    if (!xcd_pair_item(bid, nb, k, NCHUNK * 4, pr, dir)) break;
    const int c = pr >> 2, hd = pr & 3;
    const int t0 = c * 128;
    const float lg = p.lg2[dir][hd];
    const bf16_t* src = proj + (size_t)(t0 + sr) * NPROJ + hd * 128 + sck;
    u32x4 rv[4], rk[4];
#pragma unroll
    for (int i = 0; i < 4; ++i) {
      rv[i] = *(const u32x4*)(src + 2560 + (size_t)(16 * i) * NPROJ);
      rk[i] = *(const u32x4*)(src + 2048 + (size_t)(16 * i) * NPROJ);
    }
    f32x4 acc[4][4];
#pragma unroll
    for (int i = 0; i < 4; ++i)
#pragma unroll
      for (int j = 0; j < 4; ++j) acc[i][j] = zero4();
#pragma unroll
    for (int half = 0; half < 2; ++half) {
      __syncthreads();
#pragma unroll
      for (int i = 0; i < 4; ++i) {
        const int r = sr + 16 * i, sp = half * 64 + r;
        const float w = exp2f((dir == 0 ? (float)(127 - sp) : (float)sp) * lg);
        u32x4 ko;
#pragma unroll
        for (int q = 0; q < 4; ++q) ko[q] = pack2(bflo(rk[i][q]) * w, bfhi(rk[i][q]) * w);
        *(u32x4*)(Vs + r * 136 + sck) = rv[i];
        *(u32x4*)(Ks + r * 136 + sck) = ko;
      }
      __syncthreads();
      if (half == 0) {
#pragma unroll
        for (int i = 0; i < 4; ++i) {
          rv[i] = *(const u32x4*)(src + 2560 + (size_t)(64 + 16 * i) * NPROJ);
          rk[i] = *(const u32x4*)(src + 2048 + (size_t)(64 + 16 * i) * NPROJ);
        }
      }
      static_for<2>([&](auto KS) {
        constexpr int ks = decltype(KS)::value;
        bf16x8 af[4], bfr[4];
        tr_frag4<ks * 32 * 272 + 0, ks * 32 * 272 + 32, ks * 32 * 272 + 64, ks * 32 * 272 + 96, 4 * 272>(va, af[0], af[1], af[2], af[3]);
        tr_frag4<ks * 32 * 272 + 0, ks * 32 * 272 + 32, ks * 32 * 272 + 64, ks * 32 * 272 + 96, 4 * 272>(ka, bfr[0], bfr[1], bfr[2], bfr[3]);
#pragma unroll
        for (int i = 0; i < 4; ++i)
#pragma unroll
          for (int j = 0; j < 4; ++j) acc[i][j] = __builtin_amdgcn_mfma_f32_16x16x32_bf16(bfr[j], af[i], acc[i][j], 0, 0, 0);
      });
    }
    bf16_t* dst = (bf16_t*)p.st + ((size_t)(dir * NCHUNK + c) * 4 + hd) * 16384;
#pragma unroll
    for (int i = 0; i < 4; ++i)
#pragma unroll
      for (int j = 0; j < 4; ++j) {
        const int row = wm * 64 + i * 16 + (lane & 15);
        const int col = wn * 64 + j * 16 + (lane >> 4) * 4;
        uint2 o; o.x = pack2(acc[i][j][0], acc[i][j][1]); o.y = pack2(acc[i][j][2], acc[i][j][3]);
        *(uint2*)(dst + row * 128 + col) = o;
      }
  }
}

__device__ __forceinline__ void ph_ret_scan(const Params& p, int bid, int nb) {
  const int TIX = opaque_tid(); bid = opaque_s(bid);
  const int gtid = bid * 256 + TIX, gn = nb * 256;
  bf16_t* sout = (bf16_t*)p.ybuf;
  for (int idx = gtid; idx < 2 * 4 * 4 * 8192; idx += gn) {
    const int e = (idx & 8191) * 2, hd = (idx >> 13) & 3, b = (idx >> 15) & 3, dir = idx >> 17;
    const float dc = exp2f(128.f * p.lg2[dir][hd]);
    const size_t boff = (size_t)dir * NCHUNK * 4 * 16384 + (size_t)hd * 16384 + e;
    const bf16_t* __restrict__ src = (const bf16_t*)p.st + boff;
    bf16_t* __restrict__ dst = sout + boff;
    const size_t cs = (size_t)4 * 16384;
    float c0 = 0.f, c1 = 0.f;
    {
      const size_t o0 = (size_t)(256 + b * 2 + (dir ? 1 : 0)) * cs, o1 = (size_t)(256 + b * 2 + (dir ? 0 : 1)) * cs;
      const uint32_t u0 = *(const uint32_t*)(src + o0), u1 = *(const uint32_t*)(src + o1);
      *(uint32_t*)(dst + o0) = pack2(c0, c1); c0 = c0 * dc + bflo(u0); c1 = c1 * dc + bfhi(u0);
      *(uint32_t*)(dst + o1) = pack2(c0, c1); c0 = c0 * dc + bflo(u1); c1 = c1 * dc + bfhi(u1);
    }
    for (int n0 = 0; n0 < 64; n0 += 16) {
      uint32_t u[16];
#pragma unroll
      for (int i = 0; i < 16; ++i) {
        const int n = dir ? (63 - (n0 + i)) : (n0 + i);
        u[i] = *(const uint32_t*)(src + (size_t)(b * 64 + n) * cs);
      }
#pragma unroll
      for (int i = 0; i < 16; ++i) {
        const int n = dir ? (63 - (n0 + i)) : (n0 + i);
        *(uint32_t*)(dst + (size_t)(b * 64 + n) * cs) = pack2(c0, c1);
        c0 = c0 * dc + bflo(u[i]); c1 = c1 * dc + bfhi(u[i]);
      }
    }
  }
}

__device__ __forceinline__ void ph_ret_out(const Params& p, int l, int bid, int nb, char* smem) {
  const int TIX = opaque_tid(); bid = opaque_s(bid);
  const bf16_t* proj = (const bf16_t*)p.big;
  const bf16_t* sin = (const bf16_t*)p.ybuf;
  bf16_t* buf = (bf16_t*)smem;
  bf16_t* Pb = buf + 128 * 136;
  const int tid = TIX, lane = tid & 63, wave = tid >> 6;
  const unsigned ba = tr_lane_base((unsigned)(size_t)buf, 272u, lane);
  const int g = lane >> 4, l15 = lane & 15;
  bf16_t* Pw = Pb + wave * 16 * 136;
  const int sr = tid >> 4, sck = (tid & 15) * 8;
  const int nitem_ro = ((l == NLAYER - 1) ? 256 : NCHUNK) * 8;
  for (int k = 0;; ++k) {
    int pr, rh;
    if (!xcd_pair_item(bid, nb, k, nitem_ro >> 1, pr, rh)) break;
    const int c = pr >> 2, hd = pr & 3;
    const int t0 = c * 128;
    const int rw = rh * 64 + wave * 16;
    const float lgf = p.lg2[0][hd], lgb = p.lg2[1][hd];
    bf16x8 qf[4];
#pragma unroll
    for (int ks = 0; ks < 4; ++ks)
      qf[ks] = *(const bf16x8*)(proj + (size_t)(t0 + rw + l15) * NPROJ + 1536 + hd * 128 + ks * 32 + g * 8);
    u32x4 ra[8], rb[8];
    const bf16_t* kv = proj + (size_t)(t0 + sr) * NPROJ + hd * 128 + sck;
#pragma unroll
    for (int i = 0; i < 8; ++i) ra[i] = *(const u32x4*)(kv + 2048 + (size_t)(16 * i) * NPROJ);
#pragma unroll
    for (int i = 0; i < 8; ++i) rb[i] = *(const u32x4*)(kv + 2560 + (size_t)(16 * i) * NPROJ);
    const bf16_t* sf = sin + ((size_t)(0 * NCHUNK + c) * 4 + hd) * 16384 + sr * 128 + sck;
    const bf16_t* sb = sin + ((size_t)(1 * NCHUNK + c) * 4 + hd) * 16384 + sr * 128 + sck;
    __syncthreads();
#pragma unroll
    for (int i = 0; i < 8; ++i) *(u32x4*)(buf + (sr + 16 * i) * 136 + sck) = ra[i];
    __syncthreads();
#pragma unroll
    for (int i = 0; i < 8; ++i) ra[i] = *(const u32x4*)(sf + (size_t)(16 * i) * 128);
    f32x4 acc[8];
#pragma unroll
    for (int nt = 0; nt < 8; ++nt) acc[nt] = zero4();
#pragma unroll
    for (int ks = 0; ks < 4; ++ks) {
#pragma unroll
      for (int nt = 0; nt < 8; ++nt) {
        const bf16x8 bfr = *(const bf16x8*)(buf + (nt * 16 + l15) * 136 + ks * 32 + g * 8);
        acc[nt] = __builtin_amdgcn_mfma_f32_16x16x32_bf16(qf[ks], bfr, acc[nt], 0, 0, 0);
      }
    }
#pragma unroll
    for (int nt = 0; nt < 8; ++nt)
#pragma unroll
      for (int r = 0; r < 4; ++r) {
        const int tl = g * 4 + r;
        const int t = rw + tl, s2 = nt * 16 + l15;
        const float d = (s2 <= t) ? exp2f((float)(t - s2) * lgf) : exp2f((float)(s2 - t) * lgb);
        Pw[tl * 136 + s2] = f2bf(acc[nt][r] * d);
      }
    __syncthreads();
#pragma unroll
    for (int i = 0; i < 8; ++i) *(u32x4*)(buf + (sr + 16 * i) * 136 + sck) = rb[i];
    __syncthreads();
#pragma unroll
    for (int i = 0; i < 8; ++i) rb[i] = *(const u32x4*)(sb + (size_t)(16 * i) * 128);
    f32x4 o[8];
#pragma unroll
    for (int nt = 0; nt < 8; ++nt) o[nt] = zero4();
    static_for<4>([&](auto KS) {
      constexpr int ks = decltype(KS)::value;
      const bf16x8 pf = *(const bf16x8*)(Pw + l15 * 136 + ks * 32 + g * 8);
      static_for<2>([&](auto NH) {
        constexpr int nh = decltype(NH)::value;
        bf16x8 bfr[4];
        tr_frag4<ks * 32 * 272 + nh * 128 + 0, ks * 32 * 272 + nh * 128 + 32, ks * 32 * 272 + nh * 128 + 64, ks * 32 * 272 + nh * 128 + 96, 4 * 272>(
            ba, bfr[0], bfr[1], bfr[2], bfr[3]);
#pragma unroll
        for (int j = 0; j < 4; ++j) o[nh * 4 + j] = __builtin_amdgcn_mfma_f32_16x16x32_bf16(pf, bfr[j], o[nh * 4 + j], 0, 0, 0);
      });
    });
#define RO_CROSS(DIRV, REG)                                                                                     \
    {                                                                                                           \
      __syncthreads();                                                                                          \
      _Pragma("unroll") for (int i = 0; i < 8; ++i) *(u32x4*)(buf + (sr + 16 * i) * 136 + sck) = REG[i];        \
      __syncthreads();                                                                                          \
      float fr[4];                                                                                              \
      _Pragma("unroll") for (int r = 0; r < 4; ++r) {                                                           \
        const int t = rw + g * 4 + r;                                                                           \
        fr[r] = (DIRV == 0) ? exp2f((float)(t + 1) * lgf) : exp2f((float)(128 - t) * lgb);                      \
      }                                                                                                         \
      _Pragma("unroll") for (int nt = 0; nt < 8; ++nt) acc[nt] = zero4();                                       \
      _Pragma("unroll") for (int ks = 0; ks < 4; ++ks) {                                                        \
        _Pragma("unroll") for (int nt = 0; nt < 8; ++nt) {                                                      \
          const bf16x8 bfr = *(const bf16x8*)(buf + (nt * 16 + l15) * 136 + ks * 32 + g * 8);                   \
          acc[nt] = __builtin_amdgcn_mfma_f32_16x16x32_bf16(qf[ks], bfr, acc[nt], 0, 0, 0);                     \
        }                                                                                                       \
      }                                                                                                         \
      _Pragma("unroll") for (int r = 0; r < 4; ++r)                                                             \
        _Pragma("unroll") for (int nt = 0; nt < 8; ++nt) o[nt][r] += fr[r] * acc[nt][r];                        \
    }
    RO_CROSS(0, ra)
    RO_CROSS(1, rb)
#undef RO_CROSS
#pragma unroll
    for (int r = 0; r < 4; ++r) {
      const int t = t0 + rw + g * 4 + r;
#pragma unroll
      for (int nt = 0; nt < 8; ++nt) p.cat[(size_t)t * DM + 512 + hd * 128 + nt * 16 + l15] = f2bf(o[nt][r]);
    }
  }
}

__device__ __forceinline__ void ph_gnorm(const Params& p, int l, int bid, int nb) {
  const int TIX = opaque_tid(); bid = opaque_s(bid);
  const bf16_t* proj = (const bf16_t*)p.big;
  const int lane = TIX & 63;
  const int gw = bid * 4 + (TIX >> 6), nw = nb * 4;
  const float* cw = p.conv_w + ((size_t)l * 512 + lane * 8) * 3;
  float cwv[24];
#pragma unroll
  for (int i = 0; i < 24; ++i) cwv[i] = cw[i];
  const int tend = (l == NLAYER - 1) ? TL : TT;
  struct GnRaw { uint4 bg, c0, c1, c2, h0, h1, h2, ov, gv; };
  auto fetch = [&](int t, GnRaw& r) {
    const bf16_t* row = proj + (size_t)t * NPROJ;
    const int ch = lane * 8;
    bool hasl, hasr;
    if (t < TL) { const int i = t & 63; hasl = i != 0; hasr = i != 63; }
    else { const int i = (t - TL) & 255; hasl = i != 0; hasr = i != 255; }
    r.bg = *(const uint4*)(row + ch);
    r.c1 = *(const uint4*)(row + 512 + ch); r.h1 = *(const uint4*)(row + 1024 + ch);
    r.c0 = make_uint4(0, 0, 0, 0); r.h0 = r.c0; r.c2 = r.c0; r.h2 = r.c0;
    if (hasl) { r.c0 = *(const uint4*)(row - NPROJ + 512 + ch); r.h0 = *(const uint4*)(row - NPROJ + 1024 + ch); }
    if (hasr) { r.c2 = *(const uint4*)(row + NPROJ + 512 + ch); r.h2 = *(const uint4*)(row + NPROJ + 1024 + ch); }
    r.ov = *(const uint4*)(p.cat + (size_t)t * DM + 512 + lane * 8);
    r.gv = *(const uint4*)(row + 3072 + lane * 8);
  };
  GnRaw cur;
  if (gw < tend) fetch(gw, cur);
  for (int t = gw; t < tend; t += nw) {
    GnRaw nxt = cur;
    if (t + nw < tend) fetch(t + nw, nxt);
    {
      const int ch = lane * 8;
      const uint4 bg = cur.bg, c0 = cur.c0, c1 = cur.c1, c2 = cur.c2, h0 = cur.h0, h1 = cur.h1, h2 = cur.h2;
      const uint32_t bgw[4] = {bg.x, bg.y, bg.z, bg.w};
      const uint32_t c0w[4] = {c0.x, c0.y, c0.z, c0.w}, c1w[4] = {c1.x, c1.y, c1.z, c1.w}, c2w[4] = {c2.x, c2.y, c2.z, c2.w};
      const uint32_t h0w[4] = {h0.x, h0.y, h0.z, h0.w}, h1w[4] = {h1.x, h1.y, h1.z, h1.w}, h2w[4] = {h2.x, h2.y, h2.z, h2.w};
      uint32_t ow[4];
#pragma unroll
      for (int e = 0; e < 4; ++e) {
        const float z0a = bflo(c0w[e]) * bflo(h0w[e]), z1a = bflo(c1w[e]) * bflo(h1w[e]), z2a = bflo(c2w[e]) * bflo(h2w[e]);
        const float z0b = bfhi(c0w[e]) * bfhi(h0w[e]), z1b = bfhi(c1w[e]) * bfhi(h1w[e]), z2b = bfhi(c2w[e]) * bfhi(h2w[e]);
        const float ya = z0a * cwv[6 * e + 0] + z1a * cwv[6 * e + 1] + z2a * cwv[6 * e + 2];
        const float yb = z0b * cwv[6 * e + 3] + z1b * cwv[6 * e + 4] + z2b * cwv[6 * e + 5];
        ow[e] = pack2(bflo(bgw[e]) * ya, bfhi(bgw[e]) * yb);
      }
      *(uint4*)(p.cat + (size_t)t * DM + ch) = make_uint4(ow[0], ow[1], ow[2], ow[3]);
    }
    bf16_t* op = p.cat + (size_t)t * DM + 512 + lane * 8;
    const uint4 ov = cur.ov;
    const uint4 gv = cur.gv;
    float o[8], gg[8];
    o[0] = bflo(ov.x); o[1] = bfhi(ov.x); o[2] = bflo(ov.y); o[3] = bfhi(ov.y);
    o[4] = bflo(ov.z); o[5] = bfhi(ov.z); o[6] = bflo(ov.w); o[7] = bfhi(ov.w);
    gg[0] = bflo(gv.x); gg[1] = bfhi(gv.x); gg[2] = bflo(gv.y); gg[3] = bfhi(gv.y);
    gg[4] = bflo(gv.z); gg[5] = bfhi(gv.z); gg[6] = bflo(gv.w); gg[7] = bfhi(gv.w);
    float s1 = 0.f;
#pragma unroll
    for (int i = 0; i < 8; ++i) s1 += o[i];
    s1 = row16_sum(s1);
    const float mu = s1 * (1.f / 128.f);
    float s2 = 0.f;
#pragma unroll
    for (int i = 0; i < 8; ++i) { const float d = o[i] - mu; s2 += d * d; }
    s2 = row16_sum(s2);
    const float rs = rsqrtf(s2 * (1.f / 128.f) + 1e-5f);
    float y[8];
#pragma unroll
    for (int i = 0; i < 8; ++i) y[i] = silu_f(gg[i]) * (o[i] - mu) * rs;
    *(uint4*)op = make_uint4(pack2(y[0], y[1]), pack2(y[2], y[3]), pack2(y[4], y[5]), pack2(y[6], y[7]));
    cur = nxt;
  }
}

__device__ __forceinline__ void ph_ln(const Params& p, int l, int which, int bid, int nb) {
  const int TIX = opaque_tid(); bid = opaque_s(bid);
  const int lane = TIX & 63;
  const int gw = bid * 4 + (TIX >> 6), nw = nb * 4;
  const bool last = (l == NLAYER - 1);
  const int tend = last ? TL : TT;
  bf16_t* xres = (bf16_t*)p.xres;
  const bf16_t* ybf = (const bf16_t*)p.ybuf;
  (void)which;
  float4 pgg[4], pbb[4], pgv[4], psh[4], psc[4];
#pragma unroll
  for (int i = 0; i < 4; ++i) {
    pgg[i] = *(const float4*)(p.ln1_g + (size_t)l * DM + lane * 16 + 4 * i);
    pbb[i] = *(const float4*)(p.ln1_b + (size_t)l * DM + lane * 16 + 4 * i);
    pgv[i] = pgg[i]; psh[i] = pgg[i]; psc[i] = pgg[i];
  }
  int cur_row = -1;
  uint4 xa, xb, ya, yb;
  float4 xf[4];
#define LN_FETCH(T, XA, XB, YA, YB, XF) {                                                                                       \
    if (l == 0) { const float* xs_ = ((T) < TL ? p.x + (size_t)(T) * DM : p.ctx + (size_t)((T) - TL) * DM) + lane * 16;        \
      _Pragma("unroll") for (int i = 0; i < 4; ++i) XF[i] = *(const float4*)(xs_ + 4 * i); }                                     \
    else { const bf16_t* xs_ = xres + (size_t)(T) * DM + lane * 16; XA = *(const uint4*)xs_; XB = *(const uint4*)(xs_ + 8); }    \
    const bf16_t* ys_ = ybf + (size_t)(T) * DM + lane * 16; YA = *(const uint4*)ys_; YB = *(const uint4*)(ys_ + 8); }
  if (gw < tend) LN_FETCH(gw, xa, xb, ya, yb, xf)
  for (int t = gw; t < tend; t += nw) {
    uint4 nxa = xa, nxb = xb, nya = ya, nyb = yb; float4 nxf[4] = {xf[0], xf[1], xf[2], xf[3]};
    if (t + nw < tend) LN_FETCH(t + nw, nxa, nxb, nya, nyb, nxf)
    const int mr = mod_row(t);
    if (mr != cur_row) {
      cur_row = mr;
      const float* m = p.mod + (size_t)(l * 5 + mr) * 6144 + lane * 16;
#pragma unroll
      for (int i = 0; i < 4; ++i) { pgv[i] = *(const float4*)(m + 2048 + 4 * i); psh[i] = *(const float4*)(m + 3072 + 4 * i); psc[i] = *(const float4*)(m + 4096 + 4 * i); }
    }
    const uint32_t xw[8] = {xa.x, xa.y, xa.z, xa.w, xb.x, xb.y, xb.z, xb.w};
    const uint32_t yw[8] = {ya.x, ya.y, ya.z, ya.w, yb.x, yb.y, yb.z, yb.w};
    float v[16];
    float s1 = 0.f;
#pragma unroll
    for (int i = 0; i < 4; ++i) {
      const float4 xv = (l == 0) ? xf[i] : make_float4(bflo(xw[2 * i]), bfhi(xw[2 * i]), bflo(xw[2 * i + 1]), bfhi(xw[2 * i + 1]));
      const float4 gv = pgv[i];
      v[4 * i + 0] = ALPHA_F * xv.x + gv.x * bflo(yw[2 * i]); v[4 * i + 1] = ALPHA_F * xv.y + gv.y * bfhi(yw[2 * i]);
      v[4 * i + 2] = ALPHA_F * xv.z + gv.z * bflo(yw[2 * i + 1]); v[4 * i + 3] = ALPHA_F * xv.w + gv.w * bfhi(yw[2 * i + 1]);
      s1 += v[4 * i + 0] + v[4 * i + 1] + v[4 * i + 2] + v[4 * i + 3];
    }
    const float mu = wave_sum(s1) * (1.f / 1024.f);
    float s2 = 0.f;
#pragma unroll
    for (int i = 0; i < 16; ++i) { const float d = v[i] - mu; s2 += d * d; }
    const float rs = rsqrtf(wave_sum(s2) * (1.f / 1024.f) + 1e-5f);
    uint32_t xo[8], hw[8];
#pragma unroll
    for (int i = 0; i < 4; ++i) {
      const float4 gg = pgg[i], bb = pbb[i], sh = psh[i], sc = psc[i];
      float4 o;
      o.x = (v[4 * i + 0] - mu) * rs * gg.x + bb.x; o.y = (v[4 * i + 1] - mu) * rs * gg.y + bb.y;
      o.z = (v[4 * i + 2] - mu) * rs * gg.z + bb.z; o.w = (v[4 * i + 3] - mu) * rs * gg.w + bb.w;
      xo[2 * i] = pack2(o.x, o.y); xo[2 * i + 1] = pack2(o.z, o.w);
      hw[2 * i] = pack2(o.x * (1.f + sc.x) + sh.x, o.y * (1.f + sc.y) + sh.y);
      hw[2 * i + 1] = pack2(o.z * (1.f + sc.z) + sh.z, o.w * (1.f + sc.w) + sh.w);
    }
    bf16_t* xd = xres + (size_t)t * DM + lane * 16;
    *(uint4*)xd = make_uint4(xo[0], xo[1], xo[2], xo[3]);
    *(uint4*)(xd + 8) = make_uint4(xo[4], xo[5], xo[6], xo[7]);
    bf16_t* hd = p.hA + (size_t)t * DM + lane * 16;
    *(uint4*)hd = make_uint4(hw[0], hw[1], hw[2], hw[3]);
    *(uint4*)(hd + 8) = make_uint4(hw[4], hw[5], hw[6], hw[7]);
    xa = nxa; xb = nxb; ya = nya; yb = nyb;
#pragma unroll
    for (int i = 0; i < 4; ++i) xf[i] = nxf[i];
  }
#undef LN_FETCH
}

#define CE_DESC(A, B) { const unsigned hi_ = max(A, B), lo_ = min(A, B); A = hi_; B = lo_; }
__device__ __forceinline__ unsigned key_enc(float x, unsigned lowmask, unsigned tag) {
  const unsigned b = __float_as_uint(x);
  const unsigned sgn = (unsigned)((int)b >> 31) | 0x80000000u;
  return ((b ^ sgn) & ~lowmask) | tag;
}
__device__ __forceinline__ float key_val(unsigned key, unsigned lowmask) {
  const unsigned sv = key & ~lowmask;
  return __uint_as_float((sv & 0x80000000u) ? (sv ^ 0x80000000u) : ~sv);
}
__device__ __forceinline__ void sort16_desc(unsigned (&k)[16]) {
#pragma unroll
  for (int size = 2; size <= 16; size <<= 1) {
#pragma unroll
    for (int stride = size >> 1; stride >= 1; stride >>= 1) {
#pragma unroll
      for (int i = 0; i < 16; ++i) {
        if ((i & stride) == 0) {
          const int j = i | stride;
          if ((i & size) == 0 || size == 16) { CE_DESC(k[i], k[j]) } else { CE_DESC(k[j], k[i]) }
        }
      }
    }
  }
}
__device__ __forceinline__ void merge16_desc(unsigned (&r)[16], const unsigned (&c)[16]) {
#pragma unroll
  for (int i = 0; i < 16; ++i) r[i] = max(r[i], c[15 - i]);
#pragma unroll
  for (int stride = 8; stride >= 1; stride >>= 1) {
#pragma unroll
    for (int i = 0; i < 16; ++i) {
      if ((i & stride) == 0) { CE_DESC(r[i], r[i | stride]) }
    }
  }
}

__device__ __forceinline__ void pair_merge16(unsigned (&r)[16]) {
  unsigned c[16];
#pragma unroll
  for (int i = 0; i < 16; ++i) c[i] = (unsigned)__builtin_amdgcn_update_dpp(0, (int)r[i], 0xB1, 0xF, 0xF, true);
  merge16_desc(r, c);
}

__device__ __forceinline__ void ph_wk_topk(const Params& p, int l, int bid, int nb, char* smem) {
  const int TIX = opaque_tid(); bid = opaque_s(bid);
  const int tid = TIX, lane = tid & 63, wave = tid >> 6;
  const int wm = wave >> 1, wn = wave & 1;
  float* sc = (float*)smem;
  const bf16_t* Bt = p.wkT + (size_t)l * 2048 * DM;
  const int trow = tid >> 1, thalf = tid & 1;
  const int nitem_wk = (((l == NLAYER - 1) ? TL : TT) / 128) * 8;
  for (int k = 0;; ++k) {
    int tm, hh;
    if (!xcd_tile<4, 2>(bid, nb, k, nitem_wk >> 3, 8, tm, hh)) break;
    const int m0 = tm << 7;
    unsigned K0[16];
#pragma unroll
    for (int i = 0; i < 16; ++i) K0[i] = 0u;
    for (int ph = 0; ph < 2; ++ph) {
      f32x4 acc[4][4];
      gemm_tile_acc(p.hA, Bt, DM, m0, (hh * 2 + ph) * 128, smem, tid, acc);
#pragma unroll
      for (int i = 0; i < 4; ++i)
#pragma unroll
        for (int j = 0; j < 4; ++j)
#pragma unroll
          for (int r = 0; r < 4; ++r)
            sc[(wm * 64 + i * 16 + (lane >> 4) * 4 + r) * 130 + wn * 65 + j * 16 + (lane & 15)] = acc[i][j][r];
      __syncthreads();
      {
        float* row = sc + trow * 130 + thalf * 65;
        unsigned R[16];
#pragma unroll
        for (int i = 0; i < 16; ++i) R[i] = key_enc(row[i], 127u, 127u - (unsigned)(thalf * 64 + i));
        sort16_desc(R);
#pragma unroll 1
        for (int c = 1; c < 4; ++c) {
          unsigned C[16];
#pragma unroll
          for (int i = 0; i < 16; ++i) C[i] = key_enc(row[c * 16 + i], 127u, 127u - (unsigned)(thalf * 64 + c * 16 + i));
          sort16_desc(C);
          merge16_desc(R, C);
        }
        pair_merge16(R);
        if (ph == 0) {
#pragma unroll
          for (int i = 0; i < 16; ++i) K0[i] = R[i];
        } else {
          float av[16], bv[16];
          int* tab = (int*)(sc + trow * 130);
#pragma unroll
          for (int i = 0; i < 16; ++i) {
            av[i] = key_val(K0[i], 127u); bv[i] = key_val(R[i], 127u);
            tab[i] = 127 - (int)(K0[i] & 127u); tab[16 + i] = 127 - (int)(R[i] & 127u);
          }
          unsigned QA[16], QB[16];
#pragma unroll
          for (int i = 0; i < 16; ++i) { QA[i] = 0u; QB[i] = 0u; }
          {
            int n = 0;
#pragma unroll
            for (int i = 0; i < 16; ++i) {
#pragma unroll
              for (int j = 0; j < 16; ++j) {
                if ((i + 1) * (j + 1) <= 16) {
                  const unsigned key = key_enc(av[i] + bv[j], 255u, 255u - (unsigned)(i * 16 + j));
                  const int ch = n >> 4, sl = n & 15;
                  if (ch == 0) QA[sl] = thalf ? QA[sl] : key;
                  if (ch == 1) QB[sl] = thalf ? QB[sl] : key;
                  if (ch == 2) QA[sl] = thalf ? key : QA[sl];
                  if (ch == 3) QB[sl] = thalf ? key : QB[sl];
                  ++n;
                }
              }
            }
          }
          sort16_desc(QA); sort16_desc(QB);
          merge16_desc(QA, QB);
          pair_merge16(QA);
          float e[16], sum = 0.f;
          const float cv0 = key_val(QA[0], 255u);
#pragma unroll
          for (int i = 0; i < 16; ++i) { e[i] = __expf(key_val(QA[i], 255u) - cv0); sum += e[i]; }
          const float inv = 1.f / sum;
          const unsigned hm = thalf ? 0xFFFFFFFFu : 0u;
          int ce[8]; float ge[8];
#pragma unroll
          for (int i = 0; i < 8; ++i) {
            const unsigned key = (QA[8 + i] & hm) | (QA[i] & ~hm);
            const unsigned flat = 255u - (key & 255u);
            ce[i] = tab[flat >> 4] * 128 + tab[16 + (flat & 15u)];
            ge[i] = __uint_as_float((__float_as_uint(e[8 + i]) & hm) | (__float_as_uint(e[i]) & ~hm)) * inv;
          }
          const size_t o = ((size_t)(m0 + trow) * 8 + hh) * 16 + thalf * 8;
          int4* de = (int4*)(p.pe + o);
          float4* dg = (float4*)(p.pg + o);
          de[0] = make_int4(ce[0], ce[1], ce[2], ce[3]); de[1] = make_int4(ce[4], ce[5], ce[6], ce[7]);
          dg[0] = make_float4(ge[0], ge[1], ge[2], ge[3]); dg[1] = make_float4(ge[4], ge[5], ge[6], ge[7]);
        }
      }
    }
  }
}

typedef float f32x2 __attribute__((ext_vector_type(2)));

#define DPPI(V, CTRL) __builtin_amdgcn_update_dpp(0, (V), (CTRL), 0xF, 0xF, true)
__device__ __forceinline__ int reduce16_transpose_i(const int (&v)[16], int lane) {
  const bool b0 = lane & 1, b1 = lane & 2, b2 = lane & 4, b3 = lane & 8;
  int w[8], x[4], y[2];
#pragma unroll
  for (int i = 0; i < 8; ++i) {
    const int mine = b0 ? v[2 * i + 1] : v[2 * i], other = b0 ? v[2 * i] : v[2 * i + 1];
    w[i] = mine + DPPI(other, 0xB1);
  }
#pragma unroll
  for (int i = 0; i < 4; ++i) {
    const int mine = b1 ? w[2 * i + 1] : w[2 * i], other = b1 ? w[2 * i] : w[2 * i + 1];
    x[i] = mine + DPPI(other, 0x4E);
  }
#pragma unroll
  for (int i = 0; i < 2; ++i) {
    const int mine = b2 ? x[2 * i + 1] : x[2 * i], other = b2 ? x[2 * i] : x[2 * i + 1];
    const int up = DPPI(other, 0x104), dn = DPPI(other, 0x114);
    y[i] = mine + (b2 ? dn : up);
  }
  const int mine = b3 ? y[1] : y[0], other = b3 ? y[0] : y[1];
  int z = mine + DPPI(other, 0x128);
  z += __shfl_xor(z, 16);
  z += __shfl_xor(z, 32);
  return z;
}

#define GBS 16
#define GBV 8
#define GGT 8
__device__ __forceinline__ void wave_sort128(int& a, int& b, int lane) {
#pragma unroll
  for (int size = 2; size <= 128; size <<= 1) {
#pragma unroll
    for (int stride = size >> 1; stride >= 1; stride >>= 1) {
      if (stride == 64) {
        const int lo = min(a, b), hi = max(a, b); a = lo; b = hi;
      } else {
        const int pa = __shfl_xor(a, stride), pb = __shfl_xor(b, stride);
        const bool lower = (lane & stride) == 0;
        const bool asc_a = (lane & size) == 0, asc_b = ((lane + 64) & size) == 0;
        a = (lower == asc_a) ? min(a, pa) : max(a, pa);
        b = (lower == asc_b) ? min(b, pb) : max(b, pb);
      }
    }
  }
}

template <int GT>
__device__ __forceinline__ void gather_group(const Params& p, const int l, const int tb, const int lane, const unsigned char* ut,
                                             const unsigned char* vt, const bool last, const float* lg, const float* lb,
                                             int* es, float* gs, uint4* hqs) {
    float hsc[GT];
#pragma unroll
    for (int j = 0; j < GT; ++j) {
      const size_t t = (size_t)(tb + j);
      int ka = (p.pe[t * 128 + lane] << 7) | lane, kb2 = (p.pe[t * 128 + 64 + lane] << 7) | (64 + lane);
      const float ga = p.pg[t * 128 + lane], gb = p.pg[t * 128 + 64 + lane];
      wave_sort128(ka, kb2, lane);
      const int ia = ka & 127, ib = kb2 & 127;
      const float xa = __shfl(ga, ia & 63), ya = __shfl(gb, ia & 63);
      const float xb = __shfl(ga, ib & 63), yb = __shfl(gb, ib & 63);
      es[j * 128 + lane] = ka >> 7; es[j * 128 + 64 + lane] = kb2 >> 7;
      gs[j * 128 + lane] = ia < 64 ? xa : ya; gs[j * 128 + 64 + lane] = ib < 64 ? xb : yb;
      const bf16_t* hrow = p.hA + t * DM + lane * 16;
      const uint4 h0 = *(const uint4*)hrow, h1 = *(const uint4*)(hrow + 8);
      float hf[16];
      hf[0] = bflo(h0.x); hf[1] = bfhi(h0.x); hf[2] = bflo(h0.y); hf[3] = bfhi(h0.y);
      hf[4] = bflo(h0.z); hf[5] = bfhi(h0.z); hf[6] = bflo(h0.w); hf[7] = bfhi(h0.w);
      hf[8] = bflo(h1.x); hf[9] = bfhi(h1.x); hf[10] = bflo(h1.y); hf[11] = bfhi(h1.y);
      hf[12] = bflo(h1.z); hf[13] = bfhi(h1.z); hf[14] = bflo(h1.w); hf[15] = bfhi(h1.w);
      float mx = 0.f;
#pragma unroll
      for (int i = 0; i < 16; ++i) mx = fmaxf(mx, fabsf(hf[i]));
#pragma unroll
      for (int o = 32; o > 0; o >>= 1) mx = fmaxf(mx, __shfl_xor(mx, o));
      mx = fmaxf(mx, 1e-20f);
      const float qs = 127.f / mx;
      hsc[j] = mx * (1.f / 127.f) * (1.f / QSCALE_U);
      hqs[j * 64 + lane] = make_uint4(pack_i8x4(hf[0] * qs, hf[1] * qs, hf[2] * qs, hf[3] * qs), pack_i8x4(hf[4] * qs, hf[5] * qs, hf[6] * qs, hf[7] * qs),
                                      pack_i8x4(hf[8] * qs, hf[9] * qs, hf[10] * qs, hf[11] * qs), pack_i8x4(hf[12] * qs, hf[13] * qs, hf[14] * qs, hf[15] * qs));
    }
#pragma unroll 1
    for (int bi = 0; bi < 128 / GBS; ++bi) {
#pragma unroll
      for (int j = 0; j < GT; ++j) {
        uint4 uw[GBS];
        const int esrc = es[j * 128 + bi * GBS + (lane & (GBS - 1))];
#pragma unroll
        for (int u = 0; u < GBS; ++u) {
          const int e = __builtin_amdgcn_readlane(esrc, u);
          uw[u] = *(const uint4*)(ut + (size_t)e * DM);
        }
        int d[GBS];
        const uint4 hqj = hqs[j * 64 + lane];
#pragma unroll
        for (int u = 0; u < GBS; ++u) {
          int dd = __builtin_amdgcn_sdot4((int)uw[u].x, (int)hqj.x, 0, false);
          dd = __builtin_amdgcn_sdot4((int)uw[u].y, (int)hqj.y, dd, false);
          dd = __builtin_amdgcn_sdot4((int)uw[u].z, (int)hqj.z, dd, false);
          dd = __builtin_amdgcn_sdot4((int)uw[u].w, (int)hqj.w, dd, false);
          d[u] = dd;
        }
        static_assert(GBS == 16, "reduce16_transpose handles 16 pairs per batch");
        const float dsel = (float)reduce16_transpose_i(d, lane) * hsc[j];
        const float gsel = gs[j * 128 + bi * GBS + (lane & (GBS - 1))];
        const float a = gsel * 0.5f * dsel * (1.f + erff(dsel * 0.7071067811865476f)) * (1.f / SCALE_V);
        if (lane < GBS) gs[j * 128 + bi * GBS + lane] = a;
        asm volatile("" ::: "memory");
        __builtin_amdgcn_sched_barrier(0);
      }
    }
    constexpr int GV = (GT > 4) ? 4 : GT;
#pragma unroll 1
    for (int j0 = 0; j0 < GT; j0 += GV) {
    f32x2 acc2[GV][8];
#pragma unroll
    for (int j = 0; j < GV; ++j)
#pragma unroll
      for (int i = 0; i < 8; ++i) acc2[j][i] = f32x2{0.f, 0.f};
#pragma unroll 1
    for (int bi = 0; bi < 128 / GBV; ++bi) {
#pragma unroll
      for (int j = 0; j < GV; ++j) {
        uint4 vw[GBV]; float aa[GBV];
        const int esrc = es[(j0 + j) * 128 + bi * GBV + (lane & (GBV - 1))];
        const int gsrc = __builtin_bit_cast(int, gs[(j0 + j) * 128 + bi * GBV + (lane & (GBV - 1))]);
#pragma unroll
        for (int u = 0; u < GBV; ++u) {
          const int e = __builtin_amdgcn_readlane(esrc, u);
          aa[u] = __builtin_bit_cast(float, __builtin_amdgcn_readlane(gsrc, u));
          vw[u] = *(const uint4*)(vt + (size_t)e * DM);
        }
#pragma unroll
        for (int u = 0; u < GBV; ++u) {
          uint32_t w0 = vw[u].x, w1 = vw[u].y, w2 = vw[u].z, w3 = vw[u].w;
          asm volatile("" : "+v"(w0), "+v"(w1), "+v"(w2), "+v"(w3) : "v"(acc2[j][0]), "v"(acc2[j][7]));
          const f32x2 a2 = f32x2{aa[u], aa[u]};
          acc2[j][0] += __builtin_amdgcn_cvt_pk_f32_fp8((int)w0, false) * a2;
          acc2[j][1] += __builtin_amdgcn_cvt_pk_f32_fp8((int)w0, true) * a2;
          acc2[j][2] += __builtin_amdgcn_cvt_pk_f32_fp8((int)w1, false) * a2;
          acc2[j][3] += __builtin_amdgcn_cvt_pk_f32_fp8((int)w1, true) * a2;
          acc2[j][4] += __builtin_amdgcn_cvt_pk_f32_fp8((int)w2, false) * a2;
          acc2[j][5] += __builtin_amdgcn_cvt_pk_f32_fp8((int)w2, true) * a2;
          acc2[j][6] += __builtin_amdgcn_cvt_pk_f32_fp8((int)w3, false) * a2;
          acc2[j][7] += __builtin_amdgcn_cvt_pk_f32_fp8((int)w3, true) * a2;
        }
        asm volatile("" ::: "memory");
        __builtin_amdgcn_sched_barrier(0);
      }
    }
    float acc[GV][16];
#pragma unroll
    for (int j = 0; j < GV; ++j)
#pragma unroll
      for (int i = 0; i < 8; ++i) { acc[j][2 * i] = acc2[j][i].x; acc[j][2 * i + 1] = acc2[j][i].y; }
    float4 pgv[4], pgg[4], pbb[4], psh[4], psc[4];
    {
      const int t0 = tb + j0;
      const float* m = p.mod + (size_t)(l * 5 + mod_row(t0)) * 6144 + lane * 16;
      const float* m2 = p.mod + (size_t)((last ? l : l + 1) * 5 + mod_row(t0)) * 6144 + lane * 16;
#pragma unroll
      for (int i = 0; i < 4; ++i) {
        pgv[i] = *(const float4*)(m + 5120 + 4 * i);
        pgg[i] = *(const float4*)(lg + 4 * i); pbb[i] = *(const float4*)(lb + 4 * i);
        psh[i] = *(const float4*)(m2 + 4 * i); psc[i] = *(const float4*)(m2 + 1024 + 4 * i);
      }
    }
#pragma unroll
    for (int j = 0; j < GV; ++j) {
      __builtin_amdgcn_sched_barrier(0);
      const int t = tb + j0 + j;
      bf16_t* xr = (bf16_t*)p.xres + (size_t)t * DM + lane * 16;
      const uint4 xb0 = *(const uint4*)xr, xb1 = *(const uint4*)(xr + 8);
      const uint32_t xw[8] = {xb0.x, xb0.y, xb0.z, xb0.w, xb1.x, xb1.y, xb1.z, xb1.w};
      float v[16];
      float s1 = 0.f;
#pragma unroll
      for (int i = 0; i < 4; ++i) {
        const float4 xv = make_float4(bflo(xw[2 * i]), bfhi(xw[2 * i]), bflo(xw[2 * i + 1]), bfhi(xw[2 * i + 1]));
        const float4 gv = pgv[i];
        v[4 * i + 0] = ALPHA_F * xv.x + gv.x * acc[j][4 * i + 0]; v[4 * i + 1] = ALPHA_F * xv.y + gv.y * acc[j][4 * i + 1];
        v[4 * i + 2] = ALPHA_F * xv.z + gv.z * acc[j][4 * i + 2]; v[4 * i + 3] = ALPHA_F * xv.w + gv.w * acc[j][4 * i + 3];
        s1 += v[4 * i + 0] + v[4 * i + 1] + v[4 * i + 2] + v[4 * i + 3];
      }
      const float mu = wave_sum(s1) * (1.f / 1024.f);
      float s2 = 0.f;
#pragma unroll
      for (int i = 0; i < 16; ++i) { const float dlt = v[i] - mu; s2 += dlt * dlt; }
      const float rs = rsqrtf(wave_sum(s2) * (1.f / 1024.f) + 1e-5f);
      uint32_t hw[8], xo[8];
#pragma unroll
      for (int i = 0; i < 4; ++i) {
        const float4 gg = pgg[i];
        const float4 bb = pbb[i];
        float4 o;
        o.x = (v[4 * i + 0] - mu) * rs * gg.x + bb.x; o.y = (v[4 * i + 1] - mu) * rs * gg.y + bb.y;
        o.z = (v[4 * i + 2] - mu) * rs * gg.z + bb.z; o.w = (v[4 * i + 3] - mu) * rs * gg.w + bb.w;
        xo[2 * i] = pack2(o.x, o.y); xo[2 * i + 1] = pack2(o.z, o.w);
        if (last && t < TL) *(float4*)(p.out + (size_t)t * DM + lane * 16 + 4 * i) = o;
        const float4 sh = psh[i];
        const float4 sc = psc[i];
        hw[2 * i] = pack2(o.x * (1.f + sc.x) + sh.x, o.y * (1.f + sc.y) + sh.y);
        hw[2 * i + 1] = pack2(o.z * (1.f + sc.z) + sh.z, o.w * (1.f + sc.w) + sh.w);
      }
      *(uint4*)xr = make_uint4(xo[0], xo[1], xo[2], xo[3]);
      *(uint4*)(xr + 8) = make_uint4(xo[4], xo[5], xo[6], xo[7]);
      bf16_t* hd = p.hA + (size_t)t * DM + lane * 16;
      *(uint4*)hd = make_uint4(hw[0], hw[1], hw[2], hw[3]);
      *(uint4*)(hd + 8) = make_uint4(hw[4], hw[5], hw[6], hw[7]);
    }
    }
}

__device__ __forceinline__ void ph_gather_sorted(const Params& p, int l, int bid, int nb, char* smem) {
  const int TIX = opaque_tid(); bid = opaque_s(bid);
  const int lane = TIX & 63;
  const int gw = bid * 4 + (TIX >> 6), nw = nb * 4;
  const unsigned char* ut = (const unsigned char*)p.ubf + lane * 16;
  const unsigned char* vt = (const unsigned char*)p.vbf + lane * 16;
  const bool last = (l == NLAYER - 1);
  const float* lg = p.ln2_g + (size_t)l * DM + lane * 16;
  const float* lb = p.ln2_b + (size_t)l * DM + lane * 16;
  int* es = (int*)(smem + (TIX >> 6) * (GGT * 2048));
  float* gs = (float*)(es + GGT * 128);
  uint4* hqs = (uint4*)(gs + GGT * 128);
  for (int grp = gw; grp < TL / GGT; grp += nw) gather_group<GGT>(p, l, grp * GGT, lane, ut, vt, last, lg, lb, es, gs, hqs);
  if (!last) for (int t = TL + gw; t < TT; t += nw) gather_group<1>(p, l, t, lane, ut, vt, last, lg, lb, es, gs, hqs);
}

enum { PH_PRE_A = 0, PH_PRE_B, PH_INIT, PH_GEMM_IN, PH_ELEM, PH_RET_UPD, PH_RET_SCAN, PH_RET_OUT, PH_GEMM_OUT, PH_LN1,
       PH_GEMM_WK, PH_TOPK1, PH_TOPK2, PH_GATHER, PH_LN2, PH_GNORM };

__device__ __forceinline__ void run_phase(const Params& p, int ph, int l, int bid, int nb, char* smem) {
  switch (ph) {
    case PH_PRE_A:
      ph_mod_partial(p, bid, nb, smem);
      for (int ll = 0; ll < NLAYER; ++ll) {
        ph_transpose_cvt(p.w_in + (size_t)ll * DM * NPROJ, p.w_inT + (size_t)ll * NPROJ * DM, DM, NPROJ, bid, nb, smem);
        ph_transpose_cvt(p.w_out + (size_t)ll * DM * DM, p.w_outT + (size_t)ll * DM * DM, DM, DM, bid, nb, smem);
      }
      ph_wk_fold(p, bid, nb, smem);
      break;
    case PH_PRE_B: ph_mod_reduce(p, bid, nb); break;
    case PH_INIT: ph_init_h(p, bid, nb); break;
    case PH_GEMM_IN:
      ph_gemm_in(p, l, bid, nb, smem);
      break;
    case PH_RET_UPD: ph_ret_upd(p, bid, nb, smem); break;
    case PH_RET_SCAN: ph_ret_scan(p, bid, nb); break;
    case PH_RET_OUT: ph_ret_out(p, l, bid, nb, smem); break;
    case PH_GEMM_OUT: ph_gemm<true>(p.cat, p.w_outT + (size_t)l * DM * DM, p.ybuf, (l == NLAYER - 1) ? TL : TT, DM, DM, bid, nb, smem); break;
    case PH_LN1: ph_ln(p, l, 1, bid, nb); break;
    case PH_GEMM_WK: ph_wk_topk(p, l, bid, nb, smem); break;
    case PH_GATHER: ph_gather_sorted(p, l, bid, nb, smem); break;
    case PH_GNORM: ph_gnorm(p, l, bid, nb); break;
  }
}

extern __shared__ __attribute__((aligned(16))) char dyn_smem[];

#define XB_TMO      128
#define XB_XCNT(j)  (256  + 64 * (j))
#define XB_XSUB(j)  (1280 + 64 * (j))
#define XB_XGEN(j)  (2304 + 64 * (j))
#define XB_TOP      3328
#define XB_TOPGEN   3392
#define XCD_BAR_WORDS 3456
#define XB_SPIN_CAP (1u << 22)
__device__ __forceinline__ unsigned xb_ld(unsigned* q)              { return __hip_atomic_load(q, __ATOMIC_RELAXED, __HIP_MEMORY_SCOPE_AGENT); }
__device__ __forceinline__ unsigned xb_add(unsigned* q, unsigned v) { return __hip_atomic_fetch_add(q, v, __ATOMIC_RELAXED, __HIP_MEMORY_SCOPE_AGENT); }
__device__ __forceinline__ unsigned xb_xcc_id() { return (unsigned)__builtin_amdgcn_s_getreg((3 << 11) | 20) & 0xFu; }
#define XB_SPIN(cond, bar) do { unsigned _sp = 0; while (cond) { __builtin_amdgcn_s_sleep(1); \
    if ((++_sp & 255u) == 0u) { if (xb_ld(&(bar)[XB_TMO])) break; if (_sp > XB_SPIN_CAP) { atomicAdd(&(bar)[XB_TMO], 1u); break; } } } } while (0)
struct XcdBarrier { unsigned* bar; unsigned x; volatile unsigned* st; };
__device__ __forceinline__ XcdBarrier xcd_barrier_post(unsigned* bar, volatile unsigned* st) {
  XcdBarrier b; b.bar = bar; b.x = xb_xcc_id(); b.st = st;
  if (threadIdx.x == 0) (void)xb_add(&bar[XB_XCNT(b.x)], 1u);
  return b;
}
__device__ __forceinline__ void xcd_barrier_complete(unsigned* bar, unsigned x, unsigned& nloc, unsigned& nx) {
  const unsigned G = gridDim.x * gridDim.y * gridDim.z;
  unsigned sum, cnt, mine, sp = 0u;
  for (;;) {
    sum = 0u; cnt = 0u; mine = 0u;
#pragma unroll
    for (unsigned j = 0; j < 16; ++j) { const unsigned c = xb_ld(&bar[XB_XCNT(j)]); sum += c; cnt += (c > 0u) ? 1u : 0u; mine = (j == x) ? c : mine; }
    if (sum == G) break;
    __builtin_amdgcn_s_sleep(1);
    if ((++sp & 255u) == 0u) { if (xb_ld(&bar[XB_TMO])) break; if (sp > XB_SPIN_CAP) { atomicAdd(&bar[XB_TMO], 1u); break; } }
  }
  nloc = mine > 0u ? mine : 1u; nx = cnt > 0u ? cnt : 1u;
}
__device__ __forceinline__ void xcd_barrier(const XcdBarrier& b) {
  asm volatile("s_waitcnt vmcnt(0)" ::: "memory");
  __syncthreads();
  if (threadIdx.x == 0) {
    unsigned* bar = b.bar;
    __builtin_amdgcn_s_waitcnt(0);
    unsigned nloc = b.st[0], nx = b.st[1];
    if (nloc == 0u) { xcd_barrier_complete(bar, b.x, nloc, nx); b.st[0] = nloc; b.st[1] = nx; }
    const unsigned old = xb_add(&bar[XB_XSUB(b.x)], 1u);
    const unsigned gen = old / nloc;
    if (old + 1u == (gen + 1u) * nloc) {
      __builtin_amdgcn_fence(__ATOMIC_RELEASE, "agent");
      asm volatile("s_waitcnt vmcnt(0)" ::: "memory");
      const unsigned og = xb_add(&bar[XB_TOP], 1u);
      const unsigned tg = og / nx;
      if (og + 1u == (tg + 1u) * nx) xb_add(&bar[XB_TOPGEN], 1u);
      else XB_SPIN(xb_ld(&bar[XB_TOPGEN]) == tg, bar);
      __builtin_amdgcn_fence(__ATOMIC_ACQUIRE, "agent");
      xb_add(&bar[XB_XGEN(b.x)], 1u);
      asm volatile("s_waitcnt vmcnt(0)" ::: "memory");
    } else {
      XB_SPIN(xb_ld(&bar[XB_XGEN(b.x)]) == gen, bar);
      __builtin_amdgcn_fence(__ATOMIC_ACQUIRE, "agent");
      asm volatile("s_waitcnt vmcnt(0)" ::: "memory");
    }
  }
  __syncthreads();
}

__global__ void __launch_bounds__(256, 2) k_mega(Params p) {
  cg::grid_group grid = cg::this_grid();
  const int bid = blockIdx.x, nb = gridDim.x;
  volatile unsigned* xst = (volatile unsigned*)(dyn_smem + 66560);
  if (threadIdx.x == 0) { xst[0] = 0u; xst[1] = 0u; xst[2] = 0u; xst[3] = 0u; }
  __syncthreads();
  const XcdBarrier xb = xcd_barrier_post(p.bar, xst);
#define GSYNC() xcd_barrier(xb)
  grid.sync();
#define RUNP(PH, L, SYNC) do { unsigned long long t0_ = 0; if ((PROBE_MASK >> (PH)) & 1) t0_ = wall_clock64(); \
    run_phase(p, PH, L, bid, nb, dyn_smem); if (SYNC) GSYNC(); \
    if ((PROBE_MASK >> (PH)) & 1) { if (!(SYNC)) GSYNC(); const unsigned long long t1_ = wall_clock64(); \
      while (wall_clock64() - t1_ < t1_ - t0_) __builtin_amdgcn_s_sleep(8); GSYNC(); } } while (0)
  RUNP(PH_PRE_A, 0, 1);
  RUNP(PH_PRE_B, 0, 1);
  RUNP(PH_INIT, 0, 1);
  for (int l = 0; l < NLAYER; ++l) {
    RUNP(PH_GEMM_IN, l, 1);
    RUNP(PH_RET_UPD, l, 1);
    RUNP(PH_RET_SCAN, l, 1);
    RUNP(PH_RET_OUT, l, 1);
    RUNP(PH_GNORM, l, 1);
    RUNP(PH_GEMM_OUT, l, 1);
    RUNP(PH_LN1, l, 1);
    RUNP(PH_GEMM_WK, l, 1);
    RUNP(PH_GATHER, l, (l + 1 < NLAYER));
  }
#undef GSYNC
}

static inline size_t al256(size_t v) { return (v + 255) & ~(size_t)255; }

extern "C" void kernel_launch(void* const* d_in, const int* in_sizes, int n_in, void* d_out, int out_size, void* d_ws,
                              size_t ws_size, hipStream_t stream) {
  static int mgrid = 0;
  if (mgrid == 0) {
    int dev = 0, cus = 0, per_cu = 0;
    (void)hipGetDevice(&dev);
    (void)hipDeviceGetAttribute(&cus, hipDeviceAttributeMultiprocessorCount, dev);
    if (cus <= 0) cus = 256;
    (void)hipFuncSetAttribute((const void*)k_mega, hipFuncAttributeMaxDynamicSharedMemorySize, SMEM_BYTES);
    if (hipOccupancyMaxActiveBlocksPerMultiprocessor(&per_cu, (const void*)k_mega, 256, SMEM_BYTES) != hipSuccess || per_cu < 1) per_cu = 1;
    if (per_cu > 2) per_cu = 2;
    mgrid = cus * per_cu;
  }
  Params p{};
  p.x = (const float*)d_in[0]; p.c = (const float*)d_in[1]; p.ctx = (const float*)d_in[2]; p.c_ctx = (const float*)d_in[3];
  p.w_mod = (const float*)d_in[4]; p.b_mod = (const float*)d_in[5]; p.w_in = (const float*)d_in[6]; p.conv_w = (const float*)d_in[7];
  p.w_out = (const float*)d_in[8]; p.ln1_g = (const float*)d_in[9]; p.ln1_b = (const float*)d_in[10]; p.peer_wq = (const float*)d_in[11];
  p.peer_keys = (const float*)d_in[12]; p.peer_u = (const float*)d_in[13]; p.peer_v = (const float*)d_in[14];
  p.ln2_g = (const float*)d_in[15]; p.ln2_b = (const float*)d_in[16];
  p.out = (float*)d_out;
  char* w = (char*)d_ws; size_t off = 0;
  auto take = [&](size_t bytes) { char* r = w + off; off = al256(off + bytes); return r; };
  p.xres = (float*)take((size_t)TT * DM * 4);
  p.hA = (bf16_t*)take((size_t)TT * DM * 2);
  p.big = take((size_t)TT * 2048 * 4);
  p.cat = (bf16_t*)take((size_t)TT * DM * 2);
  p.st = (float*)take((size_t)2 * NCHUNK * 4 * 16384 * 4);
  p.ybuf = (float*)take((size_t)TT * DM * 4);
  p.w_inT = (bf16_t*)take((size_t)NLAYER * NPROJ * DM * 2);
  p.w_outT = (bf16_t*)take((size_t)NLAYER * DM * DM * 2);
  p.wkT = (bf16_t*)take((size_t)NLAYER * 2048 * DM * 2);
  p.ubf = (bf16_t*)take((size_t)NEXP * DM * 2);
  p.vbf = (bf16_t*)take((size_t)NEXP * DM * 2);
  p.mod = (float*)take((size_t)4 * 5 * 6144 * 4);
  p.modp = (float*)take((size_t)8 * 4 * 5 * 6144 * 4);
  p.ropec = (float*)take(128 * 32 * 4);
  p.ropes = (float*)take(128 * 32 * 4);
  p.bar = (unsigned*)take(XCD_BAR_WORDS * 4);
  p.pad0 = nullptr;
  {
    char* a = (char*)p.st; size_t o2 = 0;
    p.sv = (float*)(a + o2); o2 = al256(o2 + (size_t)TT * 256 * 4);
    p.si = (unsigned char*)(a + o2); o2 = al256(o2 + (size_t)TT * 256);
    p.pe = (int*)(a + o2); o2 = al256(o2 + (size_t)TT * 128 * 4);
    p.pg = (float*)(a + o2); o2 = al256(o2 + (size_t)TT * 128 * 4);
  }
  for (int d = 0; d < 2; ++d)
    for (int h = 0; h < 4; ++h) p.lg2[d][h] = (float)log2(1.0 - exp2(-(5.0 + 0.5 * d + (double)h)));
  if (off > ws_size) { fprintf(stderr, "kernel_launch: workspace too small: need %zu have %zu\n", off, ws_size); return; }

  (void)hipMemsetAsync(p.bar, 0, XCD_BAR_WORDS * 4, stream);
  void* args[] = {(void*)&p};
  hipError_t e = hipLaunchCooperativeKernel((const void*)k_mega, dim3(mgrid), dim3(256), args, SMEM_BYTES, stream);
  if (e != hipSuccess) fprintf(stderr, "kernel_launch: cooperative launch failed: %s (grid %d)\n", hipGetErrorString(e), mgrid);
}
```

```cpp
#include <hip/hip_runtime.h>
#include <hip/hip_cooperative_groups.h>
#include <stdint.h>
#include <math.h>
#include <stdio.h>
#include <utility>
#include <type_traits>

namespace cg = cooperative_groups;

typedef unsigned short bf16_t;
using bf16x8 = __attribute__((ext_vector_type(8))) short;
using s16x4 = __attribute__((ext_vector_type(4))) short;
using f32x4 = __attribute__((ext_vector_type(4))) float;
using u32x4 = __attribute__((ext_vector_type(4))) unsigned;

#define DM 1024
#define NB 4
#define SEQ 8192
#define TL 32768
#define TC 1024
#define TT 33792
#define NCHUNK 264
#define NPROJ 3584
#define NLAYER 4
#define NEXP 16384
#define ALPHA_F 1.681792830507429f
#define SMEM_BYTES 66576
#ifndef PROBE_MASK
#define PROBE_MASK 0
#endif

struct Params {
  const float *x, *c, *ctx, *c_ctx, *w_mod, *b_mod, *w_in, *conv_w, *w_out, *ln1_g, *ln1_b;
  const float *peer_wq, *peer_keys, *peer_u, *peer_v, *ln2_g, *ln2_b;
  float* out;
  float* xres; bf16_t* hA; char* big; bf16_t* cat; float* st; float* ybuf;
  bf16_t *w_inT, *w_outT, *wkT, *ubf, *vbf;
  float* sv; unsigned char* si; int* pe; float* pg;
  float *mod, *modp, *ropec, *ropes;
  unsigned* bar; unsigned* pad0;
  float lg2[2][4];
};

__device__ __forceinline__ bf16_t f2bf(float f) {
  uint32_t u = __float_as_uint(f);
  u += 0x7fffu + ((u >> 16) & 1u);
  return (bf16_t)(u >> 16);
}
__device__ __forceinline__ float bf2f(bf16_t b) { return __uint_as_float(((uint32_t)b) << 16); }
__device__ __forceinline__ uint32_t pack2(float a, float b) { return (uint32_t)f2bf(a) | ((uint32_t)f2bf(b) << 16); }
__device__ __forceinline__ float bflo(uint32_t w) { return __uint_as_float(w << 16); }
__device__ __forceinline__ float bfhi(uint32_t w) { return __uint_as_float(w & 0xffff0000u); }
__device__ __forceinline__ float wave_sum(float v) {
#pragma unroll
  for (int o = 32; o > 0; o >>= 1) v += __shfl_xor(v, o);
  return v;
}
__device__ __forceinline__ float row16_sum(float v) {
  v += __builtin_bit_cast(float, __builtin_amdgcn_update_dpp(0, __builtin_bit_cast(int, v), 0xB1, 0xF, 0xF, true));
  v += __builtin_bit_cast(float, __builtin_amdgcn_update_dpp(0, __builtin_bit_cast(int, v), 0x4E, 0xF, 0xF, true));
  v += __builtin_bit_cast(float, __builtin_amdgcn_update_dpp(0, __builtin_bit_cast(int, v), 0x141, 0xF, 0xF, true));
  v += __builtin_bit_cast(float, __builtin_amdgcn_update_dpp(0, __builtin_bit_cast(int, v), 0x140, 0xF, 0xF, true));
  return v;
}
__device__ __forceinline__ float silu_f(float v) { return v * __builtin_amdgcn_rcpf(1.f + __expf(-v)); }
__device__ __forceinline__ int mod_row(int t) { return t < TL ? (t >> 13) : 4; }

__device__ __forceinline__ f32x4 zero4() { f32x4 a = {0.f, 0.f, 0.f, 0.f}; asm volatile("" : "+v"(a)); return a; }

__device__ __forceinline__ int opaque_tid() { int t = threadIdx.x; asm volatile("" : "+v"(t)); return t; }
__device__ __forceinline__ int opaque_s(int v) { v = __builtin_amdgcn_readfirstlane(v); asm volatile("" : "+s"(v)); return v; }

template <class F, int... I>
__device__ __forceinline__ void static_for_impl(F&& f, std::integer_sequence<int, I...>) { (f(std::integral_constant<int, I>{}), ...); }
template <int N, class F>
__device__ __forceinline__ void static_for(F&& f) { static_for_impl(f, std::make_integer_sequence<int, N>{}); }

__device__ __forceinline__ unsigned tr_lane_base(unsigned base, unsigned ld, unsigned lane) {
  const unsigned g = lane >> 4, q = (lane & 15u) >> 2, p = lane & 3u;
  return base + (8u * g + q) * ld + 8u * p;
}
template <int O0, int O1, int O2, int O3, int D>
__device__ __forceinline__ void tr_frag4(unsigned a, bf16x8& f0, bf16x8& f1, bf16x8& f2, bf16x8& f3) {
  s16x4 r0, r1, r2, r3, r4, r5, r6, r7;
  asm volatile(
      "ds_read_b64_tr_b16 %0, %8 offset:%9\n\t"
      "ds_read_b64_tr_b16 %1, %8 offset:%10\n\t"
      "ds_read_b64_tr_b16 %2, %8 offset:%11\n\t"
      "ds_read_b64_tr_b16 %3, %8 offset:%12\n\t"
      "ds_read_b64_tr_b16 %4, %8 offset:%13\n\t"
      "ds_read_b64_tr_b16 %5, %8 offset:%14\n\t"
      "ds_read_b64_tr_b16 %6, %8 offset:%15\n\t"
      "ds_read_b64_tr_b16 %7, %8 offset:%16\n\t"
      "s_waitcnt lgkmcnt(0)"
      : "=&v"(r0), "=&v"(r1), "=&v"(r2), "=&v"(r3), "=&v"(r4), "=&v"(r5), "=&v"(r6), "=&v"(r7)
      : "v"(a), "n"(O0), "n"(O0 + D), "n"(O1), "n"(O1 + D), "n"(O2), "n"(O2 + D), "n"(O3), "n"(O3 + D)
      : "memory");
  f0 = __builtin_shufflevector(r0, r1, 0, 1, 2, 3, 4, 5, 6, 7);
  f1 = __builtin_shufflevector(r2, r3, 0, 1, 2, 3, 4, 5, 6, 7);
  f2 = __builtin_shufflevector(r4, r5, 0, 1, 2, 3, 4, 5, 6, 7);
  f3 = __builtin_shufflevector(r6, r7, 0, 1, 2, 3, 4, 5, 6, 7);
}

__device__ __forceinline__ void ph_mod_partial(const Params& p, int bid, int nb, char* smem) {
  const int TIX = opaque_tid(); bid = opaque_s(bid);
  float* sm = (float*)smem;
  const int tid = TIX;
  for (int item = bid; item < 4 * 24 * 8; item += nb) {
    const int ks = item & 7, cb = (item >> 3) % 24, l = item / 192;
    __syncthreads();
    for (int idx = tid; idx < 640; idx += 256) {
      const int r = idx >> 7, k = ks * 128 + (idx & 127);
      const float v = (r < 4) ? p.c[r * DM + k] : p.c_ctx[k];
      sm[idx] = silu_f(v);
    }
    __syncthreads();
    const int col = cb * 256 + tid;
    float acc[5] = {0.f, 0.f, 0.f, 0.f, 0.f};
    const float* w = p.w_mod + ((size_t)l * DM + ks * 128) * 6144 + col;
#pragma unroll 4
    for (int k = 0; k < 128; ++k) {
      const float wv = w[(size_t)k * 6144];
#pragma unroll
      for (int r = 0; r < 5; ++r) acc[r] += sm[r * 128 + k] * wv;
    }
#pragma unroll
    for (int r = 0; r < 5; ++r) p.modp[((size_t)(ks * 4 + l) * 5 + r) * 6144 + col] = acc[r];
  }
}

__device__ __forceinline__ void ph_mod_reduce(const Params& p, int bid, int nb) {
  const int TIX = opaque_tid(); bid = opaque_s(bid);
  const int gtid = bid * 256 + TIX, gn = nb * 256;
  for (int idx = gtid; idx < 4 * 5 * 6144; idx += gn) {
    const int l = idx / (5 * 6144), col = idx % 6144;
    float s = p.b_mod[l * 6144 + col];
#pragma unroll
    for (int ks = 0; ks < 8; ++ks) s += p.modp[(size_t)ks * (4 * 5 * 6144) + idx];
    p.mod[idx] = s;
  }
  for (int idx = gtid; idx < 128 * 32; idx += gn) {
    const int pos = idx >> 5, d = idx & 31;
    const float inv = exp2f(-(float)d * (13.287712379549449f / 32.f));
    const float angf = (float)pos * inv;
    const double a = (double)angf;
    const double kk = rint(a * 0.15915494309189535);
    const double r = a - kk * 6.283185307179586;
    const double r2 = r * r;
    double sn = 1.0, cs = 1.0;
    for (int n = 13; n >= 1; --n) {
      sn = 1.0 - sn * r2 / (double)((2 * n) * (2 * n + 1));
      cs = 1.0 - cs * r2 / (double)((2 * n - 1) * (2 * n));
    }
    p.ropec[idx] = (float)cs;
    p.ropes[idx] = (float)(r * sn);
  }
}

__device__ __forceinline__ void ph_transpose_cvt(const float* src, bf16_t* dst, int K, int N, int bid, int nb, char* smem) {
  const int TIX = opaque_tid(); bid = opaque_s(bid);
  float* tile = (float*)smem;
  const int tid = TIX;
  const int ntn = N >> 6, ntk = K >> 6;
  for (int item = bid; item < ntn * ntk; item += nb) {
    const int kt = item / ntn, nt = item % ntn;
    __syncthreads();
#pragma unroll
    for (int i = 0; i < 4; ++i) {
      const int r = (tid >> 4) + 16 * i, c4 = (tid & 15) * 4;
      const float4 v = *(const float4*)(src + (size_t)(kt * 64 + r) * N + nt * 64 + c4);
      tile[r * 65 + c4 + 0] = v.x; tile[r * 65 + c4 + 1] = v.y; tile[r * 65 + c4 + 2] = v.z; tile[r * 65 + c4 + 3] = v.w;
    }
    __syncthreads();
    const int n = tid >> 2, kseg = (tid & 3) * 16;
    uint32_t w[8];
#pragma unroll
    for (int e = 0; e < 8; ++e) w[e] = pack2(tile[(kseg + 2 * e) * 65 + n], tile[(kseg + 2 * e + 1) * 65 + n]);
    uint4* d = (uint4*)(dst + (size_t)(nt * 64 + n) * K + kt * 64 + kseg);
    d[0] = make_uint4(w[0], w[1], w[2], w[3]);
    d[1] = make_uint4(w[4], w[5], w[6], w[7]);
  }
}

__device__ __forceinline__ void ph_wk_fold(const Params& p, int bid, int nb, char* smem) {
  const int TIX = opaque_tid(); bid = opaque_s(bid);
  float* wq_s = (float*)smem;
  float* key_s = wq_s + 64 * 65;
  const int tid = TIX;
  const int tc = tid >> 4, tn = tid & 15;
  for (int item = bid; item < 4 * 16 * 16; item += nb) {
    const int ct = item & 15, hp = (item >> 4) & 15, l = item >> 8;
    float acc[4][8];
#pragma unroll
    for (int a = 0; a < 4; ++a)
#pragma unroll
      for (int b = 0; b < 8; ++b) acc[a][b] = 0.f;
    for (int dh = 0; dh < 2; ++dh) {
      __syncthreads();
#pragma unroll
      for (int i = 0; i < 4; ++i) {
        const int r = (tid >> 4) + 16 * i, c4 = (tid & 15) * 4;
        const float4 v = *(const float4*)(p.peer_wq + ((size_t)l * DM + ct * 64 + r) * 2048 + hp * 128 + dh * 64 + c4);
        wq_s[r * 65 + c4 + 0] = v.x; wq_s[r * 65 + c4 + 1] = v.y; wq_s[r * 65 + c4 + 2] = v.z; wq_s[r * 65 + c4 + 3] = v.w;
      }
#pragma unroll
      for (int i = 0; i < 8; ++i) {
        const int r = (tid >> 4) + 16 * i, c4 = (tid & 15) * 4;
        const float4 v = *(const float4*)(p.peer_keys + (((size_t)l * 2 + (hp & 1)) * 128 + r) * 128 + dh * 64 + c4);
        key_s[r * 65 + c4 + 0] = v.x; key_s[r * 65 + c4 + 1] = v.y; key_s[r * 65 + c4 + 2] = v.z; key_s[r * 65 + c4 + 3] = v.w;
      }
      __syncthreads();
#pragma unroll 4
      for (int d = 0; d < 64; ++d) {
        float av[4], bv[8];
#pragma unroll
        for (int a = 0; a < 4; ++a) av[a] = wq_s[(tc * 4 + a) * 65 + d];
#pragma unroll
        for (int b = 0; b < 8; ++b) bv[b] = key_s[(tn + 16 * b) * 65 + d];
#pragma unroll
        for (int a = 0; a < 4; ++a)
#pragma unroll
          for (int b = 0; b < 8; ++b) acc[a][b] += av[a] * bv[b];
      }
    }
#pragma unroll
    for (int b = 0; b < 8; ++b) {
      const int row = hp * 128 + tn + 16 * b;
      uint2 o;
      o.x = pack2(acc[0][b], acc[1][b]);
      o.y = pack2(acc[2][b], acc[3][b]);
      *(uint2*)(p.wkT + ((size_t)l * 2048 + row) * DM + ct * 64 + tc * 4) = o;
    }
  }
}

#define SCALE_U 128.f
#define SCALE_V 8.f
__device__ __forceinline__ uint32_t pack_fp8x4(float a, float b, float c, float d) {
  int w = 0;
  w = __builtin_amdgcn_cvt_pk_fp8_f32(a, b, w, false);
  w = __builtin_amdgcn_cvt_pk_fp8_f32(c, d, w, true);
  return (uint32_t)w;
}
#define QSCALE_U 512.f
__device__ __forceinline__ uint32_t pack_i8x4(float a, float b, float c, float d) {
  const int qa = max(-127, min(127, __float2int_rn(a))), qb = max(-127, min(127, __float2int_rn(b)));
  const int qc = max(-127, min(127, __float2int_rn(c))), qd = max(-127, min(127, __float2int_rn(d)));
  return (uint32_t)(qa & 255) | ((uint32_t)(qb & 255) << 8) | ((uint32_t)(qc & 255) << 16) | ((uint32_t)(qd & 255) << 24);
}
__device__ __forceinline__ void cvt_uv_unit(const Params& p, int l, size_t i) {
  const size_t n16 = (size_t)NEXP * DM / 16;
  const bool isv = i >= n16;
  const size_t j = isv ? i - n16 : i;
  const float sc = SCALE_V;
  const float4* s4 = (const float4*)((isv ? p.peer_v : p.peer_u) + (size_t)l * NEXP * DM + j * 16);
  const float4 a0 = s4[0], a1 = s4[1], a2 = s4[2], a3 = s4[3];
  uint4 o;
  if (isv) {
    o.x = pack_fp8x4(a0.x * sc, a0.y * sc, a0.z * sc, a0.w * sc);
    o.y = pack_fp8x4(a1.x * sc, a1.y * sc, a1.z * sc, a1.w * sc);
    o.z = pack_fp8x4(a2.x * sc, a2.y * sc, a2.z * sc, a2.w * sc);
    o.w = pack_fp8x4(a3.x * sc, a3.y * sc, a3.z * sc, a3.w * sc);
  } else {
    o.x = pack_i8x4(a0.x * QSCALE_U, a0.y * QSCALE_U, a0.z * QSCALE_U, a0.w * QSCALE_U);
    o.y = pack_i8x4(a1.x * QSCALE_U, a1.y * QSCALE_U, a1.z * QSCALE_U, a1.w * QSCALE_U);
    o.z = pack_i8x4(a2.x * QSCALE_U, a2.y * QSCALE_U, a2.z * QSCALE_U, a2.w * QSCALE_U);
    o.w = pack_i8x4(a3.x * QSCALE_U, a3.y * QSCALE_U, a3.z * QSCALE_U, a3.w * QSCALE_U);
  }
  *(uint4*)((unsigned char*)(isv ? p.vbf : p.ubf) + j * 16) = o;
}
#define CVT_UNITS ((size_t)2 * NEXP * DM / 16)

__device__ __forceinline__ void ph_init_h(const Params& p, int bid, int nb) {
  const int TIX = opaque_tid(); bid = opaque_s(bid);
  const int lane = TIX & 63;
  const int gw = bid * 4 + (TIX >> 6), nw = nb * 4;
  float4 psh[4], psc[4], xc[4];
  int cur_row = -1;
#define IH_FETCH(T, X) { const float* xr_ = ((T) < TL ? p.x + (size_t)(T) * DM : p.ctx + (size_t)((T) - TL) * DM) + lane * 16; \
    _Pragma("unroll") for (int i = 0; i < 4; ++i) X[i] = *(const float4*)(xr_ + 4 * i); }
  if (gw < TT) IH_FETCH(gw, xc)
  for (int t = gw; t < TT; t += nw) {
    float4 xn[4] = {xc[0], xc[1], xc[2], xc[3]};
    if (t + nw < TT) IH_FETCH(t + nw, xn)
    const int mr = mod_row(t);
    if (mr != cur_row) {
      cur_row = mr;
      const float* m = p.mod + (size_t)(0 * 5 + mr) * 6144 + lane * 16;
#pragma unroll
      for (int i = 0; i < 4; ++i) { psh[i] = *(const float4*)(m + 4 * i); psc[i] = *(const float4*)(m + 1024 + 4 * i); }
    }
    uint32_t o[8];
#pragma unroll
    for (int i = 0; i < 4; ++i) {
      const float4 v = xc[i], sh = psh[i], sc = psc[i];
      o[2 * i] = pack2(v.x * (1.f + sc.x) + sh.x, v.y * (1.f + sc.y) + sh.y);
      o[2 * i + 1] = pack2(v.z * (1.f + sc.z) + sh.z, v.w * (1.f + sc.w) + sh.w);
    }
    bf16_t* hd = p.hA + (size_t)t * DM + lane * 16;
    *(uint4*)hd = make_uint4(o[0], o[1], o[2], o[3]);
    *(uint4*)(hd + 8) = make_uint4(o[4], o[5], o[6], o[7]);
#pragma unroll
    for (int i = 0; i < 4; ++i) xc[i] = xn[i];
  }
#undef IH_FETCH
}

__device__ __forceinline__ void gemm_tile_acc(const bf16_t* __restrict__ A, const bf16_t* __restrict__ Bt, int K, int m0, int n0,
                                              char* smem, int tid, f32x4 (&acc)[4][4]) {
  const int lane = tid & 63, wave = opaque_s(tid >> 6);
  const int wm = wave >> 1, wn = wave & 1;
  const int g = lane >> 4, l15 = lane & 15;
  const int nt = K >> 6;
#pragma unroll
  for (int i = 0; i < 4; ++i)
#pragma unroll
    for (int j = 0; j < 4; ++j) acc[i][j] = zero4();
  const int sb = lane * 16, swz = sb ^ (((sb >> 9) & 1) << 5);
  const int R0 = (wave >> 1) * 16 + (swz >> 6), C0 = (wave & 1) * 32 + ((swz & 63) >> 1);
  const bf16_t* ga = A + (size_t)(m0 + R0) * K + C0;
  const bf16_t* gb = Bt + (size_t)(n0 + R0) * K + C0;
  char* stA = smem + wave * 1024;
  char* stB = smem + 16384 + wave * 1024;
  const int fl = l15 * 64 + ((g * 16) ^ ((l15 >> 3) << 5));
  const char* rdA = smem + fl + wm * 8192;
  const char* rdB = smem + 16384 + fl + wn * 8192;
#define GLDS_STAGE(BUF, KT) do { _Pragma("unroll") for (int i_ = 0; i_ < 4; ++i_) {                                                        \
    __builtin_amdgcn_global_load_lds((const unsigned*)(ga + (size_t)(32 * i_) * K + (KT) * 64), (unsigned*)(stA + (BUF) * 32768 + i_ * 4096), 16, 0, 0); \
    __builtin_amdgcn_global_load_lds((const unsigned*)(gb + (size_t)(32 * i_) * K + (KT) * 64), (unsigned*)(stB + (BUF) * 32768 + i_ * 4096), 16, 0, 0); } } while (0)
  __syncthreads();
  GLDS_STAGE(0, 0);
  asm volatile("s_waitcnt vmcnt(0)" ::: "memory");
  __syncthreads();
  if (nt > 1) GLDS_STAGE(1, 1);
  bf16x8 af0[4], bf0[4], af1[4], bf1[4];
#pragma unroll
  for (int i = 0; i < 4; ++i) af0[i] = *(const bf16x8*)(rdA + (i * 2) * 1024);
#pragma unroll
  for (int j = 0; j < 4; ++j) bf0[j] = *(const bf16x8*)(rdB + (j * 2) * 1024);
  for (int t = 0; t < nt; ++t) {
    const int cur = t & 1;
    acc[0][0] = __builtin_amdgcn_mfma_f32_16x16x32_bf16(af0[0], bf0[0], acc[0][0], 0, 0, 0);
    __builtin_amdgcn_sched_barrier(0);
#pragma unroll
    for (int q = 0; q < 8; ++q) {
      if (q < 4) af1[q] = *(const bf16x8*)(rdA + cur * 32768 + (q * 2 + 1) * 1024);
      else bf1[q - 4] = *(const bf16x8*)(rdB + cur * 32768 + ((q - 4) * 2 + 1) * 1024);
      __builtin_amdgcn_sched_barrier(0);
      { const int x = 1 + q;
        acc[x >> 2][x & 3] = __builtin_amdgcn_mfma_f32_16x16x32_bf16(af0[x >> 2], bf0[x & 3], acc[x >> 2][x & 3], 0, 0, 0); }
      __builtin_amdgcn_sched_barrier(0);
    }
#pragma unroll
    for (int x = 9; x < 16; ++x) acc[x >> 2][x & 3] = __builtin_amdgcn_mfma_f32_16x16x32_bf16(af0[x >> 2], bf0[x & 3], acc[x >> 2][x & 3], 0, 0, 0);
    __builtin_amdgcn_sched_barrier(0);
    asm volatile("s_waitcnt vmcnt(0)" ::: "memory");
    __syncthreads();
    if (t + 2 < nt) GLDS_STAGE(cur, t + 2);
    __builtin_amdgcn_sched_barrier(0);
#pragma unroll
    for (int q = 0; q < 8; ++q) {
      if (t + 1 < nt) {
        if (q < 4) af0[q] = *(const bf16x8*)(rdA + (cur ^ 1) * 32768 + (q * 2) * 1024);
        else bf0[q - 4] = *(const bf16x8*)(rdB + (cur ^ 1) * 32768 + ((q - 4) * 2) * 1024);
      }
      __builtin_amdgcn_sched_barrier(0);
      { const int x = q;
        acc[x >> 2][x & 3] = __builtin_amdgcn_mfma_f32_16x16x32_bf16(af1[x >> 2], bf1[x & 3], acc[x >> 2][x & 3], 0, 0, 0); }
      __builtin_amdgcn_sched_barrier(0);
    }
#pragma unroll
    for (int x = 8; x < 16; ++x) acc[x >> 2][x & 3] = __builtin_amdgcn_mfma_f32_16x16x32_bf16(af1[x >> 2], bf1[x & 3], acc[x >> 2][x & 3], 0, 0, 0);
    __builtin_amdgcn_sched_barrier(0);
  }
#undef GLDS_STAGE
}

template <int MX, int NX>
__device__ __forceinline__ bool xcd_tile(int bid, int nb, int k, int ntm, int ntn, int& m, int& n) {
  if ((nb & 7) || (ntm % MX) || (ntn % NX)) {
    const int t = bid + k * nb;
    if (t >= ntm * ntn) return false;
    m = t / ntn; n = t % ntn; return true;
  }
  const int x = bid & 7, q = bid >> 3, nq = nb >> 3;
  const int nloc = ntn / NX, per_x = (ntm / MX) * nloc;
  const int j = q + k * nq;
  if (j >= per_x) return false;
  m = (j / nloc) * MX + (x % MX); n = (j % nloc) * NX + (x / MX);
  return true;
}

__device__ __forceinline__ bool xcd_pair_item(int bid, int nb, int k, int npairs, int& pair, int& sub) {
  if ((nb & 7) || (npairs & 7)) {
    const int t = bid + k * nb;
    if (t >= npairs * 2) return false;
    pair = t >> 1; sub = t & 1; return true;
  }
  const int x = bid & 7, q = bid >> 3, nq = nb >> 3;
  const int j = q + k * nq;
  if (j >= (npairs >> 3) * 2) return false;
  pair = (j >> 1) * 8 + x; sub = j & 1;
  return true;
}

template <bool OUT_BF16>
__device__ __forceinline__ void ph_gemm(const bf16_t* __restrict__ A, const bf16_t* __restrict__ Bt, void* Cout, int M, int N, int K,
                        int bid, int nb, char* smem) {
  const int TIX = opaque_tid(); bid = opaque_s(bid);
  const int tid = TIX, lane = tid & 63, wave = tid >> 6;
  const int wm = wave >> 1, wn = wave & 1;
  const int ntn = N >> 7, ntm = M >> 7;
  for (int k = 0;; ++k) {
    int tm, tn;
    if (!xcd_tile<8, 1>(bid, nb, k, ntm, ntn, tm, tn)) break;
    const int m0 = tm << 7, n0 = tn << 7;
    f32x4 acc[4][4];
    gemm_tile_acc(A, Bt, K, m0, n0, smem, tid, acc);
#pragma unroll
    for (int i = 0; i < 4; ++i)
#pragma unroll
      for (int j = 0; j < 4; ++j)
#pragma unroll
        for (int r = 0; r < 4; ++r) {
          const int row = m0 + wm * 64 + i * 16 + (lane >> 4) * 4 + r;
          const int col = n0 + wn * 64 + j * 16 + (lane & 15);
          if (OUT_BF16) ((bf16_t*)Cout)[(size_t)row * N + col] = f2bf(acc[i][j][r]);
          else ((float*)Cout)[(size_t)row * N + col] = acc[i][j][r];
        }
  }
}

__device__ __forceinline__ void ph_gemm_in(const Params& p, int l, int bid, int nb, char* smem) {
  const int TIX = opaque_tid(); bid = opaque_s(bid);
  const int tid = TIX, lane = tid & 63, wave = tid >> 6;
  const int wm = wave >> 1, wn = wave & 1;
  const int g = lane >> 4, l15 = lane & 15;
  bf16_t* proj = (bf16_t*)p.big;
  const bf16_t* Bt = p.w_inT + (size_t)l * NPROJ * DM;
  constexpr int ntn = NPROJ >> 7;
  for (int k = 0;; ++k) {
    int tm, nt;
    if (!xcd_tile<2, 4>(bid, nb, k, TT >> 7, ntn, tm, nt)) break;
    const int m0 = tm << 7, n0 = nt << 7;
    {
      const size_t cu = (size_t)(bid + k * nb) * 512 + tid;
      if (cu < CVT_UNITS) cvt_uv_unit(p, l, cu);
      if (cu + 256 < CVT_UNITS) cvt_uv_unit(p, l, cu + 256);
    }
    if (l == NLAYER - 1 && m0 >= TL && (nt < 16 || nt >= 24)) continue;
    f32x4 acc[4][4];
    gemm_tile_acc(p.hA, Bt, DM, m0, n0, smem, tid, acc);
    if (nt >= 12 && nt < 20) {
      const float scl = (nt >= 16) ? 0.08838834764831845f : 1.f;
      if (m0 < TL) {
#pragma unroll
        for (int i = 0; i < 4; ++i)
#pragma unroll
          for (int r = 0; r < 4; ++r) {
            const int ii = (m0 + wm * 64 + i * 16 + g * 4 + r) & 8191;
            const int pos = wn ? (ii & 63) : (ii >> 6);
#pragma unroll
            for (int jj = 0; jj < 2; ++jj) {
              const float cs = p.ropec[pos * 32 + jj * 16 + l15], sn = p.ropes[pos * 32 + jj * 16 + l15];
              const float a = acc[i][jj][r], b = acc[i][jj + 2][r];
              acc[i][jj][r] = (a * cs - b * sn) * scl;
              acc[i][jj + 2][r] = (a * sn + b * cs) * scl;
            }
          }
      } else if (nt >= 16) {
#pragma unroll
        for (int i = 0; i < 4; ++i)
#pragma unroll
          for (int j = 0; j < 4; ++j)
#pragma unroll
            for (int r = 0; r < 4; ++r) acc[i][j][r] *= scl;
      }
    }
#pragma unroll
    for (int i = 0; i < 4; ++i)
#pragma unroll
      for (int j = 0; j < 4; ++j)
#pragma unroll
        for (int r = 0; r < 4; ++r) {
          const int row = m0 + wm * 64 + i * 16 + g * 4 + r;
          const int col = n0 + wn * 64 + j * 16 + l15;
          proj[(size_t)row * NPROJ + col] = f2bf(acc[i][j][r]);
        }
  }
}

__device__ __forceinline__ void ph_ret_upd(const Params& p, int bid, int nb, char* smem) {
  const int TIX = opaque_tid(); bid = opaque_s(bid);
  const bf16_t* proj = (const bf16_t*)p.big;
  bf16_t* Vs = (bf16_t*)smem;
  bf16_t* Ks = Vs + 64 * 136;
  const int tid = TIX, lane = tid & 63, wave = tid >> 6;
  const int wm = wave >> 1, wn = wave & 1;
  const unsigned va = tr_lane_base((unsigned)(size_t)Vs, 272u, lane) + wm * 128;
  const unsigned ka = tr_lane_base((unsigned)(size_t)Ks, 272u, lane) + wn * 128;
  const int sr = tid >> 4, sck = (tid & 15) * 8;
  for (int k = 0;; ++k) {
    int pr, dir;
    if (!xcd_pair_item(bid, nb, k, NCHUNK * 4, pr, dir)) break;
    const int c = pr >> 2, hd = pr & 3;
    const int t0 = c * 128;
    const float lg = p.lg2[dir][hd];
    const bf16_t* src = proj + (size_t)(t0 + sr) * NPROJ + hd * 128 + sck;
    u32x4 rv[4], rk[4];
#pragma unroll
    for (int i = 0; i < 4; ++i) {
      rv[i] = *(const u32x4*)(src + 2560 + (size_t)(16 * i) * NPROJ);
      rk[i] = *(const u32x4*)(src + 2048 + (size_t)(16 * i) * NPROJ);
    }
    f32x4 acc[4][4];
#pragma unroll
    for (int i = 0; i < 4; ++i)
#pragma unroll
      for (int j = 0; j < 4; ++j) acc[i][j] = zero4();
#pragma unroll
    for (int half = 0; half < 2; ++half) {
      __syncthreads();
#pragma unroll
      for (int i = 0; i < 4; ++i) {
        const int r = sr + 16 * i, sp = half * 64 + r;
        const float w = exp2f((dir == 0 ? (float)(127 - sp) : (float)sp) * lg);
        u32x4 ko;
#pragma unroll
        for (int q = 0; q < 4; ++q) ko[q] = pack2(bflo(rk[i][q]) * w, bfhi(rk[i][q]) * w);
        *(u32x4*)(Vs + r * 136 + sck) = rv[i];
        *(u32x4*)(Ks + r * 136 + sck) = ko;
      }
      __syncthreads();
      if (half == 0) {
#pragma unroll
        for (int i = 0; i < 4; ++i) {
          rv[i] = *(const u32x4*)(src + 2560 + (size_t)(64 + 16 * i) * NPROJ);
          rk[i] = *(const u32x4*)(src + 2048 + (size_t)(64 + 16 * i) * NPROJ);
        }
      }
      static_for<2>([&](auto KS) {
        constexpr int ks = decltype(KS)::value;
        bf16x8 af[4], bfr[4];
        tr_frag4<ks * 32 * 272 + 0, ks * 32 * 272 + 32, ks * 32 * 272 + 64, ks * 32 * 272 + 96, 4 * 272>(va, af[0], af[1], af[2], af[3]);
        tr_frag4<ks * 32 * 272 + 0, ks * 32 * 272 + 32, ks * 32 * 272 + 64, ks * 32 * 272 + 96, 4 * 272>(ka, bfr[0], bfr[1], bfr[2], bfr[3]);
#pragma unroll
        for (int i = 0; i < 4; ++i)
#pragma unroll
          for (int j = 0; j < 4; ++j) acc[i][j] = __builtin_amdgcn_mfma_f32_16x16x32_bf16(bfr[j], af[i], acc[i][j], 0, 0, 0);
      });
    }
    bf16_t* dst = (bf16_t*)p.st + ((size_t)(dir * NCHUNK + c) * 4 + hd) * 16384;
#pragma unroll
    for (int i = 0; i < 4; ++i)
#pragma unroll
      for (int j = 0; j < 4; ++j) {
        const int row = wm * 64 + i * 16 + (lane & 15);
        const int col = wn * 64 + j * 16 + (lane >> 4) * 4;
        uint2 o; o.x = pack2(acc[i][j][0], acc[i][j][1]); o.y = pack2(acc[i][j][2], acc[i][j][3]);
        *(uint2*)(dst + row * 128 + col) = o;
      }
  }
}

__device__ __forceinline__ void ph_ret_scan(const Params& p, int bid, int nb) {
  const int TIX = opaque_tid(); bid = opaque_s(bid);
  const int gtid = bid * 256 + TIX, gn = nb * 256;
  bf16_t* sout = (bf16_t*)p.ybuf;
  for (int idx = gtid; idx < 2 * 4 * 4 * 8192; idx += gn) {
    const int e = (idx & 8191) * 2, hd = (idx >> 13) & 3, b = (idx >> 15) & 3, dir = idx >> 17;
    const float dc = exp2f(128.f * p.lg2[dir][hd]);
    const size_t boff = (size_t)dir * NCHUNK * 4 * 16384 + (size_t)hd * 16384 + e;
    const bf16_t* __restrict__ src = (const bf16_t*)p.st + boff;
    bf16_t* __restrict__ dst = sout + boff;
    const size_t cs = (size_t)4 * 16384;
    float c0 = 0.f, c1 = 0.f;
    {
      const size_t o0 = (size_t)(256 + b * 2 + (dir ? 1 : 0)) * cs, o1 = (size_t)(256 + b * 2 + (dir ? 0 : 1)) * cs;
      const uint32_t u0 = *(const uint32_t*)(src + o0), u1 = *(const uint32_t*)(src + o1);
      *(uint32_t*)(dst + o0) = pack2(c0, c1); c0 = c0 * dc + bflo(u0); c1 = c1 * dc + bfhi(u0);
      *(uint32_t*)(dst + o1) = pack2(c0, c1); c0 = c0 * dc + bflo(u1); c1 = c1 * dc + bfhi(u1);
    }
    for (int n0 = 0; n0 < 64; n0 += 16) {
      uint32_t u[16];
#pragma unroll
      for (int i = 0; i < 16; ++i) {
        const int n = dir ? (63 - (n0 + i)) : (n0 + i);
        u[i] = *(const uint32_t*)(src + (size_t)(b * 64 + n) * cs);
      }
#pragma unroll
      for (int i = 0; i < 16; ++i) {
        const int n = dir ? (63 - (n0 + i)) : (n0 + i);
        *(uint32_t*)(dst + (size_t)(b * 64 + n) * cs) = pack2(c0, c1);
        c0 = c0 * dc + bflo(u[i]); c1 = c1 * dc + bfhi(u[i]);
      }
    }
  }
}

__device__ __forceinline__ void ph_ret_out(const Params& p, int l, int bid, int nb, char* smem) {
  const int TIX = opaque_tid(); bid = opaque_s(bid);
  const bf16_t* proj = (const bf16_t*)p.big;
  const bf16_t* sin = (const bf16_t*)p.ybuf;
  bf16_t* buf = (bf16_t*)smem;
  bf16_t* Pb = buf + 128 * 136;
  const int tid = TIX, lane = tid & 63, wave = tid >> 6;
  const unsigned ba = tr_lane_base((unsigned)(size_t)buf, 272u, lane);
  const int g = lane >> 4, l15 = lane & 15;
  bf16_t* Pw = Pb + wave * 16 * 136;
  const int sr = tid >> 4, sck = (tid & 15) * 8;
  const int nitem_ro = ((l == NLAYER - 1) ? 256 : NCHUNK) * 8;
  for (int k = 0;; ++k) {
    int pr, rh;
    if (!xcd_pair_item(bid, nb, k, nitem_ro >> 1, pr, rh)) break;
    const int c = pr >> 2, hd = pr & 3;
    const int t0 = c * 128;
    const int rw = rh * 64 + wave * 16;
    const float lgf = p.lg2[0][hd], lgb = p.lg2[1][hd];
    bf16x8 qf[4];
#pragma unroll
    for (int ks = 0; ks < 4; ++ks)
      qf[ks] = *(const bf16x8*)(proj + (size_t)(t0 + rw + l15) * NPROJ + 1536 + hd * 128 + ks * 32 + g * 8);
    u32x4 ra[8], rb[8];
    const bf16_t* kv = proj + (size_t)(t0 + sr) * NPROJ + hd * 128 + sck;
#pragma unroll
    for (int i = 0; i < 8; ++i) ra[i] = *(const u32x4*)(kv + 2048 + (size_t)(16 * i) * NPROJ);
#pragma unroll
    for (int i = 0; i < 8; ++i) rb[i] = *(const u32x4*)(kv + 2560 + (size_t)(16 * i) * NPROJ);
    const bf16_t* sf = sin + ((size_t)(0 * NCHUNK + c) * 4 + hd) * 16384 + sr * 128 + sck;
    const bf16_t* sb = sin + ((size_t)(1 * NCHUNK + c) * 4 + hd) * 16384 + sr * 128 + sck;
    __syncthreads();
#pragma unroll
    for (int i = 0; i < 8; ++i) *(u32x4*)(buf + (sr + 16 * i) * 136 + sck) = ra[i];
    __syncthreads();
#pragma unroll
    for (int i = 0; i < 8; ++i) ra[i] = *(const u32x4*)(sf + (size_t)(16 * i) * 128);
    f32x4 acc[8];
#pragma unroll
    for (int nt = 0; nt < 8; ++nt) acc[nt] = zero4();
#pragma unroll
    for (int ks = 0; ks < 4; ++ks) {
#pragma unroll
      for (int nt = 0; nt < 8; ++nt) {
        const bf16x8 bfr = *(const bf16x8*)(buf + (nt * 16 + l15) * 136 + ks * 32 + g * 8);
        acc[nt] = __builtin_amdgcn_mfma_f32_16x16x32_bf16(qf[ks], bfr, acc[nt], 0, 0, 0);
      }
    }
#pragma unroll
    for (int nt = 0; nt < 8; ++nt)
#pragma unroll
      for (int r = 0; r < 4; ++r) {
        const int tl = g * 4 + r;
        const int t = rw + tl, s2 = nt * 16 + l15;
        const float d = (s2 <= t) ? exp2f((float)(t - s2) * lgf) : exp2f((float)(s2 - t) * lgb);
        Pw[tl * 136 + s2] = f2bf(acc[nt][r] * d);
      }
    __syncthreads();
#pragma unroll
    for (int i = 0; i < 8; ++i) *(u32x4*)(buf + (sr + 16 * i) * 136 + sck) = rb[i];
    __syncthreads();
#pragma unroll
    for (int i = 0; i < 8; ++i) rb[i] = *(const u32x4*)(sb + (size_t)(16 * i) * 128);
    f32x4 o[8];
#pragma unroll
    for (int nt = 0; nt < 8; ++nt) o[nt] = zero4();
    static_for<4>([&](auto KS) {
      constexpr int ks = decltype(KS)::value;
      const bf16x8 pf = *(const bf16x8*)(Pw + l15 * 136 + ks * 32 + g * 8);
      static_for<2>([&](auto NH) {
        constexpr int nh = decltype(NH)::value;
        bf16x8 bfr[4];
        tr_frag4<ks * 32 * 272 + nh * 128 + 0, ks * 32 * 272 + nh * 128 + 32, ks * 32 * 272 + nh * 128 + 64, ks * 32 * 272 + nh * 128 + 96, 4 * 272>(
            ba, bfr[0], bfr[1], bfr[2], bfr[3]);
#pragma unroll
        for (int j = 0; j < 4; ++j) o[nh * 4 + j] = __builtin_amdgcn_mfma_f32_16x16x32_bf16(pf, bfr[j], o[nh * 4 + j], 0, 0, 0);
      });
    });
#define RO_CROSS(DIRV, REG)                                                                                     \
    {                                                                                                           \
      __syncthreads();                                                                                          \
      _Pragma("unroll") for (int i = 0; i < 8; ++i) *(u32x4*)(buf + (sr + 16 * i) * 136 + sck) = REG[i];        \
      __syncthreads();                                                                                          \
      float fr[4];                                                                                              \
      _Pragma("unroll") for (int r = 0; r < 4; ++r) {                                                           \
        const int t = rw + g * 4 + r;                                                                           \
        fr[r] = (DIRV == 0) ? exp2f((float)(t + 1) * lgf) : exp2f((float)(128 - t) * lgb);                      \
      }                                                                                                         \
      _Pragma("unroll") for (int nt = 0; nt < 8; ++nt) acc[nt] = zero4();                                       \
      _Pragma("unroll") for (int ks = 0; ks < 4; ++ks) {                                                        \
        _Pragma("unroll") for (int nt = 0; nt < 8; ++nt) {                                                      \
          const bf16x8 bfr = *(const bf16x8*)(buf + (nt * 16 + l15) * 136 + ks * 32 + g * 8);                   \
          acc[nt] = __builtin_amdgcn_mfma_f32_16x16x32_bf16(qf[ks], bfr, acc[nt], 0, 0, 0);                     \
        }                                                                                                       \
      }                                                                                                         \
      _Pragma("unroll") for (int r = 0; r < 4; ++r)                                                             \
        _Pragma("unroll") for (int nt = 0; nt < 8; ++nt) o[nt][r] += fr[r] * acc[nt][r];                        \
    }
    RO_CROSS(0, ra)
    RO_CROSS(1, rb)
#undef RO_CROSS
#pragma unroll
    for (int r = 0; r < 4; ++r) {
      const int t = t0 + rw + g * 4 + r;
#pragma unroll
      for (int nt = 0; nt < 8; ++nt) p.cat[(size_t)t * DM + 512 + hd * 128 + nt * 16 + l15] = f2bf(o[nt][r]);
    }
  }
}

__device__ __forceinline__ void ph_gnorm(const Params& p, int l, int bid, int nb) {
  const int TIX = opaque_tid(); bid = opaque_s(bid);
  const bf16_t* proj = (const bf16_t*)p.big;
  const int lane = TIX & 63;
  const int gw = bid * 4 + (TIX >> 6), nw = nb * 4;
  const float* cw = p.conv_w + ((size_t)l * 512 + lane * 8) * 3;
  float cwv[24];
#pragma unroll
  for (int i = 0; i < 24; ++i) cwv[i] = cw[i];
  const int tend = (l == NLAYER - 1) ? TL : TT;
  struct GnRaw { uint4 bg, c0, c1, c2, h0, h1, h2, ov, gv; };
  auto fetch = [&](int t, GnRaw& r) {
    const bf16_t* row = proj + (size_t)t * NPROJ;
    const int ch = lane * 8;
    bool hasl, hasr;
    if (t < TL) { const int i = t & 63; hasl = i != 0; hasr = i != 63; }
    else { const int i = (t - TL) & 255; hasl = i != 0; hasr = i != 255; }
    r.bg = *(const uint4*)(row + ch);
    r.c1 = *(const uint4*)(row + 512 + ch); r.h1 = *(const uint4*)(row + 1024 + ch);
    r.c0 = make_uint4(0, 0, 0, 0); r.h0 = r.c0; r.c2 = r.c0; r.h2 = r.c0;
    if (hasl) { r.c0 = *(const uint4*)(row - NPROJ + 512 + ch); r.h0 = *(const uint4*)(row - NPROJ + 1024 + ch); }
    if (hasr) { r.c2 = *(const uint4*)(row + NPROJ + 512 + ch); r.h2 = *(const uint4*)(row + NPROJ + 1024 + ch); }
    r.ov = *(const uint4*)(p.cat + (size_t)t * DM + 512 + lane * 8);
    r.gv = *(const uint4*)(row + 3072 + lane * 8);
  };
  GnRaw cur;
  if (gw < tend) fetch(gw, cur);
  for (int t = gw; t < tend; t += nw) {
    GnRaw nxt = cur;
    if (t + nw < tend) fetch(t + nw, nxt);
    {
      const int ch = lane * 8;
      const uint4 bg = cur.bg, c0 = cur.c0, c1 = cur.c1, c2 = cur.c2, h0 = cur.h0, h1 = cur.h1, h2 = cur.h2;
      const uint32_t bgw[4] = {bg.x, bg.y, bg.z, bg.w};
      const uint32_t c0w[4] = {c0.x, c0.y, c0.z, c0.w}, c1w[4] = {c1.x, c1.y, c1.z, c1.w}, c2w[4] = {c2.x, c2.y, c2.z, c2.w};
      const uint32_t h0w[4] = {h0.x, h0.y, h0.z, h0.w}, h1w[4] = {h1.x, h1.y, h1.z, h1.w}, h2w[4] = {h2.x, h2.y, h2.z, h2.w};
      uint32_t ow[4];
#pragma unroll
      for (int e = 0; e < 4; ++e) {
        const float z0a = bflo(c0w[e]) * bflo(h0w[e]), z1a = bflo(c1w[e]) * bflo(h1w[e]), z2a = bflo(c2w[e]) * bflo(h2w[e]);
        const float z0b = bfhi(c0w[e]) * bfhi(h0w[e]), z1b = bfhi(c1w[e]) * bfhi(h1w[e]), z2b = bfhi(c2w[e]) * bfhi(h2w[e]);
        const float ya = z0a * cwv[6 * e + 0] + z1a * cwv[6 * e + 1] + z2a * cwv[6 * e + 2];
        const float yb = z0b * cwv[6 * e + 3] + z1b * cwv[6 * e + 4] + z2b * cwv[6 * e + 5];
        ow[e] = pack2(bflo(bgw[e]) * ya, bfhi(bgw[e]) * yb);
      }
      *(uint4*)(p.cat + (size_t)t * DM + ch) = make_uint4(ow[0], ow[1], ow[2], ow[3]);
    }
    bf16_t* op = p.cat + (size_t)t * DM + 512 + lane * 8;
    const uint4 ov = cur.ov;
    const uint4 gv = cur.gv;
    float o[8], gg[8];
    o[0] = bflo(ov.x); o[1] = bfhi(ov.x); o[2] = bflo(ov.y); o[3] = bfhi(ov.y);
    o[4] = bflo(ov.z); o[5] = bfhi(ov.z); o[6] = bflo(ov.w); o[7] = bfhi(ov.w);
    gg[0] = bflo(gv.x); gg[1] = bfhi(gv.x); gg[2] = bflo(gv.y); gg[3] = bfhi(gv.y);
    gg[4] = bflo(gv.z); gg[5] = bfhi(gv.z); gg[6] = bflo(gv.w); gg[7] = bfhi(gv.w);
    float s1 = 0.f;
#pragma unroll
    for (int i = 0; i < 8; ++i) s1 += o[i];
    s1 = row16_sum(s1);
    const float mu = s1 * (1.f / 128.f);
    float s2 = 0.f;
#pragma unroll
    for (int i = 0; i < 8; ++i) { const float d = o[i] - mu; s2 += d * d; }
    s2 = row16_sum(s2);
    const float rs = rsqrtf(s2 * (1.f / 128.f) + 1e-5f);
    float y[8];
#pragma unroll
    for (int i = 0; i < 8; ++i) y[i] = silu_f(gg[i]) * (o[i] - mu) * rs;
    *(uint4*)op = make_uint4(pack2(y[0], y[1]), pack2(y[2], y[3]), pack2(y[4], y[5]), pack2(y[6], y[7]));
    cur = nxt;
  }
}

__device__ __forceinline__ void ph_ln(const Params& p, int l, int which, int bid, int nb) {
  const int TIX = opaque_tid(); bid = opaque_s(bid);
  const int lane = TIX & 63;
  const int gw = bid * 4 + (TIX >> 6), nw = nb * 4;
  const bool last = (l == NLAYER - 1);
  const int tend = last ? TL : TT;
  bf16_t* xres = (bf16_t*)p.xres;
  const bf16_t* ybf = (const bf16_t*)p.ybuf;
  (void)which;
  float4 pgg[4], pbb[4], pgv[4], psh[4], psc[4];
#pragma unroll
  for (int i = 0; i < 4; ++i) {
    pgg[i] = *(const float4*)(p.ln1_g + (size_t)l * DM + lane * 16 + 4 * i);
    pbb[i] = *(const float4*)(p.ln1_b + (size_t)l * DM + lane * 16 + 4 * i);
    pgv[i] = pgg[i]; psh[i] = pgg[i]; psc[i] = pgg[i];
  }
  int cur_row = -1;
  uint4 xa, xb, ya, yb;
  float4 xf[4];
#define LN_FETCH(T, XA, XB, YA, YB, XF) {                                                                                       \
    if (l == 0) { const float* xs_ = ((T) < TL ? p.x + (size_t)(T) * DM : p.ctx + (size_t)((T) - TL) * DM) + lane * 16;        \
      _Pragma("unroll") for (int i = 0; i < 4; ++i) XF[i] = *(const float4*)(xs_ + 4 * i); }                                     \
    else { const bf16_t* xs_ = xres + (size_t)(T) * DM + lane * 16; XA = *(const uint4*)xs_; XB = *(const uint4*)(xs_ + 8); }    \
    const bf16_t* ys_ = ybf + (size_t)(T) * DM + lane * 16; YA = *(const uint4*)ys_; YB = *(const uint4*)(ys_ + 8); }
  if (gw < tend) LN_FETCH(gw, xa, xb, ya, yb, xf)
  for (int t = gw; t < tend; t += nw) {
    uint4 nxa = xa, nxb = xb, nya = ya, nyb = yb; float4 nxf[4] = {xf[0], xf[1], xf[2], xf[3]};
    if (t + nw < tend) LN_FETCH(t + nw, nxa, nxb, nya, nyb, nxf)
    const int mr = mod_row(t);
    if (mr != cur_row) {
      cur_row = mr;
      const float* m = p.mod + (size_t)(l * 5 + mr) * 6144 + lane * 16;
#pragma unroll
      for (int i = 0; i < 4; ++i) { pgv[i] = *(const float4*)(m + 2048 + 4 * i); psh[i] = *(const float4*)(m + 3072 + 4 * i); psc[i] = *(const float4*)(m + 4096 + 4 * i); }
    }
    const uint32_t xw[8] = {xa.x, xa.y, xa.z, xa.w, xb.x, xb.y, xb.z, xb.w};
    const uint32_t yw[8] = {ya.x, ya.y, ya.z, ya.w, yb.x, yb.y, yb.z, yb.w};
    float v[16];
    float s1 = 0.f;
#pragma unroll
    for (int i = 0; i < 4; ++i) {
      const float4 xv = (l == 0) ? xf[i] : make_float4(bflo(xw[2 * i]), bfhi(xw[2 * i]), bflo(xw[2 * i + 1]), bfhi(xw[2 * i + 1]));
      const float4 gv = pgv[i];
      v[4 * i + 0] = ALPHA_F * xv.x + gv.x * bflo(yw[2 * i]); v[4 * i + 1] = ALPHA_F * xv.y + gv.y * bfhi(yw[2 * i]);
      v[4 * i + 2] = ALPHA_F * xv.z + gv.z * bflo(yw[2 * i + 1]); v[4 * i + 3] = ALPHA_F * xv.w + gv.w * bfhi(yw[2 * i + 1]);
      s1 += v[4 * i + 0] + v[4 * i + 1] + v[4 * i + 2] + v[4 * i + 3];
    }
    const float mu = wave_sum(s1) * (1.f / 1024.f);
    float s2 = 0.f;
#pragma unroll
    for (int i = 0; i < 16; ++i) { const float d = v[i] - mu; s2 += d * d; }
    const float rs = rsqrtf(wave_sum(s2) * (1.f / 1024.f) + 1e-5f);
    uint32_t xo[8], hw[8];
#pragma unroll
    for (int i = 0; i < 4; ++i) {
      const float4 gg = pgg[i], bb = pbb[i], sh = psh[i], sc = psc[i];
      float4 o;
      o.x = (v[4 * i + 0] - mu) * rs * gg.x + bb.x; o.y = (v[4 * i + 1] - mu) * rs * gg.y + bb.y;
      o.z = (v[4 * i + 2] - mu) * rs * gg.z + bb.z; o.w = (v[4 * i + 3] - mu) * rs * gg.w + bb.w;
      xo[2 * i] = pack2(o.x, o.y); xo[2 * i + 1] = pack2(o.z, o.w);
      hw[2 * i] = pack2(o.x * (1.f + sc.x) + sh.x, o.y * (1.f + sc.y) + sh.y);
      hw[2 * i + 1] = pack2(o.z * (1.f + sc.z) + sh.z, o.w * (1.f + sc.w) + sh.w);
    }
    bf16_t* xd = xres + (size_t)t * DM + lane * 16;
    *(uint4*)xd = make_uint4(xo[0], xo[1], xo[2], xo[3]);
    *(uint4*)(xd + 8) = make_uint4(xo[4], xo[5], xo[6], xo[7]);
    bf16_t* hd = p.hA + (size_t)t * DM + lane * 16;
    *(uint4*)hd = make_uint4(hw[0], hw[1], hw[2], hw[3]);
    *(uint4*)(hd + 8) = make_uint4(hw[4], hw[5], hw[6], hw[7]);
    xa = nxa; xb = nxb; ya = nya; yb = nyb;
#pragma unroll
    for (int i = 0; i < 4; ++i) xf[i] = nxf[i];
  }
#undef LN_FETCH
}

#define CE_DESC(A, B) { const unsigned hi_ = max(A, B), lo_ = min(A, B); A = hi_; B = lo_; }
__device__ __forceinline__ unsigned key_enc(float x, unsigned lowmask, unsigned tag) {
  const unsigned b = __float_as_uint(x);
  const unsigned sgn = (unsigned)((int)b >> 31) | 0x80000000u;
  return ((b ^ sgn) & ~lowmask) | tag;
}
__device__ __forceinline__ float key_val(unsigned key, unsigned lowmask) {
  const unsigned sv = key & ~lowmask;
  return __uint_as_float((sv & 0x80000000u) ? (sv ^ 0x80000000u) : ~sv);
}
__device__ __forceinline__ void sort16_desc(unsigned (&k)[16]) {
#pragma unroll
  for (int size = 2; size <= 16; size <<= 1) {
#pragma unroll
    for (int stride = size >> 1; stride >= 1; stride >>= 1) {
#pragma unroll
      for (int i = 0; i < 16; ++i) {
        if ((i & stride) == 0) {
          const int j = i | stride;
          if ((i & size) == 0 || size == 16) { CE_DESC(k[i], k[j]) } else { CE_DESC(k[j], k[i]) }
        }
      }
    }
  }
}
__device__ __forceinline__ void merge16_desc(unsigned (&r)[16], const unsigned (&c)[16]) {
#pragma unroll
  for (int i = 0; i < 16; ++i) r[i] = max(r[i], c[15 - i]);
#pragma unroll
  for (int stride = 8; stride >= 1; stride >>= 1) {
#pragma unroll
    for (int i = 0; i < 16; ++i) {
      if ((i & stride) == 0) { CE_DESC(r[i], r[i | stride]) }
    }
  }
}

__device__ __forceinline__ void pair_merge16(unsigned (&r)[16]) {
  unsigned c[16];
#pragma unroll
  for (int i = 0; i < 16; ++i) c[i] = (unsigned)__builtin_amdgcn_update_dpp(0, (int)r[i], 0xB1, 0xF, 0xF, true);
  merge16_desc(r, c);
}

__device__ __forceinline__ void ph_wk_topk(const Params& p, int l, int bid, int nb, char* smem) {
  const int TIX = opaque_tid(); bid = opaque_s(bid);
  const int tid = TIX, lane = tid & 63, wave = tid >> 6;
  const int wm = wave >> 1, wn = wave & 1;
  float* sc = (float*)smem;
  const bf16_t* Bt = p.wkT + (size_t)l * 2048 * DM;
  const int trow = tid >> 1, thalf = tid & 1;
  const int nitem_wk = (((l == NLAYER - 1) ? TL : TT) / 128) * 8;
  for (int k = 0;; ++k) {
    int tm, hh;
    if (!xcd_tile<4, 2>(bid, nb, k, nitem_wk >> 3, 8, tm, hh)) break;
    const int m0 = tm << 7;
    unsigned K0[16];
#pragma unroll
    for (int i = 0; i < 16; ++i) K0[i] = 0u;
    for (int ph = 0; ph < 2; ++ph) {
      f32x4 acc[4][4];
      gemm_tile_acc(p.hA, Bt, DM, m0, (hh * 2 + ph) * 128, smem, tid, acc);
#pragma unroll
      for (int i = 0; i < 4; ++i)
#pragma unroll
        for (int j = 0; j < 4; ++j)
#pragma unroll
          for (int r = 0; r < 4; ++r)
            sc[(wm * 64 + i * 16 + (lane >> 4) * 4 + r) * 130 + wn * 65 + j * 16 + (lane & 15)] = acc[i][j][r];
      __syncthreads();
      {
        float* row = sc + trow * 130 + thalf * 65;
        unsigned R[16];
#pragma unroll
        for (int i = 0; i < 16; ++i) R[i] = key_enc(row[i], 127u, 127u - (unsigned)(thalf * 64 + i));
        sort16_desc(R);
#pragma unroll 1
        for (int c = 1; c < 4; ++c) {
          unsigned C[16];
#pragma unroll
          for (int i = 0; i < 16; ++i) C[i] = key_enc(row[c * 16 + i], 127u, 127u - (unsigned)(thalf * 64 + c * 16 + i));
          sort16_desc(C);
          merge16_desc(R, C);
        }
        pair_merge16(R);
        if (ph == 0) {
#pragma unroll
          for (int i = 0; i < 16; ++i) K0[i] = R[i];
        } else {
          float av[16], bv[16];
          int* tab = (int*)(sc + trow * 130);
#pragma unroll
          for (int i = 0; i < 16; ++i) {
            av[i] = key_val(K0[i], 127u); bv[i] = key_val(R[i], 127u);
            tab[i] = 127 - (int)(K0[i] & 127u); tab[16 + i] = 127 - (int)(R[i] & 127u);
          }
          unsigned QA[16], QB[16];
#pragma unroll
          for (int i = 0; i < 16; ++i) { QA[i] = 0u; QB[i] = 0u; }
          {
            int n = 0;
#pragma unroll
            for (int i = 0; i < 16; ++i) {
#pragma unroll
              for (int j = 0; j < 16; ++j) {
                if ((i + 1) * (j + 1) <= 16) {
                  const unsigned key = key_enc(av[i] + bv[j], 255u, 255u - (unsigned)(i * 16 + j));
                  const int ch = n >> 4, sl = n & 15;
                  if (ch == 0) QA[sl] = thalf ? QA[sl] : key;
                  if (ch == 1) QB[sl] = thalf ? QB[sl] : key;
                  if (ch == 2) QA[sl] = thalf ? key : QA[sl];
                  if (ch == 3) QB[sl] = thalf ? key : QB[sl];
                  ++n;
                }
              }
            }
          }
          sort16_desc(QA); sort16_desc(QB);
          merge16_desc(QA, QB);
          pair_merge16(QA);
          float e[16], sum = 0.f;
          const float cv0 = key_val(QA[0], 255u);
#pragma unroll
          for (int i = 0; i < 16; ++i) { e[i] = __expf(key_val(QA[i], 255u) - cv0); sum += e[i]; }
          const float inv = 1.f / sum;
          const unsigned hm = thalf ? 0xFFFFFFFFu : 0u;
          int ce[8]; float ge[8];
#pragma unroll
          for (int i = 0; i < 8; ++i) {
            const unsigned key = (QA[8 + i] & hm) | (QA[i] & ~hm);
            const unsigned flat = 255u - (key & 255u);
            ce[i] = tab[flat >> 4] * 128 + tab[16 + (flat & 15u)];
            ge[i] = __uint_as_float((__float_as_uint(e[8 + i]) & hm) | (__float_as_uint(e[i]) & ~hm)) * inv;
          }
          const size_t o = ((size_t)(m0 + trow) * 8 + hh) * 16 + thalf * 8;
          int4* de = (int4*)(p.pe + o);
          float4* dg = (float4*)(p.pg + o);
          de[0] = make_int4(ce[0], ce[1], ce[2], ce[3]); de[1] = make_int4(ce[4], ce[5], ce[6], ce[7]);
          dg[0] = make_float4(ge[0], ge[1], ge[2], ge[3]); dg[1] = make_float4(ge[4], ge[5], ge[6], ge[7]);
        }
      }
    }
  }
}

typedef float f32x2 __attribute__((ext_vector_type(2)));

#define DPPI(V, CTRL) __builtin_amdgcn_update_dpp(0, (V), (CTRL), 0xF, 0xF, true)
__device__ __forceinline__ int reduce16_transpose_i(const int (&v)[16], int lane) {
  const bool b0 = lane & 1, b1 = lane & 2, b2 = lane & 4, b3 = lane & 8;
  int w[8], x[4], y[2];
#pragma unroll
  for (int i = 0; i < 8; ++i) {
    const int mine = b0 ? v[2 * i + 1] : v[2 * i], other = b0 ? v[2 * i] : v[2 * i + 1];
    w[i] = mine + DPPI(other, 0xB1);
  }
#pragma unroll
  for (int i = 0; i < 4; ++i) {
    const int mine = b1 ? w[2 * i + 1] : w[2 * i], other = b1 ? w[2 * i] : w[2 * i + 1];
    x[i] = mine + DPPI(other, 0x4E);
  }
#pragma unroll
  for (int i = 0; i < 2; ++i) {
    const int mine = b2 ? x[2 * i + 1] : x[2 * i], other = b2 ? x[2 * i] : x[2 * i + 1];
    const int up = DPPI(other, 0x104), dn = DPPI(other, 0x114);
    y[i] = mine + (b2 ? dn : up);
  }
  const int mine = b3 ? y[1] : y[0], other = b3 ? y[0] : y[1];
  int z = mine + DPPI(other, 0x128);
  z += __shfl_xor(z, 16);
  z += __shfl_xor(z, 32);
  return z;
}

#define GBS 16
#define GBV 8
#define GGT 8
__device__ __forceinline__ void wave_sort128(int& a, int& b, int lane) {
#pragma unroll
  for (int size = 2; size <= 128; size <<= 1) {
#pragma unroll
    for (int stride = size >> 1; stride >= 1; stride >>= 1) {
      if (stride == 64) {
        const int lo = min(a, b), hi = max(a, b); a = lo; b = hi;
      } else {
        const int pa = __shfl_xor(a, stride), pb = __shfl_xor(b, stride);
        const bool lower = (lane & stride) == 0;
        const bool asc_a = (lane & size) == 0, asc_b = ((lane + 64) & size) == 0;
        a = (lower == asc_a) ? min(a, pa) : max(a, pa);
        b = (lower == asc_b) ? min(b, pb) : max(b, pb);
      }
    }
  }
}

template <int GT>
__device__ __forceinline__ void gather_group(const Params& p, const int l, const int tb, const int lane, const unsigned char* ut,
                                             const unsigned char* vt, const bool last, const float* lg, const float* lb,
                                             int* es, float* gs, uint4* hqs) {
    float hsc[GT];
#pragma unroll
    for (int j = 0; j < GT; ++j) {
      const size_t t = (size_t)(tb + j);
      int ka = (p.pe[t * 128 + lane] << 7) | lane, kb2 = (p.pe[t * 128 + 64 + lane] << 7) | (64 + lane);
      const float ga = p.pg[t * 128 + lane], gb = p.pg[t * 128 + 64 + lane];
      wave_sort128(ka, kb2, lane);
      const int ia = ka & 127, ib = kb2 & 127;
      const float xa = __shfl(ga, ia & 63), ya = __shfl(gb, ia & 63);
      const float xb = __shfl(ga, ib & 63), yb = __shfl(gb, ib & 63);
      es[j * 128 + lane] = ka >> 7; es[j * 128 + 64 + lane] = kb2 >> 7;
      gs[j * 128 + lane] = ia < 64 ? xa : ya; gs[j * 128 + 64 + lane] = ib < 64 ? xb : yb;
      const bf16_t* hrow = p.hA + t * DM + lane * 16;
      const uint4 h0 = *(const uint4*)hrow, h1 = *(const uint4*)(hrow + 8);
      float hf[16];
      hf[0] = bflo(h0.x); hf[1] = bfhi(h0.x); hf[2] = bflo(h0.y); hf[3] = bfhi(h0.y);
      hf[4] = bflo(h0.z); hf[5] = bfhi(h0.z); hf[6] = bflo(h0.w); hf[7] = bfhi(h0.w);
      hf[8] = bflo(h1.x); hf[9] = bfhi(h1.x); hf[10] = bflo(h1.y); hf[11] = bfhi(h1.y);
      hf[12] = bflo(h1.z); hf[13] = bfhi(h1.z); hf[14] = bflo(h1.w); hf[15] = bfhi(h1.w);
      float mx = 0.f;
#pragma unroll
      for (int i = 0; i < 16; ++i) mx = fmaxf(mx, fabsf(hf[i]));
#pragma unroll
      for (int o = 32; o > 0; o >>= 1) mx = fmaxf(mx, __shfl_xor(mx, o));
      mx = fmaxf(mx, 1e-20f);
      const float qs = 127.f / mx;
      hsc[j] = mx * (1.f / 127.f) * (1.f / QSCALE_U);
      hqs[j * 64 + lane] = make_uint4(pack_i8x4(hf[0] * qs, hf[1] * qs, hf[2] * qs, hf[3] * qs), pack_i8x4(hf[4] * qs, hf[5] * qs, hf[6] * qs, hf[7] * qs),
                                      pack_i8x4(hf[8] * qs, hf[9] * qs, hf[10] * qs, hf[11] * qs), pack_i8x4(hf[12] * qs, hf[13] * qs, hf[14] * qs, hf[15] * qs));
    }
#pragma unroll 1
    for (int bi = 0; bi < 128 / GBS; ++bi) {
#pragma unroll
      for (int j = 0; j < GT; ++j) {
        uint4 uw[GBS];
        const int esrc = es[j * 128 + bi * GBS + (lane & (GBS - 1))];
#pragma unroll
        for (int u = 0; u < GBS; ++u) {
          const int e = __builtin_amdgcn_readlane(esrc, u);
          uw[u] = *(const uint4*)(ut + (size_t)e * DM);
        }
        int d[GBS];
        const uint4 hqj = hqs[j * 64 + lane];
#pragma unroll
        for (int u = 0; u < GBS; ++u) {
          int dd = __builtin_amdgcn_sdot4((int)uw[u].x, (int)hqj.x, 0, false);
          dd = __builtin_amdgcn_sdot4((int)uw[u].y, (int)hqj.y, dd, false);
          dd = __builtin_amdgcn_sdot4((int)uw[u].z, (int)hqj.z, dd, false);
          dd = __builtin_amdgcn_sdot4((int)uw[u].w, (int)hqj.w, dd, false);
          d[u] = dd;
        }
        static_assert(GBS == 16, "reduce16_transpose handles 16 pairs per batch");
        const float dsel = (float)reduce16_transpose_i(d, lane) * hsc[j];
        const float gsel = gs[j * 128 + bi * GBS + (lane & (GBS - 1))];
        const float a = gsel * 0.5f * dsel * (1.f + erff(dsel * 0.7071067811865476f)) * (1.f / SCALE_V);
        if (lane < GBS) gs[j * 128 + bi * GBS + lane] = a;
        asm volatile("" ::: "memory");
        __builtin_amdgcn_sched_barrier(0);
      }
    }
    constexpr int GV = (GT > 4) ? 4 : GT;
#pragma unroll 1
    for (int j0 = 0; j0 < GT; j0 += GV) {
    f32x2 acc2[GV][8];
#pragma unroll
    for (int j = 0; j < GV; ++j)
#pragma unroll
      for (int i = 0; i < 8; ++i) acc2[j][i] = f32x2{0.f, 0.f};
#pragma unroll 1
    for (int bi = 0; bi < 128 / GBV; ++bi) {
#pragma unroll
      for (int j = 0; j < GV; ++j) {
        uint4 vw[GBV]; float aa[GBV];
        const int esrc = es[(j0 + j) * 128 + bi * GBV + (lane & (GBV - 1))];
        const int gsrc = __builtin_bit_cast(int, gs[(j0 + j) * 128 + bi * GBV + (lane & (GBV - 1))]);
#pragma unroll
        for (int u = 0; u < GBV; ++u) {
          const int e = __builtin_amdgcn_readlane(esrc, u);
          aa[u] = __builtin_bit_cast(float, __builtin_amdgcn_readlane(gsrc, u));
          vw[u] = *(const uint4*)(vt + (size_t)e * DM);
        }
#pragma unroll
        for (int u = 0; u < GBV; ++u) {
          uint32_t w0 = vw[u].x, w1 = vw[u].y, w2 = vw[u].z, w3 = vw[u].w;
          asm volatile("" : "+v"(w0), "+v"(w1), "+v"(w2), "+v"(w3) : "v"(acc2[j][0]), "v"(acc2[j][7]));
          const f32x2 a2 = f32x2{aa[u], aa[u]};
          acc2[j][0] += __builtin_amdgcn_cvt_pk_f32_fp8((int)w0, false) * a2;
          acc2[j][1] += __builtin_amdgcn_cvt_pk_f32_fp8((int)w0, true) * a2;
          acc2[j][2] += __builtin_amdgcn_cvt_pk_f32_fp8((int)w1, false) * a2;
          acc2[j][3] += __builtin_amdgcn_cvt_pk_f32_fp8((int)w1, true) * a2;
          acc2[j][4] += __builtin_amdgcn_cvt_pk_f32_fp8((int)w2, false) * a2;
          acc2[j][5] += __builtin_amdgcn_cvt_pk_f32_fp8((int)w2, true) * a2;
          acc2[j][6] += __builtin_amdgcn_cvt_pk_f32_fp8((int)w3, false) * a2;
          acc2[j][7] += __builtin_amdgcn_cvt_pk_f32_fp8((int)w3, true) * a2;
        }
        asm volatile("" ::: "memory");
        __builtin_amdgcn_sched_barrier(0);
      }
    }
    float acc[GV][16];
#pragma unroll
    for (int j = 0; j < GV; ++j)
#pragma unroll
      for (int i = 0; i < 8; ++i) { acc[j][2 * i] = acc2[j][i].x; acc[j][2 * i + 1] = acc2[j][i].y; }
    float4 pgv[4], pgg[4], pbb[4], psh[4], psc[4];
    {
      const int t0 = tb + j0;
      const float* m = p.mod + (size_t)(l * 5 + mod_row(t0)) * 6144 + lane * 16;
      const float* m2 = p.mod + (size_t)((last ? l : l + 1) * 5 + mod_row(t0)) * 6144 + lane * 16;
#pragma unroll
      for (int i = 0; i < 4; ++i) {
        pgv[i] = *(const float4*)(m + 5120 + 4 * i);
        pgg[i] = *(const float4*)(lg + 4 * i); pbb[i] = *(const float4*)(lb + 4 * i);
        psh[i] = *(const float4*)(m2 + 4 * i); psc[i] = *(const float4*)(m2 + 1024 + 4 * i);
      }
    }
#pragma unroll
    for (int j = 0; j < GV; ++j) {
      __builtin_amdgcn_sched_barrier(0);
      const int t = tb + j0 + j;
      bf16_t* xr = (bf16_t*)p.xres + (size_t)t * DM + lane * 16;
      const uint4 xb0 = *(const uint4*)xr, xb1 = *(const uint4*)(xr + 8);
      const uint32_t xw[8] = {xb0.x, xb0.y, xb0.z, xb0.w, xb1.x, xb1.y, xb1.z, xb1.w};
      float v[16];
      float s1 = 0.f;
#pragma unroll
      for (int i = 0; i < 4; ++i) {
        const float4 xv = make_float4(bflo(xw[2 * i]), bfhi(xw[2 * i]), bflo(xw[2 * i + 1]), bfhi(xw[2 * i + 1]));
        const float4 gv = pgv[i];
        v[4 * i + 0] = ALPHA_F * xv.x + gv.x * acc[j][4 * i + 0]; v[4 * i + 1] = ALPHA_F * xv.y + gv.y * acc[j][4 * i + 1];
        v[4 * i + 2] = ALPHA_F * xv.z + gv.z * acc[j][4 * i + 2]; v[4 * i + 3] = ALPHA_F * xv.w + gv.w * acc[j][4 * i + 3];
        s1 += v[4 * i + 0] + v[4 * i + 1] + v[4 * i + 2] + v[4 * i + 3];
      }
      const float mu = wave_sum(s1) * (1.f / 1024.f);
      float s2 = 0.f;
#pragma unroll
      for (int i = 0; i < 16; ++i) { const float dlt = v[i] - mu; s2 += dlt * dlt; }
      const float rs = rsqrtf(wave_sum(s2) * (1.f / 1024.f) + 1e-5f);
      uint32_t hw[8], xo[8];
#pragma unroll
      for (int i = 0; i < 4; ++i) {
        const float4 gg = pgg[i];
        const float4 bb = pbb[i];
        float4 o;
        o.x = (v[4 * i + 0] - mu) * rs * gg.x + bb.x; o.y = (v[4 * i + 1] - mu) * rs * gg.y + bb.y;
        o.z = (v[4 * i + 2] - mu) * rs * gg.z + bb.z; o.w = (v[4 * i + 3] - mu) * rs * gg.w + bb.w;
        xo[2 * i] = pack2(o.x, o.y); xo[2 * i + 1] = pack2(o.z, o.w);
        if (last && t < TL) *(float4*)(p.out + (size_t)t * DM + lane * 16 + 4 * i) = o;
        const float4 sh = psh[i];
        const float4 sc = psc[i];
        hw[2 * i] = pack2(o.x * (1.f + sc.x) + sh.x, o.y * (1.f + sc.y) + sh.y);
        hw[2 * i + 1] = pack2(o.z * (1.f + sc.z) + sh.z, o.w * (1.f + sc.w) + sh.w);
      }
      *(uint4*)xr = make_uint4(xo[0], xo[1], xo[2], xo[3]);
      *(uint4*)(xr + 8) = make_uint4(xo[4], xo[5], xo[6], xo[7]);
      bf16_t* hd = p.hA + (size_t)t * DM + lane * 16;
      *(uint4*)hd = make_uint4(hw[0], hw[1], hw[2], hw[3]);
      *(uint4*)(hd + 8) = make_uint4(hw[4], hw[5], hw[6], hw[7]);
    }
    }
}

__device__ __forceinline__ void ph_gather_sorted(const Params& p, int l, int bid, int nb, char* smem) {
  const int TIX = opaque_tid(); bid = opaque_s(bid);
  const int lane = TIX & 63;
  const int gw = bid * 4 + (TIX >> 6), nw = nb * 4;
  const unsigned char* ut = (const unsigned char*)p.ubf + lane * 16;
  const unsigned char* vt = (const unsigned char*)p.vbf + lane * 16;
  const bool last = (l == NLAYER - 1);
  const float* lg = p.ln2_g + (size_t)l * DM + lane * 16;
  const float* lb = p.ln2_b + (size_t)l * DM + lane * 16;
  int* es = (int*)(smem + (TIX >> 6) * (GGT * 2048));
  float* gs = (float*)(es + GGT * 128);
  uint4* hqs = (uint4*)(gs + GGT * 128);
  for (int grp = gw; grp < TL / GGT; grp += nw) gather_group<GGT>(p, l, grp * GGT, lane, ut, vt, last, lg, lb, es, gs, hqs);
  if (!last) for (int t = TL + gw; t < TT; t += nw) gather_group<1>(p, l, t, lane, ut, vt, last, lg, lb, es, gs, hqs);
}

enum { PH_PRE_A = 0, PH_PRE_B, PH_INIT, PH_GEMM_IN, PH_ELEM, PH_RET_UPD, PH_RET_SCAN, PH_RET_OUT, PH_GEMM_OUT, PH_LN1,
       PH_GEMM_WK, PH_TOPK1, PH_TOPK2, PH_GATHER, PH_LN2, PH_GNORM };

__device__ __forceinline__ void run_phase(const Params& p, int ph, int l, int bid, int nb, char* smem) {
  switch (ph) {
    case PH_PRE_A:
      ph_mod_partial(p, bid, nb, smem);
      for (int ll = 0; ll < NLAYER; ++ll) {
        ph_transpose_cvt(p.w_in + (size_t)ll * DM * NPROJ, p.w_inT + (size_t)ll * NPROJ * DM, DM, NPROJ, bid, nb, smem);
        ph_transpose_cvt(p.w_out + (size_t)ll * DM * DM, p.w_outT + (size_t)ll * DM * DM, DM, DM, bid, nb, smem);
      }
      ph_wk_fold(p, bid, nb, smem);
      break;
    case PH_PRE_B: ph_mod_reduce(p, bid, nb); break;
    case PH_INIT: ph_init_h(p, bid, nb); break;
    case PH_GEMM_IN:
      ph_gemm_in(p, l, bid, nb, smem);
      break;
    case PH_RET_UPD: ph_ret_upd(p, bid, nb, smem); break;
    case PH_RET_SCAN: ph_ret_scan(p, bid, nb); break;
    case PH_RET_OUT: ph_ret_out(p, l, bid, nb, smem); break;
    case PH_GEMM_OUT: ph_gemm<true>(p.cat, p.w_outT + (size_t)l * DM * DM, p.ybuf, (l == NLAYER - 1) ? TL : TT, DM, DM, bid, nb, smem); break;
    case PH_LN1: ph_ln(p, l, 1, bid, nb); break;
    case PH_GEMM_WK: ph_wk_topk(p, l, bid, nb, smem); break;
    case PH_GATHER: ph_gather_sorted(p, l, bid, nb, smem); break;
    case PH_GNORM: ph_gnorm(p, l, bid, nb); break;
  }
}

extern __shared__ __attribute__((aligned(16))) char dyn_smem[];

#define XB_TMO      128
#define XB_XCNT(j)  (256  + 64 * (j))
#define XB_XSUB(j)  (1280 + 64 * (j))
#define XB_XGEN(j)  (2304 + 64 * (j))
#define XB_TOP      3328
#define XB_TOPGEN   3392
#define XCD_BAR_WORDS 3456
#define XB_SPIN_CAP (1u << 22)
__device__ __forceinline__ unsigned xb_ld(unsigned* q)              { return __hip_atomic_load(q, __ATOMIC_RELAXED, __HIP_MEMORY_SCOPE_AGENT); }
__device__ __forceinline__ unsigned xb_add(unsigned* q, unsigned v) { return __hip_atomic_fetch_add(q, v, __ATOMIC_RELAXED, __HIP_MEMORY_SCOPE_AGENT); }
__device__ __forceinline__ unsigned xb_xcc_id() { return (unsigned)__builtin_amdgcn_s_getreg((3 << 11) | 20) & 0xFu; }
#define XB_SPIN(cond, bar) do { unsigned _sp = 0; while (cond) { __builtin_amdgcn_s_sleep(1); \
    if ((++_sp & 255u) == 0u) { if (xb_ld(&(bar)[XB_TMO])) break; if (_sp > XB_SPIN_CAP) { atomicAdd(&(bar)[XB_TMO], 1u); break; } } } } while (0)
struct XcdBarrier { unsigned* bar; unsigned x; volatile unsigned* st; };
__device__ __forceinline__ XcdBarrier xcd_barrier_post(unsigned* bar, volatile unsigned* st) {
  XcdBarrier b; b.bar = bar; b.x = xb_xcc_id(); b.st = st;
  if (threadIdx.x == 0) (void)xb_add(&bar[XB_XCNT(b.x)], 1u);
  return b;
}
__device__ __forceinline__ void xcd_barrier_complete(unsigned* bar, unsigned x, unsigned& nloc, unsigned& nx) {
  const unsigned G = gridDim.x * gridDim.y * gridDim.z;
  unsigned sum, cnt, mine, sp = 0u;
  for (;;) {
    sum = 0u; cnt = 0u; mine = 0u;
#pragma unroll
    for (unsigned j = 0; j < 16; ++j) { const unsigned c = xb_ld(&bar[XB_XCNT(j)]); sum += c; cnt += (c > 0u) ? 1u : 0u; mine = (j == x) ? c : mine; }
    if (sum == G) break;
    __builtin_amdgcn_s_sleep(1);
    if ((++sp & 255u) == 0u) { if (xb_ld(&bar[XB_TMO])) break; if (sp > XB_SPIN_CAP) { atomicAdd(&bar[XB_TMO], 1u); break; } }
  }
  nloc = mine > 0u ? mine : 1u; nx = cnt > 0u ? cnt : 1u;
}
__device__ __forceinline__ void xcd_barrier(const XcdBarrier& b) {
  asm volatile("s_waitcnt vmcnt(0)" ::: "memory");
  __syncthreads();
  if (threadIdx.x == 0) {
    unsigned* bar = b.bar;
    __builtin_amdgcn_s_waitcnt(0);
    unsigned nloc = b.st[0], nx = b.st[1];
    if (nloc == 0u) { xcd_barrier_complete(bar, b.x, nloc, nx); b.st[0] = nloc; b.st[1] = nx; }
    const unsigned old = xb_add(&bar[XB_XSUB(b.x)], 1u);
    const unsigned gen = old / nloc;
    if (old + 1u == (gen + 1u) * nloc) {
      __builtin_amdgcn_fence(__ATOMIC_RELEASE, "agent");
      asm volatile("s_waitcnt vmcnt(0)" ::: "memory");
      const unsigned og = xb_add(&bar[XB_TOP], 1u);
      const unsigned tg = og / nx;
      if (og + 1u == (tg + 1u) * nx) xb_add(&bar[XB_TOPGEN], 1u);
      else XB_SPIN(xb_ld(&bar[XB_TOPGEN]) == tg, bar);
      __builtin_amdgcn_fence(__ATOMIC_ACQUIRE, "agent");
      xb_add(&bar[XB_XGEN(b.x)], 1u);
      asm volatile("s_waitcnt vmcnt(0)" ::: "memory");
    } else {
      XB_SPIN(xb_ld(&bar[XB_XGEN(b.x)]) == gen, bar);
      __builtin_amdgcn_fence(__ATOMIC_ACQUIRE, "agent");
      asm volatile("s_waitcnt vmcnt(0)" ::: "memory");
    }
  }
  __syncthreads();
}

__global__ void __launch_bounds__(256, 2) k_mega(Params p) {
  cg::grid_group grid = cg::this_grid();
  const int bid = blockIdx.x, nb = gridDim.x;
  volatile unsigned* xst = (volatile unsigned*)(dyn_smem + 66560);
  if (threadIdx.x == 0) { xst[0] = 0u; xst[1] = 0u; xst[2] = 0u; xst[3] = 0u; }
  __syncthreads();
  const XcdBarrier xb = xcd_barrier_post(p.bar, xst);
#define GSYNC() xcd_barrier(xb)
  grid.sync();
#define RUNP(PH, L, SYNC) do { unsigned long long t0_ = 0; if ((PROBE_MASK >> (PH)) & 1) t0_ = wall_clock64(); \
    run_phase(p, PH, L, bid, nb, dyn_smem); if (SYNC) GSYNC(); \
    if ((PROBE_MASK >> (PH)) & 1) { if (!(SYNC)) GSYNC(); const unsigned long long t1_ = wall_clock64(); \
      while (wall_clock64() - t1_ < t1_ - t0_) __builtin_amdgcn_s_sleep(8); GSYNC(); } } while (0)
  RUNP(PH_PRE_A, 0, 1);
  RUNP(PH_PRE_B, 0, 1);
  RUNP(PH_INIT, 0, 1);
  for (int l = 0; l < NLAYER; ++l) {
    RUNP(PH_GEMM_IN, l, 1);
    RUNP(PH_RET_UPD, l, 1);
    RUNP(PH_RET_SCAN, l, 1);
    RUNP(PH_RET_OUT, l, 1);
    RUNP(PH_GNORM, l, 1);
    RUNP(PH_GEMM_OUT, l, 1);
    RUNP(PH_LN1, l, 1);
    RUNP(PH_GEMM_WK, l, 1);
    RUNP(PH_GATHER, l, (l + 1 < NLAYER));
  }
#undef GSYNC
}

static inline size_t al256(size_t v) { return (v + 255) & ~(size_t)255; }

extern "C" void kernel_launch(void* const* d_in, const int* in_sizes, int n_in, void* d_out, int out_size, void* d_ws,
                              size_t ws_size, hipStream_t stream) {
  static int mgrid = 0;
  if (mgrid == 0) {
    int dev = 0, cus = 0, per_cu = 0;
    (void)hipGetDevice(&dev);
    (void)hipDeviceGetAttribute(&cus, hipDeviceAttributeMultiprocessorCount, dev);
    if (cus <= 0) cus = 256;
    (void)hipFuncSetAttribute((const void*)k_mega, hipFuncAttributeMaxDynamicSharedMemorySize, SMEM_BYTES);
    if (hipOccupancyMaxActiveBlocksPerMultiprocessor(&per_cu, (const void*)k_mega, 256, SMEM_BYTES) != hipSuccess || per_cu < 1) per_cu = 1;
    if (per_cu > 2) per_cu = 2;
    mgrid = cus * per_cu;
  }
  Params p{};
  p.x = (const float*)d_in[0]; p.c = (const float*)d_in[1]; p.ctx = (const float*)d_in[2]; p.c_ctx = (const float*)d_in[3];
  p.w_mod = (const float*)d_in[4]; p.b_mod = (const float*)d_in[5]; p.w_in = (const float*)d_in[6]; p.conv_w = (const float*)d_in[7];
  p.w_out = (const float*)d_in[8]; p.ln1_g = (const float*)d_in[9]; p.ln1_b = (const float*)d_in[10]; p.peer_wq = (const float*)d_in[11];
  p.peer_keys = (const float*)d_in[12]; p.peer_u = (const float*)d_in[13]; p.peer_v = (const float*)d_in[14];
  p.ln2_g = (const float*)d_in[15]; p.ln2_b = (const float*)d_in[16];
  p.out = (float*)d_out;
  char* w = (char*)d_ws; size_t off = 0;
  auto take = [&](size_t bytes) { char* r = w + off; off = al256(off + bytes); return r; };
  p.xres = (float*)take((size_t)TT * DM * 4);
  p.hA = (bf16_t*)take((size_t)TT * DM * 2);
  p.big = take((size_t)TT * 2048 * 4);
  p.cat = (bf16_t*)take((size_t)TT * DM * 2);
  p.st = (float*)take((size_t)2 * NCHUNK * 4 * 16384 * 4);
  p.ybuf = (float*)take((size_t)TT * DM * 4);
  p.w_inT = (bf16_t*)take((size_t)NLAYER * NPROJ * DM * 2);
  p.w_outT = (bf16_t*)take((size_t)NLAYER * DM * DM * 2);
  p.wkT = (bf16_t*)take((size_t)NLAYER * 2048 * DM * 2);
  p.ubf = (bf16_t*)take((size_t)NEXP * DM * 2);
  p.vbf = (bf16_t*)take((size_t)NEXP * DM * 2);
  p.mod = (float*)take((size_t)4 * 5 * 6144 * 4);
  p.modp = (float*)take((size_t)8 * 4 * 5 * 6144 * 4);
  p.ropec = (float*)take(128 * 32 * 4);
  p.ropes = (float*)take(128 * 32 * 4);
  p.bar = (unsigned*)take(XCD_BAR_WORDS * 4);
  p.pad0 = nullptr;
  {
    char* a = (char*)p.st; size_t o2 = 0;
    p.sv = (float*)(a + o2); o2 = al256(o2 + (size_t)TT * 256 * 4);
    p.si = (unsigned char*)(a + o2); o2 = al256(o2 + (size_t)TT * 256);
    p.pe = (int*)(a + o2); o2 = al256(o2 + (size_t)TT * 128 * 4);
    p.pg = (float*)(a + o2); o2 = al256(o2 + (size_t)TT * 128 * 4);
  }
  for (int d = 0; d < 2; ++d)
    for (int h = 0; h < 4; ++h) p.lg2[d][h] = (float)log2(1.0 - exp2(-(5.0 + 0.5 * d + (double)h)));
  if (off > ws_size) { fprintf(stderr, "kernel_launch: workspace too small: need %zu have %zu\n", off, ws_size); return; }

  (void)hipMemsetAsync(p.bar, 0, XCD_BAR_WORDS * 4, stream);
  void* args[] = {(void*)&p};
  hipError_t e = hipLaunchCooperativeKernel((const void*)k_mega, dim3(mgrid), dim3(256), args, SMEM_BYTES, stream);
  if (e != hipSuccess) fprintf(stderr, "kernel_launch: cooperative launch failed: %s (grid %d)\n", hipGetErrorString(e), mgrid);
}
```

```cpp
#include <hip/hip_runtime.h>
#include <hip/hip_cooperative_groups.h>
#include <stdint.h>
#include <math.h>
#include <stdio.h>
#include <utility>
#include <type_traits>

namespace cg = cooperative_groups;

typedef unsigned short bf16_t;
using bf16x8 = __attribute__((ext_vector_type(8))) short;
using s16x4 = __attribute__((ext_vector_type(4))) short;
using f32x4 = __attribute__((ext_vector_type(4))) float;
using u32x4 = __attribute__((ext_vector_type(4))) unsigned;

#define DM 1024
#define NB 4
#define SEQ 8192
#define TL 32768
#define TC 1024
#define TT 33792
#define NCHUNK 264
#define NPROJ 3584
#define NLAYER 4
#define NEXP 16384
#define ALPHA_F 1.681792830507429f
#define SMEM_BYTES 66576
#ifndef PROBE_MASK
#define PROBE_MASK 0
#endif

struct Params {
  const float *x, *c, *ctx, *c_ctx, *w_mod, *b_mod, *w_in, *conv_w, *w_out, *ln1_g, *ln1_b;
  const float *peer_wq, *peer_keys, *peer_u, *peer_v, *ln2_g, *ln2_b;
  float* out;
  float* xres; bf16_t* hA; char* big; bf16_t* cat; float* st; float* ybuf;
  bf16_t *w_inT, *w_outT, *wkT, *ubf, *vbf;
  float* sv; unsigned char* si; int* pe; float* pg;
  float *mod, *modp, *ropec, *ropes;
  unsigned* bar; unsigned* pad0;
  float lg2[2][4];
};

__device__ __forceinline__ bf16_t f2bf(float f) {
  uint32_t u = __float_as_uint(f);
  u += 0x7fffu + ((u >> 16) & 1u);
  return (bf16_t)(u >> 16);
}
__device__ __forceinline__ float bf2f(bf16_t b) { return __uint_as_float(((uint32_t)b) << 16); }
__device__ __forceinline__ uint32_t pack2(float a, float b) { return (uint32_t)f2bf(a) | ((uint32_t)f2bf(b) << 16); }
__device__ __forceinline__ float bflo(uint32_t w) { return __uint_as_float(w << 16); }
__device__ __forceinline__ float bfhi(uint32_t w) { return __uint_as_float(w & 0xffff0000u); }
typedef unsigned u32x2_t __attribute__((ext_vector_type(2)));
__device__ __forceinline__ unsigned swap_pair16(unsigned u, unsigned& other) { const u32x2_t r = __builtin_amdgcn_permlane16_swap(u, u, false, false); other = r[1]; return r[0]; }
__device__ __forceinline__ unsigned swap_pair32(unsigned u, unsigned& other) { const u32x2_t r = __builtin_amdgcn_permlane32_swap(u, u, false, false); other = r[1]; return r[0]; }
__device__ __forceinline__ float rows_sum_f(float v) {
  unsigned o;
  unsigned a = swap_pair16(__float_as_uint(v), o); v = __uint_as_float(a) + __uint_as_float(o);
  a = swap_pair32(__float_as_uint(v), o); return __uint_as_float(a) + __uint_as_float(o);
}
__device__ __forceinline__ int rows_sum_i(int v) {
  unsigned o;
  unsigned a = swap_pair16((unsigned)v, o); v = (int)(a + o);
  a = swap_pair32((unsigned)v, o); return (int)(a + o);
}
__device__ __forceinline__ float row16_sum(float v);
__device__ __forceinline__ float wave_sum(float v) { return rows_sum_f(row16_sum(v)); }
__device__ __forceinline__ float row16_sum(float v) {
  v += __builtin_bit_cast(float, __builtin_amdgcn_update_dpp(0, __builtin_bit_cast(int, v), 0xB1, 0xF, 0xF, true));
  v += __builtin_bit_cast(float, __builtin_amdgcn_update_dpp(0, __builtin_bit_cast(int, v), 0x4E, 0xF, 0xF, true));
  v += __builtin_bit_cast(float, __builtin_amdgcn_update_dpp(0, __builtin_bit_cast(int, v), 0x141, 0xF, 0xF, true));
  v += __builtin_bit_cast(float, __builtin_amdgcn_update_dpp(0, __builtin_bit_cast(int, v), 0x140, 0xF, 0xF, true));
  return v;
}
__device__ __forceinline__ float silu_f(float v) { return v * __builtin_amdgcn_rcpf(1.f + __expf(-v)); }
__device__ __forceinline__ int mod_row(int t) { return t < TL ? (t >> 13) : 4; }

__device__ __forceinline__ f32x4 zero4() { f32x4 a = {0.f, 0.f, 0.f, 0.f}; asm volatile("" : "+v"(a)); return a; }

__device__ __forceinline__ int opaque_tid() { int t = threadIdx.x; asm volatile("" : "+v"(t)); return t; }
__device__ __forceinline__ int opaque_s(int v) { v = __builtin_amdgcn_readfirstlane(v); asm volatile("" : "+s"(v)); return v; }

template <class F, int... I>
__device__ __forceinline__ void static_for_impl(F&& f, std::integer_sequence<int, I...>) { (f(std::integral_constant<int, I>{}), ...); }
template <int N, class F>
__device__ __forceinline__ void static_for(F&& f) { static_for_impl(f, std::make_integer_sequence<int, N>{}); }

__device__ __forceinline__ unsigned tr_lane_base(unsigned base, unsigned ld, unsigned lane) {
  const unsigned g = lane >> 4, q = (lane & 15u) >> 2, p = lane & 3u;
  return base + (8u * g + q) * ld + 8u * p;
}
template <int O0, int O1, int O2, int O3, int D>
__device__ __forceinline__ void tr_frag4(unsigned a, bf16x8& f0, bf16x8& f1, bf16x8& f2, bf16x8& f3) {
  s16x4 r0, r1, r2, r3, r4, r5, r6, r7;
  asm volatile(
      "ds_read_b64_tr_b16 %0, %8 offset:%9\n\t"
      "ds_read_b64_tr_b16 %1, %8 offset:%10\n\t"
      "ds_read_b64_tr_b16 %2, %8 offset:%11\n\t"
      "ds_read_b64_tr_b16 %3, %8 offset:%12\n\t"
      "ds_read_b64_tr_b16 %4, %8 offset:%13\n\t"
      "ds_read_b64_tr_b16 %5, %8 offset:%14\n\t"
      "ds_read_b64_tr_b16 %6, %8 offset:%15\n\t"
      "ds_read_b64_tr_b16 %7, %8 offset:%16\n\t"
      "s_waitcnt lgkmcnt(0)"
      : "=&v"(r0), "=&v"(r1), "=&v"(r2), "=&v"(r3), "=&v"(r4), "=&v"(r5), "=&v"(r6), "=&v"(r7)
      : "v"(a), "n"(O0), "n"(O0 + D), "n"(O1), "n"(O1 + D), "n"(O2), "n"(O2 + D), "n"(O3), "n"(O3 + D)
      : "memory");
  f0 = __builtin_shufflevector(r0, r1, 0, 1, 2, 3, 4, 5, 6, 7);
  f1 = __builtin_shufflevector(r2, r3, 0, 1, 2, 3, 4, 5, 6, 7);
  f2 = __builtin_shufflevector(r4, r5, 0, 1, 2, 3, 4, 5, 6, 7);
  f3 = __builtin_shufflevector(r6, r7, 0, 1, 2, 3, 4, 5, 6, 7);
}

__device__ __forceinline__ void ph_mod_partial(const Params& p, int bid, int nb, char* smem) {
  const int TIX = opaque_tid(); bid = opaque_s(bid);
  float* sm = (float*)smem;
  const int tid = TIX;
  for (int item = bid; item < 4 * 24 * 8; item += nb) {
    const int ks = item & 7, cb = (item >> 3) % 24, l = item / 192;
    __syncthreads();
    for (int idx = tid; idx < 640; idx += 256) {
      const int r = idx >> 7, k = ks * 128 + (idx & 127);
      const float v = (r < 4) ? p.c[r * DM + k] : p.c_ctx[k];
      sm[idx] = silu_f(v);
    }
    __syncthreads();
    const int col = cb * 256 + tid;
    float acc[5] = {0.f, 0.f, 0.f, 0.f, 0.f};
    const float* w = p.w_mod + ((size_t)l * DM + ks * 128) * 6144 + col;
#pragma unroll 4
    for (int k = 0; k < 128; ++k) {
      const float wv = w[(size_t)k * 6144];
#pragma unroll
      for (int r = 0; r < 5; ++r) acc[r] += sm[r * 128 + k] * wv;
    }
#pragma unroll
    for (int r = 0; r < 5; ++r) p.modp[((size_t)(ks * 4 + l) * 5 + r) * 6144 + col] = acc[r];
  }
}

__device__ __forceinline__ void ph_mod_reduce(const Params& p, int bid, int nb) {
  const int TIX = opaque_tid(); bid = opaque_s(bid);
  const int gtid = bid * 256 + TIX, gn = nb * 256;
  for (int idx = gtid; idx < 4 * 5 * 6144; idx += gn) {
    const int l = idx / (5 * 6144), col = idx % 6144;
    float s = p.b_mod[l * 6144 + col];
#pragma unroll
    for (int ks = 0; ks < 8; ++ks) s += p.modp[(size_t)ks * (4 * 5 * 6144) + idx];
    p.mod[idx] = s;
  }
  for (int idx = gtid; idx < 128 * 32; idx += gn) {
    const int pos = idx >> 5, d = idx & 31;
    const float inv = exp2f(-(float)d * (13.287712379549449f / 32.f));
    const float angf = (float)pos * inv;
    const double a = (double)angf;
    const double kk = rint(a * 0.15915494309189535);
    const double r = a - kk * 6.283185307179586;
    const double r2 = r * r;
    double sn = 1.0, cs = 1.0;
    for (int n = 13; n >= 1; --n) {
      sn = 1.0 - sn * r2 / (double)((2 * n) * (2 * n + 1));
      cs = 1.0 - cs * r2 / (double)((2 * n - 1) * (2 * n));
    }
    p.ropec[idx] = (float)cs;
    p.ropes[idx] = (float)(r * sn);
  }
}

__device__ __forceinline__ void ph_transpose_cvt(const float* src, bf16_t* dst, int K, int N, int bid, int nb, char* smem) {
  const int TIX = opaque_tid(); bid = opaque_s(bid);
  float* tile = (float*)smem;
  const int tid = TIX;
  const int ntn = N >> 6, ntk = K >> 6;
  for (int item = bid; item < ntn * ntk; item += nb) {
    const int kt = item / ntn, nt = item % ntn;
    __syncthreads();
#pragma unroll
    for (int i = 0; i < 4; ++i) {
      const int r = (tid >> 4) + 16 * i, c4 = (tid & 15) * 4;
      const float4 v = *(const float4*)(src + (size_t)(kt * 64 + r) * N + nt * 64 + c4);
      tile[r * 65 + c4 + 0] = v.x; tile[r * 65 + c4 + 1] = v.y; tile[r * 65 + c4 + 2] = v.z; tile[r * 65 + c4 + 3] = v.w;
    }
    __syncthreads();
    const int n = tid >> 2, kseg = (tid & 3) * 16;
    uint32_t w[8];
#pragma unroll
    for (int e = 0; e < 8; ++e) w[e] = pack2(tile[(kseg + 2 * e) * 65 + n], tile[(kseg + 2 * e + 1) * 65 + n]);
    uint4* d = (uint4*)(dst + (size_t)(nt * 64 + n) * K + kt * 64 + kseg);
    d[0] = make_uint4(w[0], w[1], w[2], w[3]);
    d[1] = make_uint4(w[4], w[5], w[6], w[7]);
  }
}

__device__ __forceinline__ void ph_wk_fold(const Params& p, int bid, int nb, char* smem) {
  const int TIX = opaque_tid(); bid = opaque_s(bid);
  float* wq_s = (float*)smem;
  float* key_s = wq_s + 64 * 65;
  const int tid = TIX;
  const int tc = tid >> 4, tn = tid & 15;
  for (int item = bid; item < 4 * 16 * 16; item += nb) {
    const int ct = item & 15, hp = (item >> 4) & 15, l = item >> 8;
    float acc[4][8];
#pragma unroll
    for (int a = 0; a < 4; ++a)
#pragma unroll
      for (int b = 0; b < 8; ++b) acc[a][b] = 0.f;
    for (int dh = 0; dh < 2; ++dh) {
      __syncthreads();
#pragma unroll
      for (int i = 0; i < 4; ++i) {
        const int r = (tid >> 4) + 16 * i, c4 = (tid & 15) * 4;
        const float4 v = *(const float4*)(p.peer_wq + ((size_t)l * DM + ct * 64 + r) * 2048 + hp * 128 + dh * 64 + c4);
        wq_s[r * 65 + c4 + 0] = v.x; wq_s[r * 65 + c4 + 1] = v.y; wq_s[r * 65 + c4 + 2] = v.z; wq_s[r * 65 + c4 + 3] = v.w;
      }
#pragma unroll
      for (int i = 0; i < 8; ++i) {
        const int r = (tid >> 4) + 16 * i, c4 = (tid & 15) * 4;
        const float4 v = *(const float4*)(p.peer_keys + (((size_t)l * 2 + (hp & 1)) * 128 + r) * 128 + dh * 64 + c4);
        key_s[r * 65 + c4 + 0] = v.x; key_s[r * 65 + c4 + 1] = v.y; key_s[r * 65 + c4 + 2] = v.z; key_s[r * 65 + c4 + 3] = v.w;
      }
      __syncthreads();
#pragma unroll 4
      for (int d = 0; d < 64; ++d) {
        float av[4], bv[8];
#pragma unroll
        for (int a = 0; a < 4; ++a) av[a] = wq_s[(tc * 4 + a) * 65 + d];
#pragma unroll
        for (int b = 0; b < 8; ++b) bv[b] = key_s[(tn + 16 * b) * 65 + d];
#pragma unroll
        for (int a = 0; a < 4; ++a)
#pragma unroll
          for (int b = 0; b < 8; ++b) acc[a][b] += av[a] * bv[b];
      }
    }
#pragma unroll
    for (int b = 0; b < 8; ++b) {
      const int row = hp * 128 + tn + 16 * b;
      uint2 o;
      o.x = pack2(acc[0][b], acc[1][b]);
      o.y = pack2(acc[2][b], acc[3][b]);
      *(uint2*)(p.wkT + ((size_t)l * 2048 + row) * DM + ct * 64 + tc * 4) = o;
    }
  }
}

#define SCALE_U 128.f
#define SCALE_V 8.f
__device__ __forceinline__ uint32_t pack_fp8x4(float a, float b, float c, float d) {
  int w = 0;
  w = __builtin_amdgcn_cvt_pk_fp8_f32(a, b, w, false);
  w = __builtin_amdgcn_cvt_pk_fp8_f32(c, d, w, true);
  return (uint32_t)w;
}
#define QSCALE_U 512.f
__device__ __forceinline__ uint32_t pack_i8x4(float a, float b, float c, float d) {
  const int qa = max(-127, min(127, __float2int_rn(a))), qb = max(-127, min(127, __float2int_rn(b)));
  const int qc = max(-127, min(127, __float2int_rn(c))), qd = max(-127, min(127, __float2int_rn(d)));
  return (uint32_t)(qa & 255) | ((uint32_t)(qb & 255) << 8) | ((uint32_t)(qc & 255) << 16) | ((uint32_t)(qd & 255) << 24);
}
__device__ __forceinline__ void cvt_uv_unit(const Params& p, int l, size_t i) {
  const size_t n16 = (size_t)NEXP * DM / 16;
  const bool isv = i >= n16;
  const size_t j = isv ? i - n16 : i;
  const float sc = SCALE_V;
  const float4* s4 = (const float4*)((isv ? p.peer_v : p.peer_u) + (size_t)l * NEXP * DM + j * 16);
  const float4 a0 = s4[0], a1 = s4[1], a2 = s4[2], a3 = s4[3];
  uint4 o;
  if (isv) {
    o.x = pack_fp8x4(a0.x * sc, a0.y * sc, a0.z * sc, a0.w * sc);
    o.y = pack_fp8x4(a1.x * sc, a1.y * sc, a1.z * sc, a1.w * sc);
    o.z = pack_fp8x4(a2.x * sc, a2.y * sc, a2.z * sc, a2.w * sc);
    o.w = pack_fp8x4(a3.x * sc, a3.y * sc, a3.z * sc, a3.w * sc);
  } else {
    o.x = pack_i8x4(a0.x * QSCALE_U, a0.y * QSCALE_U, a0.z * QSCALE_U, a0.w * QSCALE_U);
    o.y = pack_i8x4(a1.x * QSCALE_U, a1.y * QSCALE_U, a1.z * QSCALE_U, a1.w * QSCALE_U);
    o.z = pack_i8x4(a2.x * QSCALE_U, a2.y * QSCALE_U, a2.z * QSCALE_U, a2.w * QSCALE_U);
    o.w = pack_i8x4(a3.x * QSCALE_U, a3.y * QSCALE_U, a3.z * QSCALE_U, a3.w * QSCALE_U);
  }
  *(uint4*)((unsigned char*)(isv ? p.vbf : p.ubf) + j * 16) = o;
}
#define CVT_UNITS ((size_t)2 * NEXP * DM / 16)

__device__ __forceinline__ void ph_init_h(const Params& p, int bid, int nb) {
  const int TIX = opaque_tid(); bid = opaque_s(bid);
  const int lane = TIX & 63;
  const int gw = bid * 4 + (TIX >> 6), nw = nb * 4;
  float4 psh[4], psc[4], xc[4];
  int cur_row = -1;
#define IH_FETCH(T, X) { const float* xr_ = ((T) < TL ? p.x + (size_t)(T) * DM : p.ctx + (size_t)((T) - TL) * DM) + lane * 16; \
    _Pragma("unroll") for (int i = 0; i < 4; ++i) X[i] = *(const float4*)(xr_ + 4 * i); }
  if (gw < TT) IH_FETCH(gw, xc)
  for (int t = gw; t < TT; t += nw) {
    float4 xn[4] = {xc[0], xc[1], xc[2], xc[3]};
    if (t + nw < TT) IH_FETCH(t + nw, xn)
    const int mr = mod_row(t);
    if (mr != cur_row) {
      cur_row = mr;
      const float* m = p.mod + (size_t)(0 * 5 + mr) * 6144 + lane * 16;
#pragma unroll
      for (int i = 0; i < 4; ++i) { psh[i] = *(const float4*)(m + 4 * i); psc[i] = *(const float4*)(m + 1024 + 4 * i); }
    }
    uint32_t o[8];
#pragma unroll
    for (int i = 0; i < 4; ++i) {
      const float4 v = xc[i], sh = psh[i], sc = psc[i];
      o[2 * i] = pack2(v.x * (1.f + sc.x) + sh.x, v.y * (1.f + sc.y) + sh.y);
      o[2 * i + 1] = pack2(v.z * (1.f + sc.z) + sh.z, v.w * (1.f + sc.w) + sh.w);
    }
    bf16_t* hd = p.hA + (size_t)t * DM + lane * 16;
    *(uint4*)hd = make_uint4(o[0], o[1], o[2], o[3]);
    *(uint4*)(hd + 8) = make_uint4(o[4], o[5], o[6], o[7]);
#pragma unroll
    for (int i = 0; i < 4; ++i) xc[i] = xn[i];
  }
#undef IH_FETCH
}

__device__ __forceinline__ void gemm_tile_acc(const bf16_t* __restrict__ A, const bf16_t* __restrict__ Bt, int K, int m0, int n0,
                                              char* smem, int tid, f32x4 (&acc)[4][4]) {
  const int lane = tid & 63, wave = opaque_s(tid >> 6);
  const int wm = wave >> 1, wn = wave & 1;
  const int g = lane >> 4, l15 = lane & 15;
  const int nt = K >> 6;
#pragma unroll
  for (int i = 0; i < 4; ++i)
#pragma unroll
    for (int j = 0; j < 4; ++j) acc[i][j] = zero4();
  const int sb = lane * 16, swz = sb ^ (((sb >> 9) & 1) << 5);
  const int R0 = (wave >> 1) * 16 + (swz >> 6), C0 = (wave & 1) * 32 + ((swz & 63) >> 1);
  const bf16_t* ga = A + (size_t)(m0 + R0) * K + C0;
  const bf16_t* gb = Bt + (size_t)(n0 + R0) * K + C0;
  char* stA = smem + wave * 1024;
  char* stB = smem + 16384 + wave * 1024;
  const int fl = l15 * 64 + ((g * 16) ^ ((l15 >> 3) << 5));
  const char* rdA = smem + fl + wm * 8192;
  const char* rdB = smem + 16384 + fl + wn * 8192;
#define GLDS_STAGE(BUF, KT) do { _Pragma("unroll") for (int i_ = 0; i_ < 4; ++i_) {                                                        \
    __builtin_amdgcn_global_load_lds((const unsigned*)(ga + (size_t)(32 * i_) * K + (KT) * 64), (unsigned*)(stA + (BUF) * 32768 + i_ * 4096), 16, 0, 0); \
    __builtin_amdgcn_global_load_lds((const unsigned*)(gb + (size_t)(32 * i_) * K + (KT) * 64), (unsigned*)(stB + (BUF) * 32768 + i_ * 4096), 16, 0, 0); } } while (0)
  __syncthreads();
  GLDS_STAGE(0, 0);
  asm volatile("s_waitcnt vmcnt(0)" ::: "memory");
  __syncthreads();
  if (nt > 1) GLDS_STAGE(1, 1);
  bf16x8 af0[4], bf0[4], af1[4], bf1[4];
#pragma unroll
  for (int i = 0; i < 4; ++i) af0[i] = *(const bf16x8*)(rdA + (i * 2) * 1024);
#pragma unroll
  for (int j = 0; j < 4; ++j) bf0[j] = *(const bf16x8*)(rdB + (j * 2) * 1024);
  for (int t = 0; t < nt; ++t) {
    const int cur = t & 1;
    acc[0][0] = __builtin_amdgcn_mfma_f32_16x16x32_bf16(af0[0], bf0[0], acc[0][0], 0, 0, 0);
    __builtin_amdgcn_sched_barrier(0);
#pragma unroll
    for (int q = 0; q < 8; ++q) {
      if (q < 4) af1[q] = *(const bf16x8*)(rdA + cur * 32768 + (q * 2 + 1) * 1024);
      else bf1[q - 4] = *(const bf16x8*)(rdB + cur * 32768 + ((q - 4) * 2 + 1) * 1024);
      __builtin_amdgcn_sched_barrier(0);
      { const int x = 1 + q;
        acc[x >> 2][x & 3] = __builtin_amdgcn_mfma_f32_16x16x32_bf16(af0[x >> 2], bf0[x & 3], acc[x >> 2][x & 3], 0, 0, 0); }
      __builtin_amdgcn_sched_barrier(0);
    }
#pragma unroll
    for (int x = 9; x < 16; ++x) acc[x >> 2][x & 3] = __builtin_amdgcn_mfma_f32_16x16x32_bf16(af0[x >> 2], bf0[x & 3], acc[x >> 2][x & 3], 0, 0, 0);
    __builtin_amdgcn_sched_barrier(0);
    asm volatile("s_waitcnt vmcnt(0)" ::: "memory");
    __syncthreads();
    if (t + 2 < nt) GLDS_STAGE(cur, t + 2);
    __builtin_amdgcn_sched_barrier(0);
#pragma unroll
    for (int q = 0; q < 8; ++q) {
      if (t + 1 < nt) {
        if (q < 4) af0[q] = *(const bf16x8*)(rdA + (cur ^ 1) * 32768 + (q * 2) * 1024);
        else bf0[q - 4] = *(const bf16x8*)(rdB + (cur ^ 1) * 32768 + ((q - 4) * 2) * 1024);
      }
      __builtin_amdgcn_sched_barrier(0);
      { const int x = q;
        acc[x >> 2][x & 3] = __builtin_amdgcn_mfma_f32_16x16x32_bf16(af1[x >> 2], bf1[x & 3], acc[x >> 2][x & 3], 0, 0, 0); }
      __builtin_amdgcn_sched_barrier(0);
    }
#pragma unroll
    for (int x = 8; x < 16; ++x) acc[x >> 2][x & 3] = __builtin_amdgcn_mfma_f32_16x16x32_bf16(af1[x >> 2], bf1[x & 3], acc[x >> 2][x & 3], 0, 0, 0);
    __builtin_amdgcn_sched_barrier(0);
  }
#undef GLDS_STAGE
}

template <int MX, int NX>
__device__ __forceinline__ bool xcd_tile(int bid, int nb, int k, int ntm, int ntn, int& m, int& n) {
  if ((nb & 7) || (ntm % MX) || (ntn % NX)) {
    const int t = bid + k * nb;
    if (t >= ntm * ntn) return false;
    m = t / ntn; n = t % ntn; return true;
  }
  const int x = bid & 7, q = bid >> 3, nq = nb >> 3;
  const int nloc = ntn / NX, per_x = (ntm / MX) * nloc;
  const int j = q + k * nq;
  if (j >= per_x) return false;
  m = (j / nloc) * MX + (x % MX); n = (j % nloc) * NX + (x / MX);
  return true;
}

__device__ __forceinline__ bool xcd_pair_item(int bid, int nb, int k, int npairs, int& pair, int& sub) {
  if ((nb & 7) || (npairs & 7)) {
    const int t = bid + k * nb;
    if (t >= npairs * 2) return false;
    pair = t >> 1; sub = t & 1; return true;
  }
  const int x = bid & 7, q = bid >> 3, nq = nb >> 3;
  const int j = q + k * nq;
  if (j >= (npairs >> 3) * 2) return false;
  pair = (j >> 1) * 8 + x; sub = j & 1;
  return true;
}

template <bool OUT_BF16>
__device__ __forceinline__ void ph_gemm(const bf16_t* __restrict__ A, const bf16_t* __restrict__ Bt, void* Cout, int M, int N, int K,
                        int bid, int nb, char* smem) {
  const int TIX = opaque_tid(); bid = opaque_s(bid);
  const int tid = TIX, lane = tid & 63, wave = tid >> 6;
  const int wm = wave >> 1, wn = wave & 1;
  const int ntn = N >> 7, ntm = M >> 7;
  for (int k = 0;; ++k) {
    int tm, tn;
    if (!xcd_tile<8, 1>(bid, nb, k, ntm, ntn, tm, tn)) break;
    const int m0 = tm << 7, n0 = tn << 7;
    f32x4 acc[4][4];
    gemm_tile_acc(A, Bt, K, m0, n0, smem, tid, acc);
#pragma unroll
    for (int i = 0; i < 4; ++i)
#pragma unroll
      for (int j = 0; j < 4; ++j)
#pragma unroll
        for (int r = 0; r < 4; ++r) {
          const int row = m0 + wm * 64 + i * 16 + (lane >> 4) * 4 + r;
          const int col = n0 + wn * 64 + j * 16 + (lane & 15);
          if (OUT_BF16) ((bf16_t*)Cout)[(size_t)row * N + col] = f2bf(acc[i][j][r]);
          else ((float*)Cout)[(size_t)row * N + col] = acc[i][j][r];
        }
  }
}

__device__ __forceinline__ void ph_gemm_in(const Params& p, int l, int bid, int nb, char* smem) {
  const int TIX = opaque_tid(); bid = opaque_s(bid);
  const int tid = TIX, lane = tid & 63, wave = tid >> 6;
  const int wm = wave >> 1, wn = wave & 1;
  const int g = lane >> 4, l15 = lane & 15;
  bf16_t* proj = (bf16_t*)p.big;
  const bf16_t* Bt = p.w_inT + (size_t)l * NPROJ * DM;
  constexpr int ntn = NPROJ >> 7;
  for (int k = 0;; ++k) {
    int tm, nt;
    if (!xcd_tile<2, 4>(bid, nb, k, TT >> 7, ntn, tm, nt)) break;
    const int m0 = tm << 7, n0 = nt << 7;
    {
      const size_t cu = (size_t)(bid + k * nb) * 512 + tid;
      if (cu < CVT_UNITS) cvt_uv_unit(p, l, cu);
      if (cu + 256 < CVT_UNITS) cvt_uv_unit(p, l, cu + 256);
    }
    if (l == NLAYER - 1 && m0 >= TL && (nt < 16 || nt >= 24)) continue;
    f32x4 acc[4][4];
    gemm_tile_acc(p.hA, Bt, DM, m0, n0, smem, tid, acc);
    if (nt >= 12 && nt < 20) {
      const float scl = (nt >= 16) ? 0.08838834764831845f : 1.f;
      if (m0 < TL) {
#pragma unroll
        for (int i = 0; i < 4; ++i)
#pragma unroll
          for (int r = 0; r < 4; ++r) {
            const int ii = (m0 + wm * 64 + i * 16 + g * 4 + r) & 8191;
            const int pos = wn ? (ii & 63) : (ii >> 6);
#pragma unroll
            for (int jj = 0; jj < 2; ++jj) {
              const float cs = p.ropec[pos * 32 + jj * 16 + l15], sn = p.ropes[pos * 32 + jj * 16 + l15];
              const float a = acc[i][jj][r], b = acc[i][jj + 2][r];
              acc[i][jj][r] = (a * cs - b * sn) * scl;
              acc[i][jj + 2][r] = (a * sn + b * cs) * scl;
            }
          }
      } else if (nt >= 16) {
#pragma unroll
        for (int i = 0; i < 4; ++i)
#pragma unroll
          for (int j = 0; j < 4; ++j)
#pragma unroll
            for (int r = 0; r < 4; ++r) acc[i][j][r] *= scl;
      }
    }
#pragma unroll
    for (int i = 0; i < 4; ++i)
#pragma unroll
      for (int j = 0; j < 4; ++j)
#pragma unroll
        for (int r = 0; r < 4; ++r) {
          const int row = m0 + wm * 64 + i * 16 + g * 4 + r;
          const int col = n0 + wn * 64 + j * 16 + l15;
          proj[(size_t)row * NPROJ + col] = f2bf(acc[i][j][r]);
        }
  }
}

__device__ __forceinline__ void ph_ret_upd(const Params& p, int bid, int nb, char* smem) {
  const int TIX = opaque_tid(); bid = opaque_s(bid);
  const bf16_t* proj = (const bf16_t*)p.big;
  bf16_t* Vs = (bf16_t*)smem;
  bf16_t* Ks = Vs + 64 * 136;
  const int tid = TIX, lane = tid & 63, wave = tid >> 6;
  const int wm = wave >> 1, wn = wave & 1;
  const unsigned va = tr_lane_base((unsigned)(size_t)Vs, 272u, lane) + wm * 128;
  const unsigned ka = tr_lane_base((unsigned)(size_t)Ks, 272u, lane) + wn * 128;
  const int sr = tid >> 4, sck = (tid & 15) * 8;
  for (int k = 0;; ++k) {
    int pr, dir;
    if (!xcd_pair_item(bid, nb, k, NCHUNK * 4, pr, dir)) break;
    const int c = pr >> 2, hd = pr & 3;
    const int t0 = c * 128;
    const float lg = p.lg2[dir][hd];
    const bf16_t* src = proj + (size_t)(t0 + sr) * NPROJ + hd * 128 + sck;
    u32x4 rv[4], rk[4];
#pragma unroll
    for (int i = 0; i < 4; ++i) {
      rv[i] = *(const u32x4*)(src + 2560 + (size_t)(16 * i) * NPROJ);
      rk[i] = *(const u32x4*)(src + 2048 + (size_t)(16 * i) * NPROJ);
    }
    f32x4 acc[4][4];
#pragma unroll
    for (int i = 0; i < 4; ++i)
#pragma unroll
      for (int j = 0; j < 4; ++j) acc[i][j] = zero4();
#pragma unroll
    for (int half = 0; half < 2; ++half) {
      __syncthreads();
#pragma unroll
      for (int i = 0; i < 4; ++i) {
        const int r = sr + 16 * i, sp = half * 64 + r;
        const float w = exp2f((dir == 0 ? (float)(127 - sp) : (float)sp) * lg);
        u32x4 ko;
#pragma unroll
        for (int q = 0; q < 4; ++q) ko[q] = pack2(bflo(rk[i][q]) * w, bfhi(rk[i][q]) * w);
        *(u32x4*)(Vs + r * 136 + sck) = rv[i];
        *(u32x4*)(Ks + r * 136 + sck) = ko;
      }
      __syncthreads();
      if (half == 0) {
#pragma unroll
        for (int i = 0; i < 4; ++i) {
          rv[i] = *(const u32x4*)(src + 2560 + (size_t)(64 + 16 * i) * NPROJ);
          rk[i] = *(const u32x4*)(src + 2048 + (size_t)(64 + 16 * i) * NPROJ);
        }
      }
      static_for<2>([&](auto KS) {
        constexpr int ks = decltype(KS)::value;
        bf16x8 af[4], bfr[4];
        tr_frag4<ks * 32 * 272 + 0, ks * 32 * 272 + 32, ks * 32 * 272 + 64, ks * 32 * 272 + 96, 4 * 272>(va, af[0], af[1], af[2], af[3]);
        tr_frag4<ks * 32 * 272 + 0, ks * 32 * 272 + 32, ks * 32 * 272 + 64, ks * 32 * 272 + 96, 4 * 272>(ka, bfr[0], bfr[1], bfr[2], bfr[3]);
#pragma unroll
        for (int i = 0; i < 4; ++i)
#pragma unroll
          for (int j = 0; j < 4; ++j) acc[i][j] = __builtin_amdgcn_mfma_f32_16x16x32_bf16(bfr[j], af[i], acc[i][j], 0, 0, 0);
      });
    }
    bf16_t* dst = (bf16_t*)p.st + ((size_t)(dir * NCHUNK + c) * 4 + hd) * 16384;
#pragma unroll
    for (int i = 0; i < 4; ++i)
#pragma unroll
      for (int j = 0; j < 4; ++j) {
        const int row = wm * 64 + i * 16 + (lane & 15);
        const int col = wn * 64 + j * 16 + (lane >> 4) * 4;
        uint2 o; o.x = pack2(acc[i][j][0], acc[i][j][1]); o.y = pack2(acc[i][j][2], acc[i][j][3]);
        *(uint2*)(dst + row * 128 + col) = o;
      }
  }
}

__device__ __forceinline__ void ph_ret_scan(const Params& p, int bid, int nb) {
  const int TIX = opaque_tid(); bid = opaque_s(bid);
  const int gtid = bid * 256 + TIX, gn = nb * 256;
  bf16_t* sout = (bf16_t*)p.ybuf;
  for (int idx = gtid; idx < 2 * 4 * 4 * 8192; idx += gn) {
    const int e = (idx & 8191) * 2, hd = (idx >> 13) & 3, b = (idx >> 15) & 3, dir = idx >> 17;
    const float dc = exp2f(128.f * p.lg2[dir][hd]);
    const size_t boff = (size_t)dir * NCHUNK * 4 * 16384 + (size_t)hd * 16384 + e;
    const bf16_t* __restrict__ src = (const bf16_t*)p.st + boff;
    bf16_t* __restrict__ dst = sout + boff;
    const size_t cs = (size_t)4 * 16384;
    float c0 = 0.f, c1 = 0.f;
    {
      const size_t o0 = (size_t)(256 + b * 2 + (dir ? 1 : 0)) * cs, o1 = (size_t)(256 + b * 2 + (dir ? 0 : 1)) * cs;
      const uint32_t u0 = *(const uint32_t*)(src + o0), u1 = *(const uint32_t*)(src + o1);
      *(uint32_t*)(dst + o0) = pack2(c0, c1); c0 = c0 * dc + bflo(u0); c1 = c1 * dc + bfhi(u0);
      *(uint32_t*)(dst + o1) = pack2(c0, c1); c0 = c0 * dc + bflo(u1); c1 = c1 * dc + bfhi(u1);
    }
    for (int n0 = 0; n0 < 64; n0 += 16) {
      uint32_t u[16];
#pragma unroll
      for (int i = 0; i < 16; ++i) {
        const int n = dir ? (63 - (n0 + i)) : (n0 + i);
        u[i] = *(const uint32_t*)(src + (size_t)(b * 64 + n) * cs);
      }
#pragma unroll
      for (int i = 0; i < 16; ++i) {
        const int n = dir ? (63 - (n0 + i)) : (n0 + i);
        *(uint32_t*)(dst + (size_t)(b * 64 + n) * cs) = pack2(c0, c1);
        c0 = c0 * dc + bflo(u[i]); c1 = c1 * dc + bfhi(u[i]);
      }
    }
  }
}

__device__ __forceinline__ void ph_ret_out(const Params& p, int l, int bid, int nb, char* smem) {
  const int TIX = opaque_tid(); bid = opaque_s(bid);
  const bf16_t* proj = (const bf16_t*)p.big;
  const bf16_t* sin = (const bf16_t*)p.ybuf;
  bf16_t* buf = (bf16_t*)smem;
  bf16_t* Pb = buf + 128 * 136;
  const int tid = TIX, lane = tid & 63, wave = tid >> 6;
  const unsigned ba = tr_lane_base((unsigned)(size_t)buf, 272u, lane);
  const int g = lane >> 4, l15 = lane & 15;
  bf16_t* Pw = Pb + wave * 16 * 136;
  const int sr = tid >> 4, sck = (tid & 15) * 8;
  const int nitem_ro = ((l == NLAYER - 1) ? 256 : NCHUNK) * 8;
  for (int k = 0;; ++k) {
    int pr, rh;
    if (!xcd_pair_item(bid, nb, k, nitem_ro >> 1, pr, rh)) break;
    const int c = pr >> 2, hd = pr & 3;
    const int t0 = c * 128;
    const int rw = rh * 64 + wave * 16;
    const float lgf = p.lg2[0][hd], lgb = p.lg2[1][hd];
    bf16x8 qf[4];
#pragma unroll
    for (int ks = 0; ks < 4; ++ks)
      qf[ks] = *(const bf16x8*)(proj + (size_t)(t0 + rw + l15) * NPROJ + 1536 + hd * 128 + ks * 32 + g * 8);
    u32x4 ra[8], rb[8];
    const bf16_t* kv = proj + (size_t)(t0 + sr) * NPROJ + hd * 128 + sck;
#pragma unroll
    for (int i = 0; i < 8; ++i) ra[i] = *(const u32x4*)(kv + 2048 + (size_t)(16 * i) * NPROJ);
#pragma unroll
    for (int i = 0; i < 8; ++i) rb[i] = *(const u32x4*)(kv + 2560 + (size_t)(16 * i) * NPROJ);
    const bf16_t* sf = sin + ((size_t)(0 * NCHUNK + c) * 4 + hd) * 16384 + sr * 128 + sck;
    const bf16_t* sb = sin + ((size_t)(1 * NCHUNK + c) * 4 + hd) * 16384 + sr * 128 + sck;
    __syncthreads();
#pragma unroll
    for (int i = 0; i < 8; ++i) *(u32x4*)(buf + (sr + 16 * i) * 136 + sck) = ra[i];
    __syncthreads();
#pragma unroll
    for (int i = 0; i < 8; ++i) ra[i] = *(const u32x4*)(sf + (size_t)(16 * i) * 128);
    f32x4 acc[8];
#pragma unroll
    for (int nt = 0; nt < 8; ++nt) acc[nt] = zero4();
#pragma unroll
    for (int ks = 0; ks < 4; ++ks) {
#pragma unroll
      for (int nt = 0; nt < 8; ++nt) {
        const bf16x8 bfr = *(const bf16x8*)(buf + (nt * 16 + l15) * 136 + ks * 32 + g * 8);
        acc[nt] = __builtin_amdgcn_mfma_f32_16x16x32_bf16(qf[ks], bfr, acc[nt], 0, 0, 0);
      }
    }
#pragma unroll
    for (int nt = 0; nt < 8; ++nt)
#pragma unroll
      for (int r = 0; r < 4; ++r) {
        const int tl = g * 4 + r;
        const int t = rw + tl, s2 = nt * 16 + l15;
        const float d = (s2 <= t) ? exp2f((float)(t - s2) * lgf) : exp2f((float)(s2 - t) * lgb);
        Pw[tl * 136 + s2] = f2bf(acc[nt][r] * d);
      }
    __syncthreads();
#pragma unroll
    for (int i = 0; i < 8; ++i) *(u32x4*)(buf + (sr + 16 * i) * 136 + sck) = rb[i];
    __syncthreads();
#pragma unroll
    for (int i = 0; i < 8; ++i) rb[i] = *(const u32x4*)(sb + (size_t)(16 * i) * 128);
    f32x4 o[8];
#pragma unroll
    for (int nt = 0; nt < 8; ++nt) o[nt] = zero4();
    static_for<4>([&](auto KS) {
      constexpr int ks = decltype(KS)::value;
      const bf16x8 pf = *(const bf16x8*)(Pw + l15 * 136 + ks * 32 + g * 8);
      static_for<2>([&](auto NH) {
        constexpr int nh = decltype(NH)::value;
        bf16x8 bfr[4];
        tr_frag4<ks * 32 * 272 + nh * 128 + 0, ks * 32 * 272 + nh * 128 + 32, ks * 32 * 272 + nh * 128 + 64, ks * 32 * 272 + nh * 128 + 96, 4 * 272>(
            ba, bfr[0], bfr[1], bfr[2], bfr[3]);
#pragma unroll
        for (int j = 0; j < 4; ++j) o[nh * 4 + j] = __builtin_amdgcn_mfma_f32_16x16x32_bf16(pf, bfr[j], o[nh * 4 + j], 0, 0, 0);
      });
    });
#define RO_CROSS(DIRV, REG)                                                                                     \
    {                                                                                                           \
      __syncthreads();                                                                                          \
      _Pragma("unroll") for (int i = 0; i < 8; ++i) *(u32x4*)(buf + (sr + 16 * i) * 136 + sck) = REG[i];        \
      __syncthreads();                                                                                          \
      float fr[4];                                                                                              \
      _Pragma("unroll") for (int r = 0; r < 4; ++r) {                                                           \
        const int t = rw + g * 4 + r;                                                                           \
        fr[r] = (DIRV == 0) ? exp2f((float)(t + 1) * lgf) : exp2f((float)(128 - t) * lgb);                      \
      }                                                                                                         \
      _Pragma("unroll") for (int nt = 0; nt < 8; ++nt) acc[nt] = zero4();                                       \
      _Pragma("unroll") for (int ks = 0; ks < 4; ++ks) {                                                        \
        _Pragma("unroll") for (int nt = 0; nt < 8; ++nt) {                                                      \
          const bf16x8 bfr = *(const bf16x8*)(buf + (nt * 16 + l15) * 136 + ks * 32 + g * 8);                   \
          acc[nt] = __builtin_amdgcn_mfma_f32_16x16x32_bf16(qf[ks], bfr, acc[nt], 0, 0, 0);                     \
        }                                                                                                       \
      }                                                                                                         \
      _Pragma("unroll") for (int r = 0; r < 4; ++r)                                                             \
        _Pragma("unroll") for (int nt = 0; nt < 8; ++nt) o[nt][r] += fr[r] * acc[nt][r];                        \
    }
    RO_CROSS(0, ra)
    RO_CROSS(1, rb)
#undef RO_CROSS
#pragma unroll
    for (int r = 0; r < 4; ++r) {
      const int t = t0 + rw + g * 4 + r;
#pragma unroll
      for (int nt = 0; nt < 8; ++nt) p.cat[(size_t)t * DM + 512 + hd * 128 + nt * 16 + l15] = f2bf(o[nt][r]);
    }
  }
}

__device__ __forceinline__ void ph_gnorm(const Params& p, int l, int bid, int nb) {
  const int TIX = opaque_tid(); bid = opaque_s(bid);
  const bf16_t* proj = (const bf16_t*)p.big;
  const int lane = TIX & 63;
  const int gw = bid * 4 + (TIX >> 6), nw = nb * 4;
  const float* cw = p.conv_w + ((size_t)l * 512 + lane * 8) * 3;
  float cwv[24];
#pragma unroll
  for (int i = 0; i < 24; ++i) cwv[i] = cw[i];
  const int tend = (l == NLAYER - 1) ? TL : TT;
  struct GnRaw { uint4 bg, c0, c1, c2, h0, h1, h2, ov, gv; };
  auto fetch = [&](int t, GnRaw& r) {
    const bf16_t* row = proj + (size_t)t * NPROJ;
    const int ch = lane * 8;
    bool hasl, hasr;
    if (t < TL) { const int i = t & 63; hasl = i != 0; hasr = i != 63; }
    else { const int i = (t - TL) & 255; hasl = i != 0; hasr = i != 255; }
    r.bg = *(const uint4*)(row + ch);
    r.c1 = *(const uint4*)(row + 512 + ch); r.h1 = *(const uint4*)(row + 1024 + ch);
    r.c0 = make_uint4(0, 0, 0, 0); r.h0 = r.c0; r.c2 = r.c0; r.h2 = r.c0;
    if (hasl) { r.c0 = *(const uint4*)(row - NPROJ + 512 + ch); r.h0 = *(const uint4*)(row - NPROJ + 1024 + ch); }
    if (hasr) { r.c2 = *(const uint4*)(row + NPROJ + 512 + ch); r.h2 = *(const uint4*)(row + NPROJ + 1024 + ch); }
    r.ov = *(const uint4*)(p.cat + (size_t)t * DM + 512 + lane * 8);
    r.gv = *(const uint4*)(row + 3072 + lane * 8);
  };
  GnRaw cur;
  if (gw < tend) fetch(gw, cur);
  for (int t = gw; t < tend; t += nw) {
    GnRaw nxt = cur;
    if (t + nw < tend) fetch(t + nw, nxt);
    {
      const int ch = lane * 8;
      const uint4 bg = cur.bg, c0 = cur.c0, c1 = cur.c1, c2 = cur.c2, h0 = cur.h0, h1 = cur.h1, h2 = cur.h2;
      const uint32_t bgw[4] = {bg.x, bg.y, bg.z, bg.w};
      const uint32_t c0w[4] = {c0.x, c0.y, c0.z, c0.w}, c1w[4] = {c1.x, c1.y, c1.z, c1.w}, c2w[4] = {c2.x, c2.y, c2.z, c2.w};
      const uint32_t h0w[4] = {h0.x, h0.y, h0.z, h0.w}, h1w[4] = {h1.x, h1.y, h1.z, h1.w}, h2w[4] = {h2.x, h2.y, h2.z, h2.w};
      uint32_t ow[4];
#pragma unroll
      for (int e = 0; e < 4; ++e) {
        const float z0a = bflo(c0w[e]) * bflo(h0w[e]), z1a = bflo(c1w[e]) * bflo(h1w[e]), z2a = bflo(c2w[e]) * bflo(h2w[e]);
        const float z0b = bfhi(c0w[e]) * bfhi(h0w[e]), z1b = bfhi(c1w[e]) * bfhi(h1w[e]), z2b = bfhi(c2w[e]) * bfhi(h2w[e]);
        const float ya = z0a * cwv[6 * e + 0] + z1a * cwv[6 * e + 1] + z2a * cwv[6 * e + 2];
        const float yb = z0b * cwv[6 * e + 3] + z1b * cwv[6 * e + 4] + z2b * cwv[6 * e + 5];
        ow[e] = pack2(bflo(bgw[e]) * ya, bfhi(bgw[e]) * yb);
      }
      *(uint4*)(p.cat + (size_t)t * DM + ch) = make_uint4(ow[0], ow[1], ow[2], ow[3]);
    }
    bf16_t* op = p.cat + (size_t)t * DM + 512 + lane * 8;
    const uint4 ov = cur.ov;
    const uint4 gv = cur.gv;
    float o[8], gg[8];
    o[0] = bflo(ov.x); o[1] = bfhi(ov.x); o[2] = bflo(ov.y); o[3] = bfhi(ov.y);
    o[4] = bflo(ov.z); o[5] = bfhi(ov.z); o[6] = bflo(ov.w); o[7] = bfhi(ov.w);
    gg[0] = bflo(gv.x); gg[1] = bfhi(gv.x); gg[2] = bflo(gv.y); gg[3] = bfhi(gv.y);
    gg[4] = bflo(gv.z); gg[5] = bfhi(gv.z); gg[6] = bflo(gv.w); gg[7] = bfhi(gv.w);
    float s1 = 0.f;
#pragma unroll
    for (int i = 0; i < 8; ++i) s1 += o[i];
    s1 = row16_sum(s1);
    const float mu = s1 * (1.f / 128.f);
    float s2 = 0.f;
#pragma unroll
    for (int i = 0; i < 8; ++i) { const float d = o[i] - mu; s2 += d * d; }
    s2 = row16_sum(s2);
    const float rs = rsqrtf(s2 * (1.f / 128.f) + 1e-5f);
    float y[8];
#pragma unroll
    for (int i = 0; i < 8; ++i) y[i] = silu_f(gg[i]) * (o[i] - mu) * rs;
    *(uint4*)op = make_uint4(pack2(y[0], y[1]), pack2(y[2], y[3]), pack2(y[4], y[5]), pack2(y[6], y[7]));
    cur = nxt;
  }
}

__device__ __forceinline__ void ph_ln(const Params& p, int l, int which, int bid, int nb) {
  const int TIX = opaque_tid(); bid = opaque_s(bid);
  const int lane = TIX & 63;
  const int gw = bid * 4 + (TIX >> 6), nw = nb * 4;
  const bool last = (l == NLAYER - 1);
  const int tend = last ? TL : TT;
  bf16_t* xres = (bf16_t*)p.xres;
  const bf16_t* ybf = (const bf16_t*)p.ybuf;
  (void)which;
  float4 pgg[4], pbb[4], pgv[4], psh[4], psc[4];
#pragma unroll
  for (int i = 0; i < 4; ++i) {
    pgg[i] = *(const float4*)(p.ln1_g + (size_t)l * DM + lane * 16 + 4 * i);
    pbb[i] = *(const float4*)(p.ln1_b + (size_t)l * DM + lane * 16 + 4 * i);
    pgv[i] = pgg[i]; psh[i] = pgg[i]; psc[i] = pgg[i];
  }
  int cur_row = -1;
  uint4 xa, xb, ya, yb;
  float4 xf[4];
#define LN_FETCH(T, XA, XB, YA, YB, XF) {                                                                                       \
    if (l == 0) { const float* xs_ = ((T) < TL ? p.x + (size_t)(T) * DM : p.ctx + (size_t)((T) - TL) * DM) + lane * 16;        \
      _Pragma("unroll") for (int i = 0; i < 4; ++i) XF[i] = *(const float4*)(xs_ + 4 * i); }                                     \
    else { const bf16_t* xs_ = xres + (size_t)(T) * DM + lane * 16; XA = *(const uint4*)xs_; XB = *(const uint4*)(xs_ + 8); }    \
    const bf16_t* ys_ = ybf + (size_t)(T) * DM + lane * 16; YA = *(const uint4*)ys_; YB = *(const uint4*)(ys_ + 8); }
  if (gw < tend) LN_FETCH(gw, xa, xb, ya, yb, xf)
  for (int t = gw; t < tend; t += nw) {
    uint4 nxa = xa, nxb = xb, nya = ya, nyb = yb; float4 nxf[4] = {xf[0], xf[1], xf[2], xf[3]};
    if (t + nw < tend) LN_FETCH(t + nw, nxa, nxb, nya, nyb, nxf)
    const int mr = mod_row(t);
    if (mr != cur_row) {
      cur_row = mr;
      const float* m = p.mod + (size_t)(l * 5 + mr) * 6144 + lane * 16;
#pragma unroll
      for (int i = 0; i < 4; ++i) { pgv[i] = *(const float4*)(m + 2048 + 4 * i); psh[i] = *(const float4*)(m + 3072 + 4 * i); psc[i] = *(const float4*)(m + 4096 + 4 * i); }
    }
    const uint32_t xw[8] = {xa.x, xa.y, xa.z, xa.w, xb.x, xb.y, xb.z, xb.w};
    const uint32_t yw[8] = {ya.x, ya.y, ya.z, ya.w, yb.x, yb.y, yb.z, yb.w};
    float v[16];
    float s1 = 0.f;
#pragma unroll
    for (int i = 0; i < 4; ++i) {
      const float4 xv = (l == 0) ? xf[i] : make_float4(bflo(xw[2 * i]), bfhi(xw[2 * i]), bflo(xw[2 * i + 1]), bfhi(xw[2 * i + 1]));
      const float4 gv = pgv[i];
      v[4 * i + 0] = ALPHA_F * xv.x + gv.x * bflo(yw[2 * i]); v[4 * i + 1] = ALPHA_F * xv.y + gv.y * bfhi(yw[2 * i]);
      v[4 * i + 2] = ALPHA_F * xv.z + gv.z * bflo(yw[2 * i + 1]); v[4 * i + 3] = ALPHA_F * xv.w + gv.w * bfhi(yw[2 * i + 1]);
      s1 += v[4 * i + 0] + v[4 * i + 1] + v[4 * i + 2] + v[4 * i + 3];
    }
    const float mu = wave_sum(s1) * (1.f / 1024.f);
    float s2 = 0.f;
#pragma unroll
    for (int i = 0; i < 16; ++i) { const float d = v[i] - mu; s2 += d * d; }
    const float rs = rsqrtf(wave_sum(s2) * (1.f / 1024.f) + 1e-5f);
    uint32_t xo[8], hw[8];
#pragma unroll
    for (int i = 0; i < 4; ++i) {
      const float4 gg = pgg[i], bb = pbb[i], sh = psh[i], sc = psc[i];
      float4 o;
      o.x = (v[4 * i + 0] - mu) * rs * gg.x + bb.x; o.y = (v[4 * i + 1] - mu) * rs * gg.y + bb.y;
      o.z = (v[4 * i + 2] - mu) * rs * gg.z + bb.z; o.w = (v[4 * i + 3] - mu) * rs * gg.w + bb.w;
      xo[2 * i] = pack2(o.x, o.y); xo[2 * i + 1] = pack2(o.z, o.w);
      hw[2 * i] = pack2(o.x * (1.f + sc.x) + sh.x, o.y * (1.f + sc.y) + sh.y);
      hw[2 * i + 1] = pack2(o.z * (1.f + sc.z) + sh.z, o.w * (1.f + sc.w) + sh.w);
    }
    bf16_t* xd = xres + (size_t)t * DM + lane * 16;
    *(uint4*)xd = make_uint4(xo[0], xo[1], xo[2], xo[3]);
    *(uint4*)(xd + 8) = make_uint4(xo[4], xo[5], xo[6], xo[7]);
    bf16_t* hd = p.hA + (size_t)t * DM + lane * 16;
    *(uint4*)hd = make_uint4(hw[0], hw[1], hw[2], hw[3]);
    *(uint4*)(hd + 8) = make_uint4(hw[4], hw[5], hw[6], hw[7]);
    xa = nxa; xb = nxb; ya = nya; yb = nyb;
#pragma unroll
    for (int i = 0; i < 4; ++i) xf[i] = nxf[i];
  }
#undef LN_FETCH
}

#define CE_DESC(A, B) { const unsigned hi_ = max(A, B), lo_ = min(A, B); A = hi_; B = lo_; }
__device__ __forceinline__ unsigned key_enc(float x, unsigned lowmask, unsigned tag) {
  const unsigned b = __float_as_uint(x);
  const unsigned sgn = (unsigned)((int)b >> 31) | 0x80000000u;
  return ((b ^ sgn) & ~lowmask) | tag;
}
__device__ __forceinline__ float key_val(unsigned key, unsigned lowmask) {
  const unsigned sv = key & ~lowmask;
  return __uint_as_float((sv & 0x80000000u) ? (sv ^ 0x80000000u) : ~sv);
}
__device__ __forceinline__ void sort16_desc(unsigned (&k)[16]) {
#pragma unroll
  for (int size = 2; size <= 16; size <<= 1) {
#pragma unroll
    for (int stride = size >> 1; stride >= 1; stride >>= 1) {
#pragma unroll
      for (int i = 0; i < 16; ++i) {
        if ((i & stride) == 0) {
          const int j = i | stride;
          if ((i & size) == 0 || size == 16) { CE_DESC(k[i], k[j]) } else { CE_DESC(k[j], k[i]) }
        }
      }
    }
  }
}
__device__ __forceinline__ void merge16_desc(unsigned (&r)[16], const unsigned (&c)[16]) {
#pragma unroll
  for (int i = 0; i < 16; ++i) r[i] = max(r[i], c[15 - i]);
#pragma unroll
  for (int stride = 8; stride >= 1; stride >>= 1) {
#pragma unroll
    for (int i = 0; i < 16; ++i) {
      if ((i & stride) == 0) { CE_DESC(r[i], r[i | stride]) }
    }
  }
}

__device__ __forceinline__ void pair_merge16(unsigned (&r)[16]) {
  unsigned c[16];
#pragma unroll
  for (int i = 0; i < 16; ++i) c[i] = (unsigned)__builtin_amdgcn_update_dpp(0, (int)r[i], 0xB1, 0xF, 0xF, true);
  merge16_desc(r, c);
}

__device__ __forceinline__ void ph_wk_topk(const Params& p, int l, int bid, int nb, char* smem) {
  const int TIX = opaque_tid(); bid = opaque_s(bid);
  const int tid = TIX, lane = tid & 63, wave = tid >> 6;
  const int wm = wave >> 1, wn = wave & 1;
  float* sc = (float*)smem;
  const bf16_t* Bt = p.wkT + (size_t)l * 2048 * DM;
  const int trow = tid >> 1, thalf = tid & 1;
  const int nitem_wk = (((l == NLAYER - 1) ? TL : TT) / 128) * 8;
  for (int k = 0;; ++k) {
    int tm, hh;
    if (!xcd_tile<4, 2>(bid, nb, k, nitem_wk >> 3, 8, tm, hh)) break;
    const int m0 = tm << 7;
    unsigned K0[16];
#pragma unroll
    for (int i = 0; i < 16; ++i) K0[i] = 0u;
    for (int ph = 0; ph < 2; ++ph) {
      f32x4 acc[4][4];
      gemm_tile_acc(p.hA, Bt, DM, m0, (hh * 2 + ph) * 128, smem, tid, acc);
#pragma unroll
      for (int i = 0; i < 4; ++i)
#pragma unroll
        for (int j = 0; j < 4; ++j)
#pragma unroll
          for (int r = 0; r < 4; ++r)
            sc[(wm * 64 + i * 16 + (lane >> 4) * 4 + r) * 130 + wn * 65 + j * 16 + (lane & 15)] = acc[i][j][r];
      __syncthreads();
      {
        float* row = sc + trow * 130 + thalf * 65;
        unsigned R[16];
#pragma unroll
        for (int i = 0; i < 16; ++i) R[i] = key_enc(row[i], 127u, 127u - (unsigned)(thalf * 64 + i));
        sort16_desc(R);
#pragma unroll 1
        for (int c = 1; c < 4; ++c) {
          unsigned C[16];
#pragma unroll
          for (int i = 0; i < 16; ++i) C[i] = key_enc(row[c * 16 + i], 127u, 127u - (unsigned)(thalf * 64 + c * 16 + i));
          sort16_desc(C);
          merge16_desc(R, C);
        }
        pair_merge16(R);
        if (ph == 0) {
#pragma unroll
          for (int i = 0; i < 16; ++i) K0[i] = R[i];
        } else {
          float av[16], bv[16];
          int* tab = (int*)(sc + trow * 130);
#pragma unroll
          for (int i = 0; i < 16; ++i) {
            av[i] = key_val(K0[i], 127u); bv[i] = key_val(R[i], 127u);
            tab[i] = 127 - (int)(K0[i] & 127u); tab[16 + i] = 127 - (int)(R[i] & 127u);
          }
          unsigned QA[16], QB[16];
#pragma unroll
          for (int i = 0; i < 16; ++i) { QA[i] = 0u; QB[i] = 0u; }
          {
            int n = 0;
#pragma unroll
            for (int i = 0; i < 16; ++i) {
#pragma unroll
              for (int j = 0; j < 16; ++j) {
                if ((i + 1) * (j + 1) <= 16) {
                  const unsigned key = key_enc(av[i] + bv[j], 255u, 255u - (unsigned)(i * 16 + j));
                  const int ch = n >> 4, sl = n & 15;
                  if (ch == 0) QA[sl] = thalf ? QA[sl] : key;
                  if (ch == 1) QB[sl] = thalf ? QB[sl] : key;
                  if (ch == 2) QA[sl] = thalf ? key : QA[sl];
                  if (ch == 3) QB[sl] = thalf ? key : QB[sl];
                  ++n;
                }
              }
            }
          }
          sort16_desc(QA); sort16_desc(QB);
          merge16_desc(QA, QB);
          pair_merge16(QA);
          float e[16], sum = 0.f;
          const float cv0 = key_val(QA[0], 255u);
#pragma unroll
          for (int i = 0; i < 16; ++i) { e[i] = __expf(key_val(QA[i], 255u) - cv0); sum += e[i]; }
          const float inv = 1.f / sum;
          const unsigned hm = thalf ? 0xFFFFFFFFu : 0u;
          int ce[8]; float ge[8];
#pragma unroll
          for (int i = 0; i < 8; ++i) {
            const unsigned key = (QA[8 + i] & hm) | (QA[i] & ~hm);
            const unsigned flat = 255u - (key & 255u);
            ce[i] = tab[flat >> 4] * 128 + tab[16 + (flat & 15u)];
            ge[i] = __uint_as_float((__float_as_uint(e[8 + i]) & hm) | (__float_as_uint(e[i]) & ~hm)) * inv;
          }
          const size_t o = ((size_t)(m0 + trow) * 8 + hh) * 16 + thalf * 8;
          int4* de = (int4*)(p.pe + o);
          float4* dg = (float4*)(p.pg + o);
          de[0] = make_int4(ce[0], ce[1], ce[2], ce[3]); de[1] = make_int4(ce[4], ce[5], ce[6], ce[7]);
          dg[0] = make_float4(ge[0], ge[1], ge[2], ge[3]); dg[1] = make_float4(ge[4], ge[5], ge[6], ge[7]);
        }
      }
    }
  }
}

typedef float f32x2 __attribute__((ext_vector_type(2)));

#define DPPI(V, CTRL) __builtin_amdgcn_update_dpp(0, (V), (CTRL), 0xF, 0xF, true)
__device__ __forceinline__ int reduce16_transpose_i(const int (&v)[16], int lane) {
  const bool b0 = lane & 1, b1 = lane & 2, b2 = lane & 4, b3 = lane & 8;
  int w[8], x[4], y[2];
#pragma unroll
  for (int i = 0; i < 8; ++i) {
    const int mine = b0 ? v[2 * i + 1] : v[2 * i], other = b0 ? v[2 * i] : v[2 * i + 1];
    w[i] = mine + DPPI(other, 0xB1);
  }
#pragma unroll
  for (int i = 0; i < 4; ++i) {
    const int mine = b1 ? w[2 * i + 1] : w[2 * i], other = b1 ? w[2 * i] : w[2 * i + 1];
    x[i] = mine + DPPI(other, 0x4E);
  }
#pragma unroll
  for (int i = 0; i < 2; ++i) {
    const int mine = b2 ? x[2 * i + 1] : x[2 * i], other = b2 ? x[2 * i] : x[2 * i + 1];
    const int up = DPPI(other, 0x104), dn = DPPI(other, 0x114);
    y[i] = mine + (b2 ? dn : up);
  }
  const int mine = b3 ? y[1] : y[0], other = b3 ? y[0] : y[1];
  int z = mine + DPPI(other, 0x128);
  return rows_sum_i(z);
}

#define GBS 16
#define GBV 8
#define GGT 8
__device__ __forceinline__ void wave_sort128(int& a, int& b, int lane) {
#pragma unroll
  for (int size = 2; size <= 128; size <<= 1) {
#pragma unroll
    for (int stride = size >> 1; stride >= 1; stride >>= 1) {
      if (stride == 64) {
        const int lo = min(a, b), hi = max(a, b); a = lo; b = hi;
      } else {
        const int pa = __shfl_xor(a, stride), pb = __shfl_xor(b, stride);
        const bool lower = (lane & stride) == 0;
        const bool asc_a = (lane & size) == 0, asc_b = ((lane + 64) & size) == 0;
        a = (lower == asc_a) ? min(a, pa) : max(a, pa);
        b = (lower == asc_b) ? min(b, pb) : max(b, pb);
      }
    }
  }
}

template <int GT>
__device__ __forceinline__ void gather_group(const Params& p, const int l, const int tb, const int lane, const unsigned char* ut,
                                             const unsigned char* vt, const bool last, const float* lg, const float* lb,
                                             int* es, float* gs, uint4* hqs) {
    float hsc[GT];
#pragma unroll
    for (int j = 0; j < GT; ++j) {
      const size_t t = (size_t)(tb + j);
      int ka = (p.pe[t * 128 + lane] << 7) | lane, kb2 = (p.pe[t * 128 + 64 + lane] << 7) | (64 + lane);
      const float ga = p.pg[t * 128 + lane], gb = p.pg[t * 128 + 64 + lane];
      wave_sort128(ka, kb2, lane);
      const int ia = ka & 127, ib = kb2 & 127;
      const float xa = __shfl(ga, ia & 63), ya = __shfl(gb, ia & 63);
      const float xb = __shfl(ga, ib & 63), yb = __shfl(gb, ib & 63);
      es[j * 128 + lane] = ka >> 7; es[j * 128 + 64 + lane] = kb2 >> 7;
      gs[j * 128 + lane] = ia < 64 ? xa : ya; gs[j * 128 + 64 + lane] = ib < 64 ? xb : yb;
      const bf16_t* hrow = p.hA + t * DM + lane * 16;
      const uint4 h0 = *(const uint4*)hrow, h1 = *(const uint4*)(hrow + 8);
      float hf[16];
      hf[0] = bflo(h0.x); hf[1] = bfhi(h0.x); hf[2] = bflo(h0.y); hf[3] = bfhi(h0.y);
      hf[4] = bflo(h0.z); hf[5] = bfhi(h0.z); hf[6] = bflo(h0.w); hf[7] = bfhi(h0.w);
      hf[8] = bflo(h1.x); hf[9] = bfhi(h1.x); hf[10] = bflo(h1.y); hf[11] = bfhi(h1.y);
      hf[12] = bflo(h1.z); hf[13] = bfhi(h1.z); hf[14] = bflo(h1.w); hf[15] = bfhi(h1.w);
      float mx = 0.f;
#pragma unroll
      for (int i = 0; i < 16; ++i) mx = fmaxf(mx, fabsf(hf[i]));
#pragma unroll
      for (int o = 32; o > 0; o >>= 1) mx = fmaxf(mx, __shfl_xor(mx, o));
      mx = fmaxf(mx, 1e-20f);
      const float qs = 127.f / mx;
      hsc[j] = mx * (1.f / 127.f) * (1.f / QSCALE_U);
      hqs[j * 64 + lane] = make_uint4(pack_i8x4(hf[0] * qs, hf[1] * qs, hf[2] * qs, hf[3] * qs), pack_i8x4(hf[4] * qs, hf[5] * qs, hf[6] * qs, hf[7] * qs),
                                      pack_i8x4(hf[8] * qs, hf[9] * qs, hf[10] * qs, hf[11] * qs), pack_i8x4(hf[12] * qs, hf[13] * qs, hf[14] * qs, hf[15] * qs));
    }
#pragma unroll 1
    for (int bi = 0; bi < 128 / GBS; ++bi) {
#pragma unroll
      for (int j = 0; j < GT; ++j) {
        uint4 uw[GBS];
        const int esrc = es[j * 128 + bi * GBS + (lane & (GBS - 1))];
#pragma unroll
        for (int u = 0; u < GBS; ++u) {
          const int e = __builtin_amdgcn_readlane(esrc, u);
          uw[u] = *(const uint4*)(ut + (size_t)e * DM);
        }
        int d[GBS];
        const uint4 hqj = hqs[j * 64 + lane];
#pragma unroll
        for (int u = 0; u < GBS; ++u) {
          int dd = __builtin_amdgcn_sdot4((int)uw[u].x, (int)hqj.x, 0, false);
          dd = __builtin_amdgcn_sdot4((int)uw[u].y, (int)hqj.y, dd, false);
          dd = __builtin_amdgcn_sdot4((int)uw[u].z, (int)hqj.z, dd, false);
          dd = __builtin_amdgcn_sdot4((int)uw[u].w, (int)hqj.w, dd, false);
          d[u] = dd;
        }
        static_assert(GBS == 16, "reduce16_transpose handles 16 pairs per batch");
        const float dsel = (float)reduce16_transpose_i(d, lane) * hsc[j];
        const float gsel = gs[j * 128 + bi * GBS + (lane & (GBS - 1))];
        const float a = gsel * 0.5f * dsel * (1.f + erff(dsel * 0.7071067811865476f)) * (1.f / SCALE_V);
        if (lane < GBS) gs[j * 128 + bi * GBS + lane] = a;
        asm volatile("" ::: "memory");
        __builtin_amdgcn_sched_barrier(0);
      }
    }
    constexpr int GV = (GT > 4) ? 4 : GT;
#pragma unroll 1
    for (int j0 = 0; j0 < GT; j0 += GV) {
    f32x2 acc2[GV][8];
#pragma unroll
    for (int j = 0; j < GV; ++j)
#pragma unroll
      for (int i = 0; i < 8; ++i) acc2[j][i] = f32x2{0.f, 0.f};
#pragma unroll 1
    for (int bi = 0; bi < 128 / GBV; ++bi) {
#pragma unroll
      for (int j = 0; j < GV; ++j) {
        uint4 vw[GBV]; float aa[GBV];
        const int esrc = es[(j0 + j) * 128 + bi * GBV + (lane & (GBV - 1))];
        const int gsrc = __builtin_bit_cast(int, gs[(j0 + j) * 128 + bi * GBV + (lane & (GBV - 1))]);
#pragma unroll
        for (int u = 0; u < GBV; ++u) {
          const int e = __builtin_amdgcn_readlane(esrc, u);
          aa[u] = __builtin_bit_cast(float, __builtin_amdgcn_readlane(gsrc, u));
          vw[u] = *(const uint4*)(vt + (size_t)e * DM);
        }
#pragma unroll
        for (int u = 0; u < GBV; ++u) {
          uint32_t w0 = vw[u].x, w1 = vw[u].y, w2 = vw[u].z, w3 = vw[u].w;
          asm volatile("" : "+v"(w0), "+v"(w1), "+v"(w2), "+v"(w3) : "v"(acc2[j][0]), "v"(acc2[j][7]));
          const f32x2 a2 = f32x2{aa[u], aa[u]};
          acc2[j][0] += __builtin_amdgcn_cvt_pk_f32_fp8((int)w0, false) * a2;
          acc2[j][1] += __builtin_amdgcn_cvt_pk_f32_fp8((int)w0, true) * a2;
          acc2[j][2] += __builtin_amdgcn_cvt_pk_f32_fp8((int)w1, false) * a2;
          acc2[j][3] += __builtin_amdgcn_cvt_pk_f32_fp8((int)w1, true) * a2;
          acc2[j][4] += __builtin_amdgcn_cvt_pk_f32_fp8((int)w2, false) * a2;
          acc2[j][5] += __builtin_amdgcn_cvt_pk_f32_fp8((int)w2, true) * a2;
          acc2[j][6] += __builtin_amdgcn_cvt_pk_f32_fp8((int)w3, false) * a2;
          acc2[j][7] += __builtin_amdgcn_cvt_pk_f32_fp8((int)w3, true) * a2;
        }
        asm volatile("" ::: "memory");
        __builtin_amdgcn_sched_barrier(0);
      }
    }
    float acc[GV][16];
#pragma unroll
    for (int j = 0; j < GV; ++j)
#pragma unroll
      for (int i = 0; i < 8; ++i) { acc[j][2 * i] = acc2[j][i].x; acc[j][2 * i + 1] = acc2[j][i].y; }
    float4 pgv[4], pgg[4], pbb[4], psh[4], psc[4];
    {
      const int t0 = tb + j0;
      const float* m = p.mod + (size_t)(l * 5 + mod_row(t0)) * 6144 + lane * 16;
      const float* m2 = p.mod + (size_t)((last ? l : l + 1) * 5 + mod_row(t0)) * 6144 + lane * 16;
#pragma unroll
      for (int i = 0; i < 4; ++i) {
        pgv[i] = *(const float4*)(m + 5120 + 4 * i);
        pgg[i] = *(const float4*)(lg + 4 * i); pbb[i] = *(const float4*)(lb + 4 * i);
        psh[i] = *(const float4*)(m2 + 4 * i); psc[i] = *(const float4*)(m2 + 1024 + 4 * i);
      }
    }
#pragma unroll
    for (int j = 0; j < GV; ++j) {
      __builtin_amdgcn_sched_barrier(0);
      const int t = tb + j0 + j;
      bf16_t* xr = (bf16_t*)p.xres + (size_t)t * DM + lane * 16;
      const uint4 xb0 = *(const uint4*)xr, xb1 = *(const uint4*)(xr + 8);
      const uint32_t xw[8] = {xb0.x, xb0.y, xb0.z, xb0.w, xb1.x, xb1.y, xb1.z, xb1.w};
      float v[16];
      float s1 = 0.f;
#pragma unroll
      for (int i = 0; i < 4; ++i) {
        const float4 xv = make_float4(bflo(xw[2 * i]), bfhi(xw[2 * i]), bflo(xw[2 * i + 1]), bfhi(xw[2 * i + 1]));
        const float4 gv = pgv[i];
        v[4 * i + 0] = ALPHA_F * xv.x + gv.x * acc[j][4 * i + 0]; v[4 * i + 1] = ALPHA_F * xv.y + gv.y * acc[j][4 * i + 1];
        v[4 * i + 2] = ALPHA_F * xv.z + gv.z * acc[j][4 * i + 2]; v[4 * i + 3] = ALPHA_F * xv.w + gv.w * acc[j][4 * i + 3];
        s1 += v[4 * i + 0] + v[4 * i + 1] + v[4 * i + 2] + v[4 * i + 3];
      }
      const float mu = wave_sum(s1) * (1.f / 1024.f);
      float s2 = 0.f;
#pragma unroll
      for (int i = 0; i < 16; ++i) { const float dlt = v[i] - mu; s2 += dlt * dlt; }
      const float rs = rsqrtf(wave_sum(s2) * (1.f / 1024.f) + 1e-5f);
      uint32_t hw[8], xo[8];
#pragma unroll
      for (int i = 0; i < 4; ++i) {
        const float4 gg = pgg[i];
        const float4 bb = pbb[i];
        float4 o;
        o.x = (v[4 * i + 0] - mu) * rs * gg.x + bb.x; o.y = (v[4 * i + 1] - mu) * rs * gg.y + bb.y;
        o.z = (v[4 * i + 2] - mu) * rs * gg.z + bb.z; o.w = (v[4 * i + 3] - mu) * rs * gg.w + bb.w;
        xo[2 * i] = pack2(o.x, o.y); xo[2 * i + 1] = pack2(o.z, o.w);
        if (last && t < TL) *(float4*)(p.out + (size_t)t * DM + lane * 16 + 4 * i) = o;
        const float4 sh = psh[i];
        const float4 sc = psc[i];
        hw[2 * i] = pack2(o.x * (1.f + sc.x) + sh.x, o.y * (1.f + sc.y) + sh.y);
        hw[2 * i + 1] = pack2(o.z * (1.f + sc.z) + sh.z, o.w * (1.f + sc.w) + sh.w);
      }
      *(uint4*)xr = make_uint4(xo[0], xo[1], xo[2], xo[3]);
      *(uint4*)(xr + 8) = make_uint4(xo[4], xo[5], xo[6], xo[7]);
      bf16_t* hd = p.hA + (size_t)t * DM + lane * 16;
      *(uint4*)hd = make_uint4(hw[0], hw[1], hw[2], hw[3]);
      *(uint4*)(hd + 8) = make_uint4(hw[4], hw[5], hw[6], hw[7]);
    }
    }
}

__device__ __forceinline__ void ph_gather_sorted(const Params& p, int l, int bid, int nb, char* smem) {
  const int TIX = opaque_tid(); bid = opaque_s(bid);
  const int lane = TIX & 63;
  const int gw = bid * 4 + (TIX >> 6), nw = nb * 4;
  const unsigned char* ut = (const unsigned char*)p.ubf + lane * 16;
  const unsigned char* vt = (const unsigned char*)p.vbf + lane * 16;
  const bool last = (l == NLAYER - 1);
  const float* lg = p.ln2_g + (size_t)l * DM + lane * 16;
  const float* lb = p.ln2_b + (size_t)l * DM + lane * 16;
  int* es = (int*)(smem + (TIX >> 6) * (GGT * 2048));
  float* gs = (float*)(es + GGT * 128);
  uint4* hqs = (uint4*)(gs + GGT * 128);
  for (int grp = gw; grp < TL / GGT; grp += nw) gather_group<GGT>(p, l, grp * GGT, lane, ut, vt, last, lg, lb, es, gs, hqs);
  if (!last) for (int t = TL + gw; t < TT; t += nw) gather_group<1>(p, l, t, lane, ut, vt, last, lg, lb, es, gs, hqs);
}

enum { PH_PRE_A = 0, PH_PRE_B, PH_INIT, PH_GEMM_IN, PH_ELEM, PH_RET_UPD, PH_RET_SCAN, PH_RET_OUT, PH_GEMM_OUT, PH_LN1,
       PH_GEMM_WK, PH_TOPK1, PH_TOPK2, PH_GATHER, PH_LN2, PH_GNORM };

__device__ __forceinline__ void run_phase(const Params& p, int ph, int l, int bid, int nb, char* smem) {
  switch (ph) {
    case PH_PRE_A:
      ph_mod_partial(p, bid, nb, smem);
      for (int ll = 0; ll < NLAYER; ++ll) {
        ph_transpose_cvt(p.w_in + (size_t)ll * DM * NPROJ, p.w_inT + (size_t)ll * NPROJ * DM, DM, NPROJ, bid, nb, smem);
        ph_transpose_cvt(p.w_out + (size_t)ll * DM * DM, p.w_outT + (size_t)ll * DM * DM, DM, DM, bid, nb, smem);
      }
      ph_wk_fold(p, bid, nb, smem);
      break;
    case PH_PRE_B: ph_mod_reduce(p, bid, nb); break;
    case PH_INIT: ph_init_h(p, bid, nb); break;
    case PH_GEMM_IN:
      ph_gemm_in(p, l, bid, nb, smem);
      break;
    case PH_RET_UPD: ph_ret_upd(p, bid, nb, smem); break;
    case PH_RET_SCAN: ph_ret_scan(p, bid, nb); break;
    case PH_RET_OUT: ph_ret_out(p, l, bid, nb, smem); break;
    case PH_GEMM_OUT: ph_gemm<true>(p.cat, p.w_outT + (size_t)l * DM * DM, p.ybuf, (l == NLAYER - 1) ? TL : TT, DM, DM, bid, nb, smem); break;
    case PH_LN1: ph_ln(p, l, 1, bid, nb); break;
    case PH_GEMM_WK: ph_wk_topk(p, l, bid, nb, smem); break;
    case PH_GATHER: ph_gather_sorted(p, l, bid, nb, smem); break;
    case PH_GNORM: ph_gnorm(p, l, bid, nb); break;
  }
}

extern __shared__ __attribute__((aligned(16))) char dyn_smem[];

#define XB_TMO      128
#define XB_XCNT(j)  (256  + 64 * (j))
#define XB_XSUB(j)  (1280 + 64 * (j))
#define XB_XGEN(j)  (2304 + 64 * (j))
#define XB_TOP      3328
#define XB_TOPGEN   3392
#define XCD_BAR_WORDS 3456
#define XB_SPIN_CAP (1u << 22)
__device__ __forceinline__ unsigned xb_ld(unsigned* q)              { return __hip_atomic_load(q, __ATOMIC_RELAXED, __HIP_MEMORY_SCOPE_AGENT); }
__device__ __forceinline__ unsigned xb_add(unsigned* q, unsigned v) { return __hip_atomic_fetch_add(q, v, __ATOMIC_RELAXED, __HIP_MEMORY_SCOPE_AGENT); }
__device__ __forceinline__ unsigned xb_xcc_id() { return (unsigned)__builtin_amdgcn_s_getreg((3 << 11) | 20) & 0xFu; }
#define XB_SPIN(cond, bar) do { unsigned _sp = 0; while (cond) { __builtin_amdgcn_s_sleep(1); \
    if ((++_sp & 255u) == 0u) { if (xb_ld(&(bar)[XB_TMO])) break; if (_sp > XB_SPIN_CAP) { atomicAdd(&(bar)[XB_TMO], 1u); break; } } } } while (0)
struct XcdBarrier { unsigned* bar; unsigned x; volatile unsigned* st; };
__device__ __forceinline__ XcdBarrier xcd_barrier_post(unsigned* bar, volatile unsigned* st) {
  XcdBarrier b; b.bar = bar; b.x = xb_xcc_id(); b.st = st;
  if (threadIdx.x == 0) (void)xb_add(&bar[XB_XCNT(b.x)], 1u);
  return b;
}
__device__ __forceinline__ void xcd_barrier_complete(unsigned* bar, unsigned x, unsigned& nloc, unsigned& nx) {
  const unsigned G = gridDim.x * gridDim.y * gridDim.z;
  unsigned sum, cnt, mine, sp = 0u;
  for (;;) {
    sum = 0u; cnt = 0u; mine = 0u;
#pragma unroll
    for (unsigned j = 0; j < 16; ++j) { const unsigned c = xb_ld(&bar[XB_XCNT(j)]); sum += c; cnt += (c > 0u) ? 1u : 0u; mine = (j == x) ? c : mine; }
    if (sum == G) break;
    __builtin_amdgcn_s_sleep(1);
    if ((++sp & 255u) == 0u) { if (xb_ld(&bar[XB_TMO])) break; if (sp > XB_SPIN_CAP) { atomicAdd(&bar[XB_TMO], 1u); break; } }
  }
  nloc = mine > 0u ? mine : 1u; nx = cnt > 0u ? cnt : 1u;
}
__device__ __forceinline__ void xcd_barrier(const XcdBarrier& b) {
  asm volatile("s_waitcnt vmcnt(0)" ::: "memory");
  __syncthreads();
  if (threadIdx.x == 0) {
    unsigned* bar = b.bar;
    __builtin_amdgcn_s_waitcnt(0);
    unsigned nloc = b.st[0], nx = b.st[1];
    if (nloc == 0u) { xcd_barrier_complete(bar, b.x, nloc, nx); b.st[0] = nloc; b.st[1] = nx; }
    const unsigned old = xb_add(&bar[XB_XSUB(b.x)], 1u);
    const unsigned gen = old / nloc;
    if (old + 1u == (gen + 1u) * nloc) {
      __builtin_amdgcn_fence(__ATOMIC_RELEASE, "agent");
      asm volatile("s_waitcnt vmcnt(0)" ::: "memory");
      const unsigned og = xb_add(&bar[XB_TOP], 1u);
      const unsigned tg = og / nx;
      if (og + 1u == (tg + 1u) * nx) xb_add(&bar[XB_TOPGEN], 1u);
      else XB_SPIN(xb_ld(&bar[XB_TOPGEN]) == tg, bar);
      __builtin_amdgcn_fence(__ATOMIC_ACQUIRE, "agent");
      xb_add(&bar[XB_XGEN(b.x)], 1u);
      asm volatile("s_waitcnt vmcnt(0)" ::: "memory");
    } else {
      XB_SPIN(xb_ld(&bar[XB_XGEN(b.x)]) == gen, bar);
      __builtin_amdgcn_fence(__ATOMIC_ACQUIRE, "agent");
      asm volatile("s_waitcnt vmcnt(0)" ::: "memory");
    }
  }
  __syncthreads();
}

__global__ void __launch_bounds__(256, 2) k_mega(Params p) {
  cg::grid_group grid = cg::this_grid();
  const int bid = blockIdx.x, nb = gridDim.x;
  volatile unsigned* xst = (volatile unsigned*)(dyn_smem + 66560);
  if (threadIdx.x == 0) { xst[0] = 0u; xst[1] = 0u; xst[2] = 0u; xst[3] = 0u; }
  __syncthreads();
  const XcdBarrier xb = xcd_barrier_post(p.bar, xst);
#define GSYNC() xcd_barrier(xb)
  grid.sync();
#define RUNP(PH, L, SYNC) do { unsigned long long t0_ = 0; if ((PROBE_MASK >> (PH)) & 1) t0_ = wall_clock64(); \
    run_phase(p, PH, L, bid, nb, dyn_smem); if (SYNC) GSYNC(); \
    if ((PROBE_MASK >> (PH)) & 1) { if (!(SYNC)) GSYNC(); const unsigned long long t1_ = wall_clock64(); \
      while (wall_clock64() - t1_ < t1_ - t0_) __builtin_amdgcn_s_sleep(8); GSYNC(); } } while (0)
  RUNP(PH_PRE_A, 0, 1);
  RUNP(PH_PRE_B, 0, 1);
  RUNP(PH_INIT, 0, 1);
  for (int l = 0; l < NLAYER; ++l) {
    RUNP(PH_GEMM_IN, l, 1);
    RUNP(PH_RET_UPD, l, 1);
    RUNP(PH_RET_SCAN, l, 1);
    RUNP(PH_RET_OUT, l, 1);
    RUNP(PH_GNORM, l, 1);
    RUNP(PH_GEMM_OUT, l, 1);
    RUNP(PH_LN1, l, 1);
    RUNP(PH_GEMM_WK, l, 1);
    RUNP(PH_GATHER, l, (l + 1 < NLAYER));
  }
#undef GSYNC
}

static inline size_t al256(size_t v) { return (v + 255) & ~(size_t)255; }

extern "C" void kernel_launch(void* const* d_in, const int* in_sizes, int n_in, void* d_out, int out_size, void* d_ws,
                              size_t ws_size, hipStream_t stream) {
  static int mgrid = 0;
  if (mgrid == 0) {
    int dev = 0, cus = 0, per_cu = 0;
    (void)hipGetDevice(&dev);
    (void)hipDeviceGetAttribute(&cus, hipDeviceAttributeMultiprocessorCount, dev);
    if (cus <= 0) cus = 256;
    (void)hipFuncSetAttribute((const void*)k_mega, hipFuncAttributeMaxDynamicSharedMemorySize, SMEM_BYTES);
    if (hipOccupancyMaxActiveBlocksPerMultiprocessor(&per_cu, (const void*)k_mega, 256, SMEM_BYTES) != hipSuccess || per_cu < 1) per_cu = 1;
    if (per_cu > 2) per_cu = 2;
    mgrid = cus * per_cu;
  }
  Params p{};
  p.x = (const float*)d_in[0]; p.c = (const float*)d_in[1]; p.ctx = (const float*)d_in[2]; p.c_ctx = (const float*)d_in[3];
  p.w_mod = (const float*)d_in[4]; p.b_mod = (const float*)d_in[5]; p.w_in = (const float*)d_in[6]; p.conv_w = (const float*)d_in[7];
  p.w_out = (const float*)d_in[8]; p.ln1_g = (const float*)d_in[9]; p.ln1_b = (const float*)d_in[10]; p.peer_wq = (const float*)d_in[11];
  p.peer_keys = (const float*)d_in[12]; p.peer_u = (const float*)d_in[13]; p.peer_v = (const float*)d_in[14];
  p.ln2_g = (const float*)d_in[15]; p.ln2_b = (const float*)d_in[16];
  p.out = (float*)d_out;
  char* w = (char*)d_ws; size_t off = 0;
  auto take = [&](size_t bytes) { char* r = w + off; off = al256(off + bytes); return r; };
  p.xres = (float*)take((size_t)TT * DM * 4);
  p.hA = (bf16_t*)take((size_t)TT * DM * 2);
  p.big = take((size_t)TT * 2048 * 4);
  p.cat = (bf16_t*)take((size_t)TT * DM * 2);
  p.st = (float*)take((size_t)2 * NCHUNK * 4 * 16384 * 4);
  p.ybuf = (float*)take((size_t)TT * DM * 4);
  p.w_inT = (bf16_t*)take((size_t)NLAYER * NPROJ * DM * 2);
  p.w_outT = (bf16_t*)take((size_t)NLAYER * DM * DM * 2);
  p.wkT = (bf16_t*)take((size_t)NLAYER * 2048 * DM * 2);
  p.ubf = (bf16_t*)take((size_t)NEXP * DM * 2);
  p.vbf = (bf16_t*)take((size_t)NEXP * DM * 2);
  p.mod = (float*)take((size_t)4 * 5 * 6144 * 4);
  p.modp = (float*)take((size_t)8 * 4 * 5 * 6144 * 4);
  p.ropec = (float*)take(128 * 32 * 4);
  p.ropes = (float*)take(128 * 32 * 4);
  p.bar = (unsigned*)take(XCD_BAR_WORDS * 4);
  p.pad0 = nullptr;
  {
    char* a = (char*)p.st; size_t o2 = 0;
    p.sv = (float*)(a + o2); o2 = al256(o2 + (size_t)TT * 256 * 4);
    p.si = (unsigned char*)(a + o2); o2 = al256(o2 + (size_t)TT * 256);
    p.pe = (int*)(a + o2); o2 = al256(o2 + (size_t)TT * 128 * 4);
    p.pg = (float*)(a + o2); o2 = al256(o2 + (size_t)TT * 128 * 4);
  }
  for (int d = 0; d < 2; ++d)
    for (int h = 0; h < 4; ++h) p.lg2[d][h] = (float)log2(1.0 - exp2(-(5.0 + 0.5 * d + (double)h)));
  if (off > ws_size) { fprintf(stderr, "kernel_launch: workspace too small: need %zu have %zu\n", off, ws_size); return; }

  (void)hipMemsetAsync(p.bar, 0, XCD_BAR_WORDS * 4, stream);
  void* args[] = {(void*)&p};
  hipError_t e = hipLaunchCooperativeKernel((const void*)k_mega, dim3(mgrid), dim3(256), args, SMEM_BYTES, stream);
  if (e != hipSuccess) fprintf(stderr, "kernel_launch: cooperative launch failed: %s (grid %d)\n", hipGetErrorString(e), mgrid);
}
```
